# Optimizing an MI355X kernel written in HIP

```python
import math
import jax, jax.numpy as jnp
from jax import lax
import numpy as np

D_MODEL = 2048
BATCH = 2
SEQ = 8192
DEPTH = 2

MEM_LEN = 256
CONV_WIDTH = 1024
CONV_K = 3
DIFF_HEADS = 8
DIFF_D = 64
DIFF_V = 2 * DIFF_D
DIFF_QK = DIFF_HEADS * 2 * DIFF_D
DIFF_VW = DIFF_HEADS * DIFF_V
X_HEADS = 4
X_HEAD_DIM = 256
X_WIDTH = X_HEADS * X_HEAD_DIM
N_BRANCH = 3
ROPE_THETA = 500000.0
ROT_FRAC = 4
D_FF = ((8 * D_MODEL // 3 + 255) // 256) * 256
Q_BLOCK = 128
EPS = 1e-6
IN_SIZES = (CONV_WIDTH, CONV_WIDTH, CONV_WIDTH, DIFF_QK, DIFF_QK, DIFF_VW, X_WIDTH, N_BRANCH * D_MODEL)
N_IN = CONV_WIDTH * 3 + DIFF_QK * 2 + DIFF_VW + X_WIDTH + N_BRANCH * D_MODEL

kernel_name = 'hybrid_conv_diffattn_memxattn_swiglu'


def rms_norm(t, g):
    t32 = t.astype(jnp.float32)
    out = t32 * lax.rsqrt(jnp.mean(t32 * t32, axis=-1, keepdims=True) + EPS)
    return (out * g.astype(jnp.float32)).astype(t.dtype)


def partial_rotary(t, positions):
    d = t.shape[-1]
    rot = d // ROT_FRAC
    half = rot // 2
    inv_freq = ROPE_THETA ** (-jnp.arange(half, dtype=jnp.float32) / half)
    ang = positions.astype(jnp.float32)[..., None] * inv_freq
    ang = ang[:, :, None, None, :]
    cos, sin = jnp.cos(ang), jnp.sin(ang)
    t32 = t.astype(jnp.float32)
    x1 = t32[..., :half]
    x2 = t32[..., half:rot]
    out = jnp.concatenate([x1 * cos - x2 * sin, x2 * cos + x1 * sin, t32[..., rot:]], axis=-1)
    return out.astype(t.dtype)


def causal_short_conv(u, w):
    S = u.shape[1]
    up = jnp.pad(u, ((0, 0), (CONV_K - 1, 0), (0, 0)))
    y = up[:, 0:S] * w[0]
    for j in range(1, CONV_K):
        y = y + up[:, j:j + S] * w[j]
    return y


def diff_attention(q, k, v, lam):
    B, S, H, _, d = q.shape
    nb = S // Q_BLOCK
    k32 = k.astype(jnp.float32)
    v32 = v.astype(jnp.float32)
    qb = (q.astype(jnp.float32) * (d ** -0.5)).reshape(B, nb, Q_BLOCK, H, 2, d).transpose(1, 0, 2, 3, 4, 5)
    starts = jnp.arange(nb, dtype=jnp.int32) * Q_BLOCK
    k_idx = jnp.arange(S, dtype=jnp.int32)

    def block(args):
        q_blk, start = args
        s = jnp.einsum('bqhcd,bkhcd->bhcqk', q_blk, k32)
        causal = (start + jnp.arange(Q_BLOCK, dtype=jnp.int32))[:, None] >= k_idx[None, :]
        s = jnp.where(causal, s, -jnp.inf)
        p = jax.nn.softmax(s, axis=-1)
        a = p[:, :, 0] - lam * p[:, :, 1]
        return jnp.einsum('bhqk,bkhe->bqhe', a, v32)

    o = lax.map(block, (qb, starts))
    return o.transpose(1, 0, 2, 3, 4).reshape(B, S, H, 2 * d)


def setup_inputs(seed: int = 0) -> dict:
    key = jax.random.key(seed)
    ks = jax.random.split(key, 24)
    f32 = jnp.float32

    def nrm(k, shape, fan_in):
        return jax.random.normal(k, shape, f32) * (fan_in ** -0.5)

    def gain(k, shape):
        return 1.0 + 0.02 * jax.random.normal(k, shape, f32)

    return {
        'x': jax.random.normal(ks[0], (BATCH, SEQ, D_MODEL), f32),
        'mem': jax.random.normal(ks[1], (BATCH, MEM_LEN, D_MODEL), f32),
        'positions': jnp.broadcast_to(jnp.arange(SEQ, dtype=jnp.int32), (BATCH, SEQ)),
        'g_mix': gain(ks[2], (DEPTH, D_MODEL)),
        'w_in': nrm(ks[3], (DEPTH, D_MODEL, N_IN), D_MODEL),
        'conv_w': nrm(ks[4], (DEPTH, CONV_K, CONV_WIDTH), CONV_K),
        'w_conv_out': nrm(ks[5], (DEPTH, CONV_WIDTH, D_MODEL), CONV_WIDTH),
        'g_q_diff': gain(ks[6], (DEPTH, DIFF_D)),
        'g_k_diff': gain(ks[7], (DEPTH, DIFF_D)),
        'lambda_vecs': 0.1 * jax.random.normal(ks[8], (DEPTH, 4, DIFF_D), f32),
        'g_subln': gain(ks[9], (DEPTH, DIFF_V)),
        'w_diff_out': nrm(ks[10], (DEPTH, DIFF_VW, D_MODEL), DIFF_VW),
        'g_mem': gain(ks[11], (DEPTH, D_MODEL)),
        'w_mem_kv': nrm(ks[12], (DEPTH, D_MODEL, 2 * X_WIDTH), D_MODEL),
        'g_q_x': gain(ks[13], (DEPTH, X_HEAD_DIM)),
        'g_k_x': gain(ks[14], (DEPTH, X_HEAD_DIM)),
        'w_x_out': nrm(ks[15], (DEPTH, X_WIDTH, D_MODEL), X_WIDTH),
        'w_o': nrm(ks[16], (DEPTH, D_MODEL, D_MODEL), D_MODEL),
        'g_ffn': gain(ks[17], (DEPTH, D_MODEL)),
        'w_gate_up': nrm(ks[18], (DEPTH, D_MODEL, 2 * D_FF), D_MODEL),
        'w_down': nrm(ks[19], (DEPTH, D_FF, D_MODEL), D_FF),
    }


def reference(x, mem, positions, g_mix, w_in, conv_w, w_conv_out, g_q_diff, g_k_diff,
              lambda_vecs, g_subln, w_diff_out, g_mem, w_mem_kv, g_q_x, g_k_x, w_x_out,
              w_o, g_ffn, w_gate_up, w_down):
    B, S, D = x.shape
    M = mem.shape[1]
    split_idx = [int(v) for v in np.cumsum(IN_SIZES)[:-1]]
    for l in range(DEPTH):
        lam_init = 0.8 - 0.6 * math.exp(-0.3 * l)
        h = rms_norm(x, g_mix[l])
        proj = jnp.einsum('bsd,dn->bsn', h, w_in[l])
        cb, cc, cx, dq, dk, dv, xq, gates = jnp.split(proj, split_idx, axis=-1)

        y_a = jnp.einsum('bsc,cd->bsd', cb * causal_short_conv(cc * cx, conv_w[l]), w_conv_out[l])

        dq = partial_rotary(rms_norm(dq.reshape(B, S, DIFF_HEADS, 2, DIFF_D), g_q_diff[l]), positions)
        dk = partial_rotary(rms_norm(dk.reshape(B, S, DIFF_HEADS, 2, DIFF_D), g_k_diff[l]), positions)
        dv = dv.reshape(B, S, DIFF_HEADS, DIFF_V)
        lv = lambda_vecs[l].astype(jnp.float32)
        lam = jnp.exp(jnp.sum(lv[0] * lv[1])) - jnp.exp(jnp.sum(lv[2] * lv[3])) + lam_init
        o_b = rms_norm(diff_attention(dq, dk, dv, lam), g_subln[l]) * (1.0 - lam_init)
        y_b = jnp.einsum('bsn,nd->bsd', o_b.reshape(B, S, DIFF_VW).astype(x.dtype), w_diff_out[l])

        kv = jnp.einsum('bmd,dn->bmn', rms_norm(mem, g_mem[l]), w_mem_kv[l]).reshape(B, M, 2, X_HEADS, X_HEAD_DIM)
        mk = rms_norm(kv[:, :, 0], g_k_x[l]).astype(jnp.float32)
        mv = kv[:, :, 1].astype(jnp.float32)
        xq = rms_norm(xq.reshape(B, S, X_HEADS, X_HEAD_DIM), g_q_x[l]).astype(jnp.float32)
        s_x = jnp.einsum('bshd,bmhd->bhsm', xq, mk) * (X_HEAD_DIM ** -0.5)
        p_x = jax.nn.softmax(s_x, axis=-1)
        o_c = jnp.einsum('bhsm,bmhd->bshd', p_x, mv).reshape(B, S, X_WIDTH).astype(x.dtype)
        y_c = jnp.einsum('bsn,nd->bsd', o_c, w_x_out[l])

        g = jax.nn.sigmoid(gates.astype(jnp.float32)).reshape(B, S, N_BRANCH, D).astype(x.dtype)
        merged = g[:, :, 0] * y_a + g[:, :, 1] * y_b + g[:, :, 2] * y_c
        x = x + jnp.einsum('bsd,de->bse', merged, w_o[l])

        h2 = rms_norm(x, g_ffn[l])
        gu = jnp.einsum('bsd,df->bsf', h2, w_gate_up[l])
        a, b = jnp.split(gu, 2, axis=-1)
        x = x + jnp.einsum('bsf,fd->bsd', jax.nn.silu(a) * b, w_down[l])
    return x
```

```cpp
#include <hip/hip_runtime.h>
#include <hip/hip_cooperative_groups.h>
#include <cstdio>
#include <cstdint>
namespace cg = cooperative_groups;

#ifndef NAIVE_MASK
#define NAIVE_MASK 0x0
#endif

#ifndef REP_ATTN
#define REP_ATTN 1
#endif
#ifndef REP_P0
#define REP_P0 1
#endif
#ifndef REP_P1
#define REP_P1 1
#endif
#ifndef REP_P4
#define REP_P4 1
#endif
#ifndef REP_P5
#define REP_P5 1
#endif
#ifndef REP_P7
#define REP_P7 1
#endif
#ifndef REP_P2
#define REP_P2 1
#endif
#ifndef REP_X
#define REP_X 1
#endif
#ifndef REP_GU
#define REP_GU 1
#endif
#ifndef DBG_SKIP
#define DBG_SKIP 0
#endif
#ifndef EN_MASK
#define EN_MASK 0xFFFF
#endif
#define PH_EN(n) (((EN_MASK) >> (n)) & 1)
constexpr int BATCH = 2, SEQ = 8192, DM = 2048, TOK = BATCH * SEQ, NIN = 13312, NP = 12288, DFF = 5632, MEMLEN = 256, DEPTH = 2;
constexpr float EPS = 1e-6f, LOG2E = 1.4426950408889634f;
constexpr int C_CB = 0, C_CC = 1024, C_CX = 2048, C_DQ = 3072, C_DK = 4096, C_XQ = 5120, C_G = 6144;
constexpr int C_CA = 0, C_P = 1024, C_OC = 2048, C_OB = 3072;

typedef unsigned short bf16_t;
typedef float f32x4 __attribute__((ext_vector_type(4)));
typedef float f32x2 __attribute__((ext_vector_type(2)));
typedef float f32x16 __attribute__((ext_vector_type(16)));
typedef unsigned u32x4 __attribute__((ext_vector_type(4)));
typedef unsigned u32x2 __attribute__((ext_vector_type(2)));
typedef short bf16x8 __attribute__((ext_vector_type(8)));
typedef __bf16 bf16x2_t __attribute__((ext_vector_type(2)));
#define LAS __attribute__((address_space(3)))

constexpr size_t MiB = 1u << 20, KiB = 1024;
constexpr size_t WS_SS = 0, WS_QSS = 256 * KiB, WS_LSUM = 768 * KiB, WS_KSS = 1280 * KiB, WS_SSMEM = 1296 * KiB, WS_ZERO_LO = 64 * KiB, WS_ZERO_HI = 1296 * KiB;
constexpr size_t WS_XSH = 1300 * KiB;
constexpr size_t WS_CS = 2 * MiB, WS_MEMB = 4 * MiB, WS_MKRAW = 6 * MiB, WS_MVT = 7 * MiB;
constexpr size_t WS_WIN = 8 * MiB, WS_WC = 60 * MiB, WS_WD = 64 * MiB, WS_WX = 68 * MiB, WS_WMKV = 72 * MiB, WS_WO = 80 * MiB, WS_WGU = 88 * MiB, WS_WDN = 132 * MiB;
constexpr size_t WS_PROJ = 154 * MiB, WS_VT = 538 * MiB, WS_XB = 570 * MiB, WS_MG = 634 * MiB, WS_END = 698 * MiB;
constexpr size_t WS_H = WS_PROJ;

__device__ __forceinline__ unsigned pk2(float lo, float hi) { f32x2 v = {lo, hi}; bf16x2_t b = __builtin_convertvector(v, bf16x2_t); return __builtin_bit_cast(unsigned, b); }
__device__ __forceinline__ u32x4 pack8(f32x4 a, f32x4 b) { u32x4 w; w.x = pk2(a.x, a.y); w.y = pk2(a.z, a.w); w.z = pk2(b.x, b.y); w.w = pk2(b.z, b.w); return w; }
__device__ __forceinline__ float blo(unsigned w) { return __uint_as_float(w << 16); }
__device__ __forceinline__ float bhi(unsigned w) { return __uint_as_float(w & 0xffff0000u); }
__device__ __forceinline__ void unpack8(u32x4 w, f32x4& a, f32x4& b) { a = (f32x4){blo(w.x), bhi(w.x), blo(w.y), bhi(w.y)}; b = (f32x4){blo(w.z), bhi(w.z), blo(w.w), bhi(w.w)}; }
__device__ __forceinline__ int opaque(int v) { asm volatile("" : "+v"(v)); return v; }
__device__ __forceinline__ int phase_tid(int wave0) { int t; asm volatile("v_mbcnt_lo_u32_b32 %0, -1, 0\n\tv_mbcnt_hi_u32_b32 %0, -1, %0" : "=v"(t)); return t | (wave0 << 6); }
__device__ __forceinline__ float sum4(f32x4 v) { return (v.x + v.y) + (v.z + v.w); }
__device__ __forceinline__ float rs_of(float ss, float invn) { return rsqrtf(ss * invn + EPS); }
__constant__ float INVF[8] = {1.0f, 0.1939227432012558f, 0.03760603070259094f, 0.007292664609849453f, 0.0014142135623842478f, 0.00027424818836152554f, 5.3182957344688475e-05f, 1.0313385246263351e-05f};
__device__ __forceinline__ float xor32_sum(float v) { auto rr = __builtin_amdgcn_permlane32_swap(__float_as_uint(v), __float_as_uint(v), false, false); return __uint_as_float(rr[0]) + __uint_as_float(rr[1]); }
__device__ __forceinline__ float xor32_max(float v) { auto rr = __builtin_amdgcn_permlane32_swap(__float_as_uint(v), __float_as_uint(v), false, false); return fmaxf(__uint_as_float(rr[0]), __uint_as_float(rr[1])); }
template <int X> __device__ __forceinline__ float swz_xor(float v) { return __int_as_float(__builtin_amdgcn_ds_swizzle(__float_as_int(v), 0x1f | (X << 10))); }
__device__ __forceinline__ float wave_sum(float v) {
    v += swz_xor<1>(v); v += swz_xor<2>(v); v += swz_xor<4>(v); v += swz_xor<8>(v); v += swz_xor<16>(v); v = xor32_sum(v);
    return v;
}
__device__ __forceinline__ float wave_max(float v) {
    v = fmaxf(v, swz_xor<1>(v)); v = fmaxf(v, swz_xor<2>(v)); v = fmaxf(v, swz_xor<4>(v)); v = fmaxf(v, swz_xor<8>(v)); v = fmaxf(v, swz_xor<16>(v)); v = xor32_max(v);
    return v;
}
__device__ __forceinline__ float sigmoidf_(float v) { return __builtin_amdgcn_rcpf(1.f + __expf(-v)); }

struct EIn {
    static constexpr bool PAIRED = false;
    bf16_t* proj; const float* ss; const float* gq; const float* gk; float* qss;
    __device__ __forceinline__ float* target(int row, int col0) const { return (qss && col0 >= C_XQ && col0 < C_G) ? qss + row * 4 + ((col0 - C_XQ) >> 8) : nullptr; }
    __device__ __forceinline__ float apply(int row, int col0, f32x4 a, f32x4 b) const {
        const float rs = rs_of(ss[row], 1.f / DM); a *= rs; b *= rs; float s = 0.f;
        if (col0 >= C_G) {
#pragma unroll
            for (int i = 0; i < 4; ++i) { a[i] = sigmoidf_(a[i]); b[i] = sigmoidf_(b[i]); }
        } else if (col0 >= C_XQ) {
            const int d = (col0 - C_XQ) & 255;
            s = sum4(a * a) + sum4(b * b);
            const f32x4 g0 = *(const f32x4*)(gq + d) * *(const f32x4*)(gk + d), g1 = *(const f32x4*)(gq + d + 4) * *(const f32x4*)(gk + d + 4);
            a *= g0; b *= g1;
        }
        *(u32x4*)(proj + (size_t)row * NP + col0) = pack8(a, b);
        return s;
    }
};
struct EColScale {
    static constexpr bool PAIRED = false;
    bf16_t* O; const float* ss; int ldc, pad;
    __device__ __forceinline__ float* target(int, int) const { return nullptr; }
    __device__ __forceinline__ float apply(int row, int col0, f32x4 a, f32x4 b) const {
        const f32x4 s0 = *(const f32x4*)(ss + col0), s1 = *(const f32x4*)(ss + col0 + 4);
#pragma unroll
        for (int i = 0; i < 4; ++i) { a[i] *= rs_of(s0[i], 1.f / DM); b[i] *= rs_of(s1[i], 1.f / DM); }
        *(u32x4*)(O + (size_t)row * ldc + col0) = pack8(a, b);
        return 0.f;
    }
};
struct EMemK {
    static constexpr bool PAIRED = false;
    bf16_t* O; const float* ssmem; float* kss;
    __device__ __forceinline__ float* target(int row, int col0) const { return kss ? kss + row * 4 + (col0 >> 8) : nullptr; }
    __device__ __forceinline__ float apply(int row, int col0, f32x4 a, f32x4 b) const {
        const float rs = rs_of(ssmem[row], 1.f / DM); a *= rs; b *= rs;
        *(u32x4*)(O + (size_t)row * 1024 + col0) = pack8(a, b);
        return sum4(a * a) + sum4(b * b);
    }
};
template <bool LDSRK> struct EXs {
    static constexpr bool PAIRED = false;
    bf16_t* proj; const float* qss; const float* kss; float* lsum; const float* Mxp; unsigned rkl; int b, h; float c;
    __device__ __forceinline__ float* target(int row, int) const { return lsum ? lsum + row * 4 + h : nullptr; }
    __device__ __forceinline__ float apply(int row, int col0, f32x4 a, f32x4 bb) const {
        const float rq = rs_of(qss[row * 4 + h], 1.f / 256) * c, Mx = __hip_atomic_load(Mxp, __ATOMIC_RELAXED, __HIP_MEMORY_SCOPE_AGENT);
        f32x4 k0, k1;
        if constexpr (LDSRK) { const LAS float* rk = (const LAS float*)rkl; k0 = *(const LAS f32x4*)(rk + col0); k1 = *(const LAS f32x4*)(rk + col0 + 4); }
        else {
#pragma unroll
            for (int i = 0; i < 4; ++i) { k0[i] = rs_of(kss[(b * 256 + col0 + i) * 4 + h], 1.f / 256); k1[i] = rs_of(kss[(b * 256 + col0 + 4 + i) * 4 + h], 1.f / 256); }
        }
        float s = 0.f;
#pragma unroll
        for (int i = 0; i < 4; ++i) {
            a[i] = __builtin_amdgcn_exp2f(a[i] * rq * k0[i] - Mx);
            bb[i] = __builtin_amdgcn_exp2f(bb[i] * rq * k1[i] - Mx);
            s += a[i] + bb[i];
        }
        *(u32x4*)(proj + (size_t)row * NP + C_P + h * 256 + col0) = pack8(a, bb);
        return s;
    }
};
struct EXo {
    static constexpr bool PAIRED = false;
    bf16_t* proj; const float* lsum; int h, pad;
    __device__ __forceinline__ float* target(int, int) const { return nullptr; }
    __device__ __forceinline__ float apply(int row, int col0, f32x4 a, f32x4 b) const {
        const float inv = 1.f / __hip_atomic_load(lsum + row * 4 + h, __ATOMIC_RELAXED, __HIP_MEMORY_SCOPE_AGENT);
        a *= inv; b *= inv;
        *(u32x4*)(proj + (size_t)row * NP + C_OC + h * 256 + col0) = pack8(a, b);
        return 0.f;
    }
};
struct EMerge {
    static constexpr bool PAIRED = false;
    bf16_t* mg; const bf16_t* proj; int gi, pad;
    __device__ __forceinline__ float* target(int, int) const { return nullptr; }
    __device__ __forceinline__ float apply(int row, int col0, f32x4 a, f32x4 b) const {
        f32x4 g0, g1; unpack8(*(const u32x4*)(proj + (size_t)row * NP + C_G + gi * 2048 + col0), g0, g1);
        a *= g0; b *= g1;
        bf16_t* p = mg + (size_t)row * DM + col0;
        if (gi > 0) { f32x4 m0, m1; unpack8(*(const u32x4*)p, m0, m1); a += m0; b += m1; }
        *(u32x4*)p = pack8(a, b);
        return 0.f;
    }
};
struct ERes {
    static constexpr bool PAIRED = false;
    const float* xin; float* xout; bf16_t* xb; float* ssn;
    __device__ __forceinline__ float* target(int row, int) const { return ssn ? ssn + row : nullptr; }
    __device__ __forceinline__ float apply(int row, int col0, f32x4 a, f32x4 b) const {
        const size_t off = (size_t)row * DM + col0;
        a += *(const f32x4*)(xin + off); b += *(const f32x4*)(xin + off + 4);
        *(f32x4*)(xout + off) = a; *(f32x4*)(xout + off + 4) = b;
        *(u32x4*)(xb + off) = pack8(a, b);
        return sum4(a * a) + sum4(b * b);
    }
};
struct EGU {
    static constexpr bool PAIRED = true;
    bf16_t* H; const float* ss;
    __device__ __forceinline__ void apply2(int row, int lcol0, f32x4 a0, f32x4 a1, f32x4 b0, f32x4 b1) const {
        const float rs = rs_of(ss[row], 1.f / DM);
#pragma unroll
        for (int i = 0; i < 4; ++i) {
            const float x = a0[i] * rs, y = a1[i] * rs;
            a0[i] = x * sigmoidf_(x) * (b0[i] * rs); a1[i] = y * sigmoidf_(y) * (b1[i] * rs);
        }
        *(u32x4*)(H + (size_t)row * DFF + lcol0) = pack8(a0, a1);
    }
};

__device__ __forceinline__ float dot8(u32x4 a, u32x4 b) {
    float s = blo(a.x) * blo(b.x); s += bhi(a.x) * bhi(b.x); s += blo(a.y) * blo(b.y); s += bhi(a.y) * bhi(b.y);
    s += blo(a.z) * blo(b.z); s += bhi(a.z) * bhi(b.z); s += blo(a.w) * blo(b.w); s += bhi(a.w) * bhi(b.w); return s;
}
__device__ __forceinline__ int pi32(int i) { return (i & 0x13) | ((i & 4) << 1) | ((i & 8) >> 1); }
template <class E> __global__ void __launch_bounds__(256) naive_gemm(const bf16_t* A, const bf16_t* Bt, E e, int lda, int ldb, int M, int N, int K, int pad) {
    const int lane = threadIdx.x & 63, i32 = lane & 31, hi = lane >> 5;
    const int nct = E::PAIRED ? (N / 256) * 4 : N / 32;
    const long w = (long)blockIdx.x * 4 + (threadIdx.x >> 6); if (w >= (long)(M / 32) * nct) return;
    const int mt = (int)(w / nct), ct = (int)(w % nct), row0 = mt * 32;
    const int pcol = E::PAIRED ? (ct >> 2) * 256 + (ct & 3) * 32 : ct * 32, lcol = E::PAIRED ? (ct >> 2) * 128 + (ct & 3) * 32 : pcol;
    const bf16_t* ap = A + (size_t)(row0 + i32) * lda + 8 * hi;
    const bf16_t* bp = Bt + (size_t)(pcol + pi32(i32)) * ldb + 8 * hi;
    f32x16 acc, acc2;
#pragma unroll
    for (int r = 0; r < 16; ++r) { acc[r] = 0.f; acc2[r] = 0.f; }
    for (int k = 0; k < K; k += 16) {
        const bf16x8 af = *(const bf16x8*)(ap + k), bf = *(const bf16x8*)(bp + k);
        acc = __builtin_amdgcn_mfma_f32_32x32x16_bf16(bf, af, acc, 0, 0, 0);
        if constexpr (E::PAIRED) { const bf16x8 bf2 = *(const bf16x8*)(bp + (size_t)128 * ldb + k); acc2 = __builtin_amdgcn_mfma_f32_32x32x16_bf16(bf2, af, acc2, 0, 0, 0); }
    }
    const int row = row0 + i32;
#pragma unroll
    for (int hf = 0; hf < 2; ++hf) {
        const f32x4 a = {acc[8 * hf], acc[8 * hf + 1], acc[8 * hf + 2], acc[8 * hf + 3]}, b = {acc[8 * hf + 4], acc[8 * hf + 5], acc[8 * hf + 6], acc[8 * hf + 7]};
        if constexpr (E::PAIRED) { const f32x4 c = {acc2[8 * hf], acc2[8 * hf + 1], acc2[8 * hf + 2], acc2[8 * hf + 3]}, d = {acc2[8 * hf + 4], acc2[8 * hf + 5], acc2[8 * hf + 6], acc2[8 * hf + 7]};
            e.apply2(row, lcol + 16 * hf + 8 * hi, a, b, c, d); }
        else { const float sp = e.apply(row, lcol + 16 * hf + 8 * hi, a, b); float* tg = e.target(row, lcol + 16 * hf + 8 * hi); if (tg) atomicAdd(tg, sp); }
    }
}

struct AttnConsts { float Mfix, lam, osc; };
__device__ __forceinline__ AttnConsts attn_consts(const float* gq, const float* gk, const float* lv, int layer, int lane) {
    AttnConsts c;
    const float mq = wave_max(fabsf(gq[lane])), mk = wave_max(fabsf(gk[lane]));
    c.Mfix = 8.f * mq * mk * LOG2E;
    const float s1 = wave_sum(lv[lane] * lv[64 + lane]), s2 = wave_sum(lv[128 + lane] * lv[192 + lane]);
    const float lam_init = 0.8f - 0.6f * expf(-0.3f * (float)layer);
    c.lam = expf(s1) - expf(s2) + lam_init; c.osc = 1.f - lam_init;
    return c;
}
__device__ __forceinline__ float xattn_shift(const float* gq, const float* gk, int lane) {
    float m = 0.f;
#pragma unroll
    for (int j = 0; j < 4; ++j) m = fmaxf(m, fabsf(gq[lane + 64 * j] * gk[lane + 64 * j]));
    return 16.f * wave_max(m) * LOG2E;
}

__global__ void __launch_bounds__(256) naive_diff_attn(bf16_t* proj, const bf16_t* VT, const float* gq, const float* gk, const float* lv, const float* gsub, int layer, int pad) {
    __shared__ float sQ[2][32][65], sK[2][32][65], sV[32][129], sP[2][32][33];
    const int t = threadIdx.x, lane = t & 63;
    const AttnConsts ac = attn_consts(gq, gk, lv, layer, lane);
    const int qt = blockIdx.x & 255, bh = blockIdx.x >> 8, b = bh >> 3, h = bh & 7;
    const size_t rowbase = (size_t)b * SEQ; const int q0 = qt * 32;
    for (int i = t; i < 2 * 32 * 64; i += 256) { const int c = i >> 11, r = (i >> 6) & 31, d = i & 63;
        sQ[c][r][d] = blo(proj[(rowbase + q0 + r) * NP + C_DQ + h * 128 + c * 64 + d]); }
    const int c = t >> 7, qr = (t & 127) >> 2, g4 = t & 3;
    float o[32]; float l = 0.f;
#pragma unroll
    for (int i = 0; i < 32; ++i) o[i] = 0.f;
    for (int kt = 0; kt <= qt; ++kt) {
        const int kv0 = kt * 32;
        __syncthreads();
        for (int i = t; i < 2 * 32 * 64; i += 256) { const int cc = i >> 11, r = (i >> 6) & 31, d = i & 63;
            sK[cc][r][d] = blo(proj[(rowbase + kv0 + r) * NP + C_DK + h * 128 + cc * 64 + d]); }
        for (int i = t; i < 32 * 128; i += 256) { const int d = i >> 5, r = i & 31;
            sV[r][d] = blo(VT[(size_t)(h * 128 + d) * TOK + rowbase + kv0 + r]); }
        __syncthreads();
#pragma unroll
        for (int j = 0; j < 8; ++j) { const int kv = g4 * 8 + j; float s = 0.f;
            for (int d = 0; d < 64; ++d) s += sQ[c][qr][d] * sK[c][kv][d];
            float p = __builtin_amdgcn_exp2f(s - ac.Mfix); if (kv0 + kv > q0 + qr) p = 0.f;
            sP[c][qr][kv] = p; }
        __syncthreads();
        for (int kv = 0; kv < 32; ++kv) { const float p = sP[c][qr][kv]; l += p;
#pragma unroll
            for (int i = 0; i < 32; ++i) o[i] += p * sV[kv][g4 * 32 + i]; }
    }
    __syncthreads();
    const float inv = 1.f / l;
    if (c == 1) {
#pragma unroll
        for (int i = 0; i < 32; ++i) sV[qr][g4 * 32 + i] = o[i] * inv; }
    __syncthreads();
    if (c == 0) {
        float ss = 0.f;
#pragma unroll
        for (int i = 0; i < 32; ++i) { o[i] = o[i] * inv - ac.lam * sV[qr][g4 * 32 + i]; ss += o[i] * o[i]; }
        ss += __shfl_xor(ss, 1); ss += __shfl_xor(ss, 2);
        const float rs = rs_of(ss, 1.f / 128) * ac.osc;
#pragma unroll
        for (int i = 0; i < 32; i += 2) {
            const int d = g4 * 32 + i;
            *(unsigned*)(proj + (rowbase + q0 + qr) * NP + C_OB + h * 128 + d) = pk2(o[i] * rs * gsub[d], o[i + 1] * rs * gsub[d + 1]);
        }
    }
}

namespace pg8 {
constexpr int BM = 256, BK = 64, HALF = 128, HTB = HALF * BK * 2, STAGE_BYTES = 8 * HTB, NXCD = 8, WGM = 8;
__host__ __device__ __forceinline__ int lds_byte(int r, int c) { const int st = (r >> 4) * 2 + (c >> 5), rr = r & 15, cc = c & 31, ob = rr * 64 + cc * 2; return st * 1024 + (ob ^ (((ob >> 9) & 1) << 5)); }
__host__ __device__ __forceinline__ void stage_rc(int b, int& R, int& C) { const int st = b / 1024, sb = b % 1024, swz = sb ^ (((sb >> 9) & 1) << 5); R = (st >> 1) * 16 + swz / 64; C = (st & 1) * 32 + (swz % 64) / 2; }
__host__ __device__ __forceinline__ int perm32(int rho) { const int n = rho >> 4, i = rho & 15; return 8 * (i >> 2) + 4 * n + (i & 3); }
struct Unit { int pm, pn, aoff, gi; };
struct Gemm { const bf16_t* A; const bf16_t* Bt; int M, N, K, lda, ldb; };
struct StaticOrder {
    int nM, nN, nwg, G, c;
    __device__ void init(int M, int N, int G_, int c_) { nM = M / BM; nN = N / BM; nwg = nM * nN; G = G_; c = c_; }
    __device__ bool next(int i, Unit& u) const {
        const long L = (long)i * G + c; if (L >= nwg || c >= G) return false;
        int wgid = (int)L; { const int q = nwg / NXCD, r = nwg % NXCD, xcd = wgid % NXCD, off = wgid / NXCD; wgid = (xcd < r ? xcd * (q + 1) : r * (q + 1) + (xcd - r) * q) + off; }
        const int nig = WGM * nN, gid = wgid / nig, fm = gid * WGM, gsz = (nM - fm) < WGM ? (nM - fm) : WGM;
        u.pm = fm + ((wgid % nig) % gsz); u.pn = (wgid % nig) / gsz; u.aoff = 0; u.gi = 0; return true;
    }
};
struct OneUnit { Unit u; bool valid; __device__ bool next(int i, Unit& o) const { if (i || !valid) return false; o = u; return true; } };

template <class F> struct EpiWrap {
    F f;
    __device__ __forceinline__ bool zero_after(const Unit&) const { return true; }
    __device__ __forceinline__ void operator()(f32x4 (&acc)[2][2][4][2], const Unit& u, int wr, int wc, int fr, int fq) const {
#pragma unroll
        for (int ai = 0; ai < 2; ++ai)
#pragma unroll
            for (int m = 0; m < 4; ++m) {
                const int row = u.pm * BM + ai * HALF + wr * 64 + m * 16 + fr;
                if constexpr (F::PAIRED) f.apply2(row, u.pn * 128 + wc * 32 + 8 * fq, acc[ai][0][m][0], acc[ai][0][m][1], acc[ai][1][m][0], acc[ai][1][m][1]);
                else {
                    float sp = 0.f;
#pragma unroll
                    for (int bj = 0; bj < 2; ++bj) sp += f.apply(row, u.pn * BM + bj * HALF + wc * 32 + 8 * fq, acc[ai][bj][m][0], acc[ai][bj][m][1]);
                    float* tg = f.target(row, u.pn * BM + wc * 32 + 8 * fq);
                    if (tg) { sp += swz_xor<16>(sp); sp = xor32_sum(sp); if (fq == 0) atomicAdd(tg, sp); }
                }
                if (m & 1) asm volatile("" ::: "memory");
            }
    }
};

struct ChainOrder {
    StaticOrder base;
    __device__ bool next(int j, Unit& u) const {
        const int i = j / 3, gi = j - 3 * i; Unit t;
        if (!base.next(i, t)) return false;
        u.pm = t.pm; u.pn = gi * 8 + t.pn; u.aoff = (gi == 0) ? C_CA : (gi == 1) ? C_OB : C_OC; u.gi = gi; return true;
    }
};
struct EpiChain {
    bf16_t* mg; const bf16_t* proj;
    __device__ __forceinline__ bool zero_after(const Unit& u) const { return u.gi == 2; }
    __device__ __forceinline__ void operator()(f32x4 (&acc)[2][2][4][2], const Unit& u, int wr, int wc, int fr, int fq) const {
        const int pn = u.pn & 7, gi = u.gi;
#pragma unroll
        for (int ai = 0; ai < 2; ++ai)
#pragma unroll
            for (int m = 0; m < 4; ++m) {
                const int row = u.pm * BM + ai * HALF + wr * 64 + m * 16 + fr;
#pragma unroll
                for (int bj = 0; bj < 2; ++bj) {
                    const int col0 = pn * BM + bj * HALF + wc * 32 + 8 * fq;
                    const bf16_t* gp = proj + (size_t)row * NP + C_G + gi * 2048 + col0;
                    f32x4 g0, g1; unpack8(*(const u32x4*)gp, g0, g1);
                    if (gi < 2) {
                        f32x4 n0, n1; unpack8(*(const u32x4*)(gp + 2048), n0, n1);
#pragma unroll
                        for (int i = 0; i < 4; ++i) { g0[i] *= __builtin_amdgcn_rcpf(fmaxf(n0[i], 1e-30f)); g1[i] *= __builtin_amdgcn_rcpf(fmaxf(n1[i], 1e-30f)); }
                        acc[ai][bj][m][0] *= g0; acc[ai][bj][m][1] *= g1;
                    } else {
                        *(u32x4*)(mg + (size_t)row * DM + col0) = pack8(acc[ai][bj][m][0] * g0, acc[ai][bj][m][1] * g1);
                    }
                }
                asm volatile("" ::: "memory");
            }
    }
};

template <class Epi, class Sched>
__device__ __forceinline__ void gemm_phase(LAS unsigned char* lds, const Gemm g, const Sched& S, const Epi& E, const int tid) {
    const int wid = __builtin_amdgcn_readfirstlane(tid >> 6), lane = tid & 63, wr = wid >> 2, wc = wid & 3, fr = lane & 15, fq = lane >> 4;
    const int K = g.K, nt = K / BK;
    unsigned voffA[2], voffB[2];
#pragma unroll
    for (int i = 0; i < 2; ++i) { int R, C; stage_rc(tid * 16 + i * 8192, R, C); const int Rb = (R & ~31) + perm32(R & 31);
        voffA[i] = (unsigned)(R * g.lda + C) * 2u; voffB[i] = (unsigned)(Rb * g.ldb + C) * 2u; }
    const size_t kstep = (size_t)(BK * 2);
    const size_t hstepA = (size_t)HALF * g.lda * 2, hstepB = (size_t)HALF * g.ldb * 2, tstepA = 2 * hstepA, tstepB = 2 * hstepB;
    const unsigned ldsw = (unsigned)wid * 1024u;
    const int aoff = lds_byte(wr * 64 + fr, fq * 8), boff = lds_byte(wc * 32 + fr, fq * 8);
#define PG8_SA(b, h) (((b) * 2 + (h)) * HTB)
#define PG8_SB(b, h) ((4 + (b) * 2 + (h)) * HTB)
#define PG8_STAGE(bufoff, gbase, voff) do { _Pragma("unroll") for (int _i = 0; _i < 2; ++_i) \
        __builtin_amdgcn_global_load_lds((const unsigned*)((const char*)(gbase) + (voff)[_i]), (LAS unsigned*)(lds + (bufoff) + ldsw + _i * 8192), 16, 0, 0); } while (0)
#define PG8_LDA(dst, b, h) do { _Pragma("unroll") for (int m = 0; m < 4; ++m) _Pragma("unroll") for (int k = 0; k < 2; ++k) dst[m][k] = *(const LAS bf16x8*)(lds + PG8_SA(b, h) + aoff + m * 2048 + k * 1024); } while (0)
#define PG8_LDB(dst, b, h) do { _Pragma("unroll") for (int n = 0; n < 2; ++n) _Pragma("unroll") for (int k = 0; k < 2; ++k) dst[n][k] = *(const LAS bf16x8*)(lds + PG8_SB(b, h) + boff + n * 2048 + k * 1024); } while (0)
#define PG8_MMA(ai, bj, At, Bt) do { __builtin_amdgcn_s_setprio(1); _Pragma("unroll") for (int m = 0; m < 4; ++m) _Pragma("unroll") for (int n = 0; n < 2; ++n) _Pragma("unroll") for (int k = 0; k < 2; ++k) \
        acc[ai][bj][m][n] = __builtin_amdgcn_mfma_f32_16x16x32_bf16(Bt[n][k], At[m][k], acc[ai][bj][m][n], 0, 0, 0); __builtin_amdgcn_s_setprio(0); } while (0)
#define PG8_WAIT_V(n) asm volatile("s_waitcnt vmcnt(" #n ")" ::: "memory")
#define PG8_WAIT_L(n) asm volatile("s_waitcnt lgkmcnt(" #n ")" ::: "memory")
#define PG8_BAR __builtin_amdgcn_s_barrier()
#define PG8_SCHED __builtin_amdgcn_sched_barrier(0)
    Unit cur, nxt; int ui = 0;
    if (!S.next(0, cur)) return;
    f32x4 acc[2][2][4][2];
#pragma unroll
    for (int a = 0; a < 2; ++a)
#pragma unroll
        for (int b = 0; b < 2; ++b)
#pragma unroll
            for (int m = 0; m < 4; ++m)
#pragma unroll
                for (int n = 0; n < 2; ++n) acc[a][b][m][n] = (f32x4){0.f, 0.f, 0.f, 0.f};
    bf16x8 At[4][2], B0[2][2], B1[2][2];
    const char* cA = (const char*)g.A + (size_t)cur.pm * tstepA + (size_t)cur.aoff * 2; const char* cB = (const char*)g.Bt + (size_t)cur.pn * tstepB;
    PG8_STAGE(PG8_SB(0, 0), cB, voffB); PG8_STAGE(PG8_SB(0, 1), cB + hstepB, voffB); PG8_STAGE(PG8_SA(0, 0), cA, voffA); PG8_STAGE(PG8_SA(0, 1), cA + hstepA, voffA);
    if (wr == 1) PG8_BAR;
    PG8_WAIT_V(2); PG8_BAR;
    PG8_STAGE(PG8_SB(1, 0), cB + kstep, voffB); PG8_STAGE(PG8_SA(1, 0), cA + kstep, voffA); PG8_STAGE(PG8_SB(1, 1), cB + hstepB + kstep, voffB);
    PG8_WAIT_V(6); PG8_BAR;
    for (;;) {
        const bool has_next = S.next(ui + 1, nxt);
        const char* nA = has_next ? (const char*)g.A + (size_t)nxt.pm * tstepA + (size_t)nxt.aoff * 2 : cA; const char* nB = has_next ? (const char*)g.Bt + (size_t)nxt.pn * tstepB : cB;
        for (int t = 0; t < nt; t += 2) {
            const bool last = (t == nt - 2);
            const char* a1 = cA + (size_t)(t + 1) * kstep;
            const char* a2 = last ? nA : cA + (size_t)(t + 2) * kstep; const char* b2 = last ? nB : cB + (size_t)(t + 2) * kstep;
            const char* a3 = a2 + kstep; const char* b3 = b2 + kstep;
            PG8_LDB(B0, 0, 0); PG8_LDB(B1, 0, 1); PG8_SCHED; PG8_LDA(At, 0, 0); PG8_STAGE(PG8_SA(1, 1), a1 + hstepA, voffA);
            PG8_WAIT_V(8); PG8_WAIT_L(0); PG8_BAR; PG8_MMA(0, 0, At, B0); PG8_MMA(0, 1, At, B1); PG8_BAR; PG8_SCHED;
            PG8_LDA(At, 0, 1); PG8_STAGE(PG8_SB(0, 0), b2, voffB); PG8_STAGE(PG8_SB(0, 1), b2 + hstepB, voffB); PG8_STAGE(PG8_SA(0, 0), a2, voffA);
            PG8_WAIT_V(8); PG8_WAIT_L(0); PG8_BAR; PG8_MMA(1, 0, At, B0); PG8_MMA(1, 1, At, B1); PG8_BAR; PG8_SCHED;
            PG8_LDB(B0, 1, 0); PG8_LDB(B1, 1, 1); PG8_SCHED; PG8_LDA(At, 1, 0); PG8_STAGE(PG8_SA(0, 1), a2 + hstepA, voffA);
            PG8_WAIT_V(8); PG8_WAIT_L(0); PG8_BAR; PG8_MMA(0, 0, At, B0); PG8_MMA(0, 1, At, B1); PG8_BAR; PG8_SCHED;
            PG8_LDA(At, 1, 1); PG8_STAGE(PG8_SB(1, 0), b3, voffB); PG8_STAGE(PG8_SB(1, 1), b3 + hstepB, voffB); PG8_STAGE(PG8_SA(1, 0), a3, voffA);
            PG8_WAIT_V(8); PG8_WAIT_L(0); PG8_BAR; PG8_MMA(1, 0, At, B0); PG8_MMA(1, 1, At, B1); PG8_BAR; PG8_SCHED;
        }
        if (wr == 0) PG8_BAR;
        E(acc, cur, wr, wc, fr, fq);
        if (!has_next) break;
        if (E.zero_after(cur))
#pragma unroll
        for (int a = 0; a < 2; ++a)
#pragma unroll
            for (int b = 0; b < 2; ++b)
#pragma unroll
                for (int m = 0; m < 4; ++m)
#pragma unroll
                    for (int n = 0; n < 2; ++n) acc[a][b][m][n] = (f32x4){0.f, 0.f, 0.f, 0.f};
        cur = nxt; cA = nA; cB = nB; ++ui;
        if (wr == 1) PG8_BAR;
    }
    PG8_WAIT_V(0);
    PG8_BAR;
#undef PG8_SA
#undef PG8_SB
#undef PG8_STAGE
#undef PG8_LDA
#undef PG8_LDB
#undef PG8_MMA
#undef PG8_WAIT_V
#undef PG8_WAIT_L
#undef PG8_BAR
#undef PG8_SCHED
}
}

__device__ __forceinline__ void glds16(const void* gsrc, unsigned lds_dst) { unsigned keep;
    asm volatile("s_mov_b32 %0, m0\n\ts_mov_b32 m0, %2\n\ts_nop 0\n\tglobal_load_lds_dwordx4 %1, off\n\ts_mov_b32 m0, %0" : "=&s"(keep) : "v"(gsrc), "s"(lds_dst) : "memory"); }
constexpr int ATT_LDS = 65536;
template <bool NOSHIFT> __device__ __forceinline__ void diff_attn_unit(LAS unsigned char* lds, bf16_t* proj, const bf16_t* VT, int b, int h, int qb, const AttnConsts ac, const float* gsub, const int tid, bf16_t* obuf, int opitch, int ocol) {
    const int lane = tid & 63, wid = __builtin_amdgcn_readfirstlane(tid >> 6), wq = wid & 3, c = wid >> 2, i32 = lane & 31, hi = lane >> 5;
    const size_t rowbase = (size_t)b * SEQ; const int q0 = qb * 128, qrow = q0 + 32 * wq + i32;
    bf16x8 qf[4];
    { const bf16_t* qp = proj + (rowbase + qrow) * NP + C_DQ + h * 128 + c * 64 + hi * 8;
#pragma unroll
      for (int ks = 0; ks < 4; ++ks) qf[ks] = *(const bf16x8*)(qp + 16 * ks); }
    const unsigned lds0 = (unsigned)(uintptr_t)lds;
    const int krow_s = 4 * wid + (lane >> 4), vd_s = 8 * wid + (lane >> 3);
    const bf16_t* kg = proj + (rowbase + krow_s) * NP + C_DK + h * 128 + (((lane & 15) ^ (krow_s & 15)) * 8);
    const bf16_t* vg = VT + (size_t)(h * 128 + vd_s) * TOK + rowbase + (((lane & 7) ^ ((vd_s >> 1) & 7)) * 8);
    const unsigned kdst = lds0 + wid * 1024, vdst = lds0 + 65536 + wid * 1024;
#define ATT_ISSUE(tt) do { const unsigned so_ = ((tt) & 3) * 16384; const bf16_t* kp_ = kg + (size_t)(tt) * 64 * NP; const bf16_t* vp_ = vg + (size_t)(tt) * 64; \
        glds16(kp_, (unsigned)__builtin_amdgcn_readfirstlane(kdst + so_)); glds16(kp_ + (size_t)32 * NP, (unsigned)__builtin_amdgcn_readfirstlane(kdst + so_ + 8192)); \
        glds16(vp_, (unsigned)__builtin_amdgcn_readfirstlane(vdst + so_)); glds16(vp_ + (size_t)64 * TOK, (unsigned)__builtin_amdgcn_readfirstlane(vdst + so_ + 8192)); } while (0)
#define ATT_WAITBAR(N) asm volatile("s_waitcnt vmcnt(" #N ") lgkmcnt(0)\n\ts_barrier" ::: "memory")
    const int krow = pi32(i32);
    int koff[2][4];
#pragma unroll
    for (int mt = 0; mt < 2; ++mt)
#pragma unroll
        for (int ks = 0; ks < 4; ++ks) { const int r = 32 * mt + krow; koff[mt][ks] = r * 256 + (((8 * c + 2 * ks + hi) ^ (r & 15)) * 16); }
    const int NT = 2 * qb + 2;
    f32x16 o[4];
#pragma unroll
    for (int dt = 0; dt < 4; ++dt)
#pragma unroll
        for (int r = 0; r < 16; ++r) o[dt][r] = 0.f;
    float l = 0.f;
    bf16x8 pf[4];
#pragma unroll
    for (int kk = 0; kk < 4; ++kk) pf[kk] = (bf16x8){0, 0, 0, 0, 0, 0, 0, 0};
    const int qmax = q0 + 32 * wq + 31;
#define ATT_LDV(dst, slot, kk) do { _Pragma("unroll") for (int dt = 0; dt < 4; ++dt) { const int d = 32 * dt + i32; \
        dst[dt] = *(const LAS bf16x8*)(lds + 65536 + (slot) + d * 128 + (((2 * (kk) + hi) ^ ((d >> 1) & 7)) * 16)); } } while (0)
#define ATT_MMV(src, kk) do { __builtin_amdgcn_s_setprio(1); _Pragma("unroll") for (int dt = 0; dt < 4; ++dt) o[dt] = __builtin_amdgcn_mfma_f32_32x32x16_bf16(src[dt], pf[kk], o[dt], 0, 0, 0); __builtin_amdgcn_s_setprio(0); } while (0)
#define ATT_SB __builtin_amdgcn_sched_barrier(0)
#define ATT_PV(slot) do { bf16x8 va[4], vb[4]; ATT_LDV(va, slot, 0); ATT_SB; ATT_LDV(vb, slot, 1); ATT_SB; ATT_MMV(va, 0); ATT_SB; ATT_LDV(va, slot, 2); ATT_SB; ATT_MMV(vb, 1); ATT_SB; \
        ATT_LDV(vb, slot, 3); ATT_SB; ATT_MMV(va, 2); ATT_SB; ATT_MMV(vb, 3); ATT_SB; } while (0)
    ATT_ISSUE(0); ATT_ISSUE(1);
    ATT_WAITBAR(4);
    for (int t = 0; t < NT; ++t) {
        const int bo = (t & 3) * 16384, sl_cur = bo, sl_prev = ((t - 1) & 3) * 16384;
        if (t + 2 < NT) ATT_ISSUE(t + 2);
        const int kv0 = 64 * t;
        if (c == 1 && t >= 1 && kv0 - 64 <= qmax) ATT_PV(sl_prev);
        if (kv0 <= qmax) {
            f32x16 p[2];
            bf16x8 kf[2][4];
#pragma unroll
            for (int mt = 0; mt < 2; ++mt)
#pragma unroll
                for (int ks = 0; ks < 4; ++ks) kf[mt][ks] = *(const LAS bf16x8*)(lds + bo + koff[mt][ks]);
            if constexpr (!NOSHIFT) {
#pragma unroll
                for (int mt = 0; mt < 2; ++mt)
#pragma unroll
                    for (int r = 0; r < 16; ++r) p[mt][r] = -ac.Mfix;
            }
            ATT_SB;
            __builtin_amdgcn_s_setprio(1);
#pragma unroll
            for (int ks = 0; ks < 4; ++ks)
#pragma unroll
                for (int mt = 0; mt < 2; ++mt) {
                    if (NOSHIFT && ks == 0) { const f32x16 z = {0.f, 0.f, 0.f, 0.f, 0.f, 0.f, 0.f, 0.f, 0.f, 0.f, 0.f, 0.f, 0.f, 0.f, 0.f, 0.f}; p[mt] = __builtin_amdgcn_mfma_f32_32x32x16_bf16(kf[mt][ks], qf[ks], z, 0, 0, 0); }
                    else p[mt] = __builtin_amdgcn_mfma_f32_32x32x16_bf16(kf[mt][ks], qf[ks], p[mt], 0, 0, 0);
                }
            __builtin_amdgcn_s_setprio(0);
            ATT_SB;
            const bool diag = (t >= 2 * qb);
            if (diag) {
                const int qrel = qrow - kv0 - 8 * hi;
#pragma unroll
                for (int mt = 0; mt < 2; ++mt)
#pragma unroll
                    for (int r = 0; r < 16; ++r) { float v = __builtin_amdgcn_exp2f(p[mt][r]); if (32 * mt + 16 * (r >> 3) + (r & 7) > qrel) v = 0.f; p[mt][r] = v; l += v; }
            } else {
#pragma unroll
                for (int mt = 0; mt < 2; ++mt)
#pragma unroll
                    for (int r = 0; r < 16; ++r) { const float v = __builtin_amdgcn_exp2f(p[mt][r]); p[mt][r] = v; l += v; }
            }
            asm volatile("" ::: "memory");
#pragma unroll
            for (int kk = 0; kk < 4; ++kk) { const int mt = kk >> 1, r0 = 8 * (kk & 1); u32x4 w;
                w.x = pk2(p[mt][r0], p[mt][r0 + 1]); w.y = pk2(p[mt][r0 + 2], p[mt][r0 + 3]); w.z = pk2(p[mt][r0 + 4], p[mt][r0 + 5]); w.w = pk2(p[mt][r0 + 6], p[mt][r0 + 7]);
                pf[kk] = __builtin_bit_cast(bf16x8, w); }
            if (c == 0) ATT_PV(sl_cur);
        }
        if (t + 2 < NT) ATT_WAITBAR(4); else ATT_WAITBAR(0);
    }
    if (c == 1 && 64 * (NT - 1) <= qmax) ATT_PV(((NT - 1) & 3) * 16384);
#undef ATT_ISSUE
#undef ATT_WAITBAR
#undef ATT_PV
#undef ATT_LDV
#undef ATT_MMV
#undef ATT_SB
    l = xor32_sum(l);
    const float inv = 1.f / l;
    LAS float* xch = (LAS float*)lds + (size_t)wq * 4096 + lane;
    if (c == 1) {
#pragma unroll
        for (int dt = 0; dt < 4; ++dt)
#pragma unroll
            for (int r = 0; r < 16; ++r) xch[(dt * 16 + r) * 64] = o[dt][r] * inv;
    }
    __syncthreads();
    if (c == 0) {
        float ss = 0.f;
#pragma unroll
        for (int dt = 0; dt < 4; ++dt)
#pragma unroll
            for (int r = 0; r < 16; ++r) { const float v = o[dt][r] * inv - ac.lam * xch[(dt * 16 + r) * 64]; o[dt][r] = v; ss += v * v; }
        ss = xor32_sum(ss);
        const float rs = rs_of(ss, 1.f / 128) * ac.osc;
        bf16_t* op = obuf + (rowbase + qrow) * opitch + ocol + h * 128;
#pragma unroll
        for (int dt = 0; dt < 4; ++dt)
#pragma unroll
            for (int rg = 0; rg < 4; ++rg) { const int d = 32 * dt + 8 * rg + 4 * hi; const f32x4 g = *(const f32x4*)(gsub + d);
                u32x2 w; w.x = pk2(o[dt][4 * rg] * rs * g.x, o[dt][4 * rg + 1] * rs * g.y); w.y = pk2(o[dt][4 * rg + 2] * rs * g.z, o[dt][4 * rg + 3] * rs * g.w);
                *(u32x2*)(op + d) = w; }
    }
    __syncthreads();
}

__device__ __forceinline__ int maprow(int mode, int n) {
    if (mode == 1) { if (n < 5120) return n; if (n < 6144) return 12288 + (n - 5120); if (n < 7168) return 5120 + (n - 6144); return 6144 + (n - 7168); }
    if (mode == 2) { if (n < DFF) return (n >> 7) * 256 + (n & 127); const int m = n - DFF; return (m >> 7) * 256 + 128 + (m & 127); }
    return n;
}
__device__ __forceinline__ void conv_item(const float* W, int K, int N, bf16_t* Wt, const float* g, int mode, int item, int lane) {
    const int nkc = K >> 7, nb = item / nkc, kc = item - nb * nkc, n0 = nb * 64, k0 = kc * 128, kgp = lane >> 4, nq = lane & 15;
    const int drow = maprow(mode, n0) + 4 * nq;
#pragma unroll
    for (int it = 0; it < 4; ++it) {
        const int kb = k0 + it * 32 + kgp * 8;
        f32x4 v[8];
#pragma unroll
        for (int j = 0; j < 8; ++j) v[j] = *(const f32x4*)(W + (size_t)(kb + j) * N + n0 + 4 * nq);
        if (g) {
            const f32x4 g0 = *(const f32x4*)(g + kb), g1 = *(const f32x4*)(g + kb + 4);
#pragma unroll
            for (int j = 0; j < 4; ++j) { v[j] *= g0[j]; v[4 + j] *= g1[j]; }
        }
#pragma unroll
        for (int i = 0; i < 4; ++i) {
            u32x4 o; o.x = pk2(v[0][i], v[1][i]); o.y = pk2(v[2][i], v[3][i]); o.z = pk2(v[4][i], v[5][i]); o.w = pk2(v[6][i], v[7][i]);
            *(u32x4*)(Wt + (size_t)(drow + i) * K + kb) = o;
        }
    }
}
__device__ __forceinline__ void row_to_bf16(const float* xr, bf16_t* orow, float* ssout, int lane) {
    float s = 0.f;
#pragma unroll
    for (int j = 0; j < 8; ++j) { const f32x4 v = *(const f32x4*)(xr + 4 * lane + 256 * j); s += sum4(v * v);
        u32x2 w; w.x = pk2(v.x, v.y); w.y = pk2(v.z, v.w); *(u32x2*)(orow + 4 * lane + 256 * j) = w; }
    s = wave_sum(s);
    if (lane == 0) *ssout = s;
}

#define XB_TMO      128
#define XB_XCNT(j)  (256  + 64 * (j))
#define XB_XSUB(j)  (1280 + 64 * (j))
#define XB_XGEN(j)  (2304 + 64 * (j))
#define XB_TOP      3328
#define XB_TOPGEN   3392
#define XCD_BAR_WORDS 3456
#define XB_SPIN_CAP (1u << 18)
__device__ __forceinline__ unsigned xb_ld(unsigned* p)              { return __hip_atomic_load(p, __ATOMIC_RELAXED, __HIP_MEMORY_SCOPE_AGENT); }
__device__ __forceinline__ unsigned xb_add(unsigned* p, unsigned v) { return __hip_atomic_fetch_add(p, v, __ATOMIC_RELAXED, __HIP_MEMORY_SCOPE_AGENT); }
__device__ __forceinline__ unsigned xb_xcc_id() { return (unsigned)__builtin_amdgcn_s_getreg((3 << 11) | 20) & 0xFu; }
#define XB_SPIN(cond, bar) do { unsigned _sp = 0; while (cond) { __builtin_amdgcn_s_sleep(1); \
    if ((++_sp & 255u) == 0u) { if (xb_ld(&(bar)[XB_TMO])) break; if (_sp > XB_SPIN_CAP) { atomicAdd(&(bar)[XB_TMO], 1u); break; } } } } while (0)
struct XcdBarrier { unsigned* bar; unsigned x; volatile LAS unsigned* st; };
__device__ __forceinline__ XcdBarrier xcd_barrier_post(unsigned* bar, volatile LAS unsigned* st) {
    XcdBarrier b; b.bar = bar; b.x = xb_xcc_id(); b.st = st;
    if (threadIdx.x == 0) (void)xb_add(&bar[XB_XCNT(b.x)], 1u);
    return b;
}
__device__ __forceinline__ void xcd_barrier_complete(unsigned* bar, unsigned x, unsigned& nloc, unsigned& nx) {
    const unsigned G = gridDim.x * gridDim.y * gridDim.z;
    unsigned sum, cnt, mine, sp = 0u;
    for (;;) {
        sum = 0u; cnt = 0u; mine = 0u;
#pragma unroll
        for (unsigned j = 0; j < 16; ++j) { const unsigned c = xb_ld(&bar[XB_XCNT(j)]); sum += c; cnt += (c > 0u) ? 1u : 0u; mine = (j == x) ? c : mine; }
        if (sum == G) break;
        __builtin_amdgcn_s_sleep(1);
        if ((++sp & 255u) == 0u) { if (xb_ld(&bar[XB_TMO])) break; if (sp > XB_SPIN_CAP) { atomicAdd(&bar[XB_TMO], 1u); break; } }
    }
    nloc = mine > 0u ? mine : 1u; nx = cnt > 0u ? cnt : 1u;
}
__device__ __forceinline__ void xcd_barrier(const XcdBarrier& b) {
    asm volatile("s_waitcnt vmcnt(0)" ::: "memory");
    __syncthreads();
    if (threadIdx.x == 0) {
        unsigned* bar = b.bar;
        __builtin_amdgcn_s_waitcnt(0);
        unsigned nloc = b.st[0], nx = b.st[1];
        if (nloc == 0u) { xcd_barrier_complete(bar, b.x, nloc, nx); b.st[0] = nloc; b.st[1] = nx; }
        const unsigned old = xb_add(&bar[XB_XSUB(b.x)], 1u);
        const unsigned gen = old / nloc;
        if (old + 1u == (gen + 1u) * nloc) {
            __builtin_amdgcn_fence(__ATOMIC_RELEASE, "agent");
            asm volatile("s_waitcnt vmcnt(0)" ::: "memory");
            const unsigned og = xb_add(&bar[XB_TOP], 1u);
            const unsigned tg = og / nx;
            if (og + 1u == (tg + 1u) * nx) xb_add(&bar[XB_TOPGEN], 1u);
            else XB_SPIN(xb_ld(&bar[XB_TOPGEN]) == tg, bar);
            __builtin_amdgcn_fence(__ATOMIC_ACQUIRE, "agent");
            xb_add(&bar[XB_XGEN(b.x)], 1u);
            asm volatile("s_waitcnt vmcnt(0)" ::: "memory");
        } else {
            XB_SPIN(xb_ld(&bar[XB_XGEN(b.x)]) == gen, bar);
            __builtin_amdgcn_fence(__ATOMIC_ACQUIRE, "agent");
            asm volatile("s_waitcnt vmcnt(0)" ::: "memory");
        }
    }
    __syncthreads();
}

struct Args { const void* in[21]; float* out; unsigned char* ws; int lo, hi, flags, pad; };
constexpr int NPHASE = 16;
constexpr int FL_SKIP_MEMKV = 1, FL_SKIP_ATTN = 2, FL_SKIP_CROSS = 4, FL_SKIP_MAIN = 8, FL_XCDBAR = 16;
constexpr int LDS_BYTES = pg8::STAGE_BYTES + 2048;
constexpr size_t WS_BAR = 1400 * KiB, WS_BAR_BYTES = 16 * KiB;

__global__ void __launch_bounds__(512, 2) mega(Args args) {
    extern __shared__ __attribute__((aligned(16))) unsigned char lds_raw[];
    LAS unsigned char* lds = (LAS unsigned char*)lds_raw;
    cg::grid_group grid = cg::this_grid();
    constexpr int G = 256;
    const int wave0 = __builtin_amdgcn_readfirstlane(threadIdx.x >> 6);
    volatile LAS unsigned* bst = (volatile LAS unsigned*)(lds + pg8::STAGE_BYTES + 1024);
    if (threadIdx.x < 2) bst[threadIdx.x] = 0u;
    __syncthreads();
    XcdBarrier xbar; xbar.bar = (unsigned*)(args.ws + WS_BAR); xbar.x = 0; xbar.st = bst;
    if (args.flags & FL_XCDBAR) xbar = xcd_barrier_post((unsigned*)(args.ws + WS_BAR), bst);
    for (int ph = args.lo; ph < args.hi; ++ph) {
        int bx_ = blockIdx.x; asm volatile("" : "+s"(bx_)); const int bx = bx_, vcu = (bx % 8) * (G / 8) + bx / 8;
        unsigned char* ws = args.ws; asm volatile("" : "+s"(ws));
        constexpr int NGW = G * 8;
        const float* x_in = (const float*)args.in[0]; const float* mem = (const float*)args.in[1]; const int* positions = (const int*)args.in[2];
        float* xcur = args.out;
        float* ssb = (float*)(ws + WS_SS); float* qssb = (float*)(ws + WS_QSS); float* lsumb = (float*)(ws + WS_LSUM); float* kssb = (float*)(ws + WS_KSS); float* ssmem = (float*)(ws + WS_SSMEM);
        float* cs = (float*)(ws + WS_CS); float* xsh = (float*)(ws + WS_XSH);
        bf16_t* memb = (bf16_t*)(ws + WS_MEMB); bf16_t* mkraw = (bf16_t*)(ws + WS_MKRAW); bf16_t* mvT = (bf16_t*)(ws + WS_MVT);
        bf16_t* Win_t = (bf16_t*)(ws + WS_WIN); bf16_t* Wc_t = (bf16_t*)(ws + WS_WC); bf16_t* Wd_t = (bf16_t*)(ws + WS_WD); bf16_t* Wx_t = (bf16_t*)(ws + WS_WX);
        bf16_t* Wmkv_t = (bf16_t*)(ws + WS_WMKV); bf16_t* Wo_t = (bf16_t*)(ws + WS_WO); bf16_t* Wgu_t = (bf16_t*)(ws + WS_WGU); bf16_t* Wdn_t = (bf16_t*)(ws + WS_WDN);
        bf16_t* proj = (bf16_t*)(ws + WS_PROJ); bf16_t* VT = (bf16_t*)(ws + WS_VT); bf16_t* xb = (bf16_t*)(ws + WS_XB); bf16_t* mg = (bf16_t*)(ws + WS_MG); bf16_t* hb = (bf16_t*)(ws + WS_H);

        const int l = ph >> 3, p = ph & 7;
        const int wave = wave0, gw = vcu * 8 + wave;
#define PHASE_TID() const int tid = phase_tid(wave0), lane = tid & 63
        const float* gq_x = (const float*)args.in[14] + l * 256; const float* gk_x = (const float*)args.in[15] + l * 256;
        float* qss = qssb + (size_t)l * TOK * 4; float* lsum = lsumb + (size_t)l * TOK * 4; float* kss = kssb + l * 2048;
        if (p == 0) {
            PHASE_TID();
            const float* g_mix = (const float*)args.in[3] + l * DM; const float* g_mem = (const float*)args.in[12] + l * DM; const float* g_ffn = (const float*)args.in[18] + l * DM;
            const float* w_in = (const float*)args.in[4] + (size_t)l * DM * NIN; const float* w_co = (const float*)args.in[6] + (size_t)l * 1024 * DM;
            const float* w_do = (const float*)args.in[11] + (size_t)l * 1024 * DM; const float* w_mkv = (const float*)args.in[13] + (size_t)l * DM * 2048;
            const float* w_xo = (const float*)args.in[16] + (size_t)l * 1024 * DM; const float* w_o = (const float*)args.in[17] + (size_t)l * DM * DM;
            const float* w_gu = (const float*)args.in[19] + (size_t)l * DM * 2 * DFF; const float* w_dn = (const float*)args.in[20] + (size_t)l * DFF * DM;
            constexpr int I_IN = (NIN / 64) * (DM / 128), I_B = (DM / 64) * (1024 / 128), I_SQ = (DM / 64) * (DM / 128), I_GU = (2 * DFF / 64) * (DM / 128), I_DN = (DM / 64) * (DFF / 128);
            constexpr int NIT = I_IN + 3 * I_B + 2 * I_SQ + I_GU + I_DN;
#pragma unroll 1
            for (int rep = 0; rep < REP_P0; ++rep)
            for (int it = gw; it < NIT; it += NGW) {
                int r = it;
                if (r < I_IN) { conv_item(w_in, DM, NIN, Win_t, g_mix, 1, r, lane); continue; } r -= I_IN;
                if (r < I_GU) { conv_item(w_gu, DM, 2 * DFF, Wgu_t, g_ffn, 2, r, lane); continue; } r -= I_GU;
                if (r < I_DN) { conv_item(w_dn, DFF, DM, Wdn_t, nullptr, 0, r, lane); continue; } r -= I_DN;
                if (r < I_SQ) { conv_item(w_mkv, DM, 2048, Wmkv_t, g_mem, 0, r, lane); continue; } r -= I_SQ;
                if (r < I_SQ) { conv_item(w_o, DM, DM, Wo_t, nullptr, 0, r, lane); continue; } r -= I_SQ;
                if (r < I_B) { conv_item(w_co, 1024, DM, Wc_t, nullptr, 0, r, lane); continue; } r -= I_B;
                if (r < I_B) { conv_item(w_do, 1024, DM, Wd_t, nullptr, 0, r, lane); continue; } r -= I_B;
                conv_item(w_xo, 1024, DM, Wx_t, nullptr, 0, r, lane);
            }
            if (l == 0) {
                for (int m = gw; m < TOK; m += NGW) row_to_bf16(x_in + (size_t)m * DM, xb + (size_t)m * DM, ssb + m, lane);
                for (int m = gw; m < BATCH * MEMLEN; m += NGW) row_to_bf16(mem + (size_t)m * DM, memb + (size_t)m * DM, ssmem + m, lane);
                { unsigned* z = (unsigned*)(ws + WS_ZERO_LO); const int nz = (int)((WS_ZERO_HI - WS_ZERO_LO) / 4);
                  for (int i = bx * 512 + tid; i < nz; i += G * 512) z[i] = 0u; }
                for (int i = bx * 512 + tid; i < TOK * 8; i += G * 512) {
                    const int row = i >> 3, k = i & 7;
                    const float ang = (float)positions[row] * INVF[k];
                    const float kk = rintf(ang * 0.15915494309189535f);
                    float rr = fmaf(-kk, 6.2831854820251465f, ang); rr = fmaf(-kk, -1.7484556000744883e-07f, rr);
                    const float fr = rr * 0.15915494309189535f;
                    cs[row * 16 + k] = __builtin_amdgcn_cosf(fr); cs[row * 16 + 8 + k] = __builtin_amdgcn_sinf(fr);
                }
            }
        } else if (p == 1) {
            PHASE_TID();
            if (PH_EN(1) && !(args.flags & FL_SKIP_MAIN)) {
#pragma unroll 1
                for (int rep = 0; rep < REP_P1; ++rep)
                { pg8::Gemm g{xb, Win_t, TOK, NP, DM, DM, DM}; pg8::StaticOrder S; S.init(TOK, NP, G, bx);
                  pg8::EpiWrap<EIn> E{EIn{proj, ssb + (size_t)(2 * l) * TOK, gq_x, gk_x, rep == REP_P1 - 1 ? qss : nullptr}}; pg8::gemm_phase(lds, g, S, E, phase_tid(wave0)); }
                { pg8::Gemm g{Win_t + (size_t)NP * DM, xb, 1024, TOK, DM, DM, DM}; pg8::StaticOrder S; S.init(1024, TOK, G, bx);
                  pg8::EpiWrap<EColScale> E{EColScale{VT, ssb + (size_t)(2 * l) * TOK, TOK, 0}}; pg8::gemm_phase(lds, g, S, E, phase_tid(wave0)); }
            }
        } else if (p == 2) {
            PHASE_TID();
            const bool do_mkv = !(args.flags & FL_SKIP_MEMKV) && G >= 32;
            if (bx == G - 1 && wave == 0) { const float mx = xattn_shift(gq_x, gk_x, lane); if (lane == 0) xsh[l] = mx; }
#pragma unroll 1
            for (int rep2 = 0; rep2 < REP_P2; ++rep2) { const bool real2 = rep2 == REP_P2 - 1;
            if (PH_EN(2) && do_mkv && bx < 16) {
                if (bx < 8) { pg8::Gemm g{memb, Wmkv_t, 512, 1024, DM, DM, DM}; pg8::StaticOrder S; S.init(512, 1024, 8, bx);
                    pg8::EpiWrap<EMemK> E{EMemK{mkraw, ssmem, real2 ? kss : nullptr}}; pg8::gemm_phase(lds, g, S, E, phase_tid(wave0)); }
                else { pg8::Gemm g{Wmkv_t + (size_t)1024 * DM, memb, 1024, 512, DM, DM, DM}; pg8::StaticOrder S; S.init(1024, 512, 8, bx - 8);
                    pg8::EpiWrap<EColScale> E{EColScale{mvT, ssmem, 512, 0}}; pg8::gemm_phase(lds, g, S, E, phase_tid(wave0)); }
            } else {
                const int nb0 = do_mkv ? 16 : 0, NW2 = (G - nb0) * 8, gw2 = (bx - nb0) * 8 + wave;
                const float* gqd = (const float*)args.in[7] + l * 64; const float* gkd = (const float*)args.in[8] + l * 64; const float* cw = (const float*)args.in[5] + l * 3 * 1024;
#pragma unroll 1
                for (int base = gw2; base < 2 * TOK; base += 4 * NW2) {
                    u32x4 wv[4][2];
#pragma unroll
                    for (int j4 = 0; j4 < 4; ++j4) { const int tk = min(base + j4 * NW2, 2 * TOK - 1);
                        const bf16_t* pp = proj + (size_t)(tk >> 1) * NP + ((tk & 1) ? C_DK : C_DQ) + lane * 16; wv[j4][0] = *(const u32x4*)pp; wv[j4][1] = *(const u32x4*)(pp + 8); }
#pragma unroll
                    for (int j4 = 0; j4 < 4; ++j4) { const int tk = base + j4 * NW2;
                        if (tk < 2 * TOK) {
                            const int row = tk >> 1, which = tk & 1, j = lane & 3;
                            bf16_t* pp = proj + (size_t)row * NP + (which ? C_DK : C_DQ) + lane * 16;
                            f32x4 f0, f1, f2, f3; unpack8(wv[j4][0], f0, f1); unpack8(wv[j4][1], f2, f3);
                            float ss = sum4(f0 * f0) + sum4(f1 * f1) + sum4(f2 * f2) + sum4(f3 * f3);
                            ss += swz_xor<1>(ss); ss += swz_xor<2>(ss);
                            const float rs = rs_of(ss, 1.f / 64);
                            const float* gg = (which ? gkd : gqd) + 16 * j;
                            f0 *= *(const f32x4*)gg * rs; f1 *= *(const f32x4*)(gg + 4) * rs; f2 *= *(const f32x4*)(gg + 8) * rs; f3 *= *(const f32x4*)(gg + 12) * rs;
                            if (j == 0) {
                                const float* cr = cs + (size_t)row * 16;
                                const f32x4 c0 = *(const f32x4*)cr, c1 = *(const f32x4*)(cr + 4), s0 = *(const f32x4*)(cr + 8), s1 = *(const f32x4*)(cr + 12);
                                const f32x4 a0 = f0 * c0 - f2 * s0, a1 = f1 * c1 - f3 * s1, b0 = f2 * c0 + f0 * s0, b1 = f3 * c1 + f1 * s1;
                                f0 = a0; f1 = a1; f2 = b0; f3 = b1;
                            }
                            if (!which) { const float sc = 0.125f * LOG2E; f0 *= sc; f1 *= sc; f2 *= sc; f3 *= sc; }
                            bf16_t* po = real2 ? pp : mg + (size_t)row * DM + lane * 16; *(u32x4*)po = pack8(f0, f1); *(u32x4*)(po + 8) = pack8(f2, f3);
                        } }
                }
#pragma unroll 1
                for (int base = gw2; base < 2 * TOK; base += 2 * NW2) {
                    u32x4 vc[2][3], vx[2][3], vb[2];
#pragma unroll
                    for (int j2 = 0; j2 < 2; ++j2) { const int tk = min(base + j2 * NW2, 2 * TOK - 1);
                        const int id = tk * 64 + lane, row = id >> 7, ch = (id & 127) * 8, sq = row & (SEQ - 1); const bf16_t* pr = proj + (size_t)row * NP;
#pragma unroll
                        for (int jj = 0; jj < 3; ++jj) { const bf16_t* q = pr - (size_t)((sq - 2 + jj >= 0) ? (2 - jj) : 0) * NP; vc[j2][jj] = *(const u32x4*)(q + C_CC + ch); vx[j2][jj] = *(const u32x4*)(q + C_CX + ch); }
                        vb[j2] = *(const u32x4*)(pr + C_CB + ch); }
#pragma unroll
                    for (int j2 = 0; j2 < 2; ++j2) { const int tk = base + j2 * NW2;
                        if (tk < 2 * TOK) { const int id = tk * 64 + lane, row = id >> 7, ch = (id & 127) * 8, sq = row & (SEQ - 1);
                            f32x4 u0 = {0.f, 0.f, 0.f, 0.f}, u1 = u0;
#pragma unroll
                            for (int jj = 0; jj < 3; ++jj) {
                                if (sq - 2 + jj >= 0) { f32x4 a0, a1, b0, b1; unpack8(vc[j2][jj], a0, a1); unpack8(vx[j2][jj], b0, b1);
                                    u0 += *(const f32x4*)(cw + jj * 1024 + ch) * (a0 * b0); u1 += *(const f32x4*)(cw + jj * 1024 + ch + 4) * (a1 * b1); } }
                            f32x4 g0, g1; unpack8(vb[j2], g0, g1);
                            *(u32x4*)(real2 ? proj + (size_t)row * NP + C_CA + ch : mg + (size_t)row * DM + 1024 + ch) = pack8(g0 * u0, g1 * u1);
                        } }
                }
            }
            }
        } else if (p == 3) {
            PHASE_TID();
            if (PH_EN(3) && !(args.flags & FL_SKIP_ATTN)) {
                const AttnConsts ac = attn_consts((const float*)args.in[7] + l * 64, (const float*)args.in[8] + l * 64, (const float*)args.in[9] + l * 256, l, lane);
                const float* gsub = (const float*)args.in[10] + l * 128;
#pragma unroll 1
                for (int rep = 0; rep < REP_ATTN; ++rep) {
                    const bool real = (rep == REP_ATTN - 1);
                    const int v = vcu, bh = v >> 4, s = v & 15;
#pragma unroll 1
                    for (int i = 0; i < 4; ++i) { const int qb = (i == 0) ? 63 - s : (i == 1) ? 32 + s : (i == 2) ? 31 - s : s;
                        if (ac.Mfix <= 40.f) diff_attn_unit<true>(lds, proj, VT, bh >> 3, bh & 7, qb, ac, gsub, phase_tid(wave0), real ? proj : mg, real ? NP : DM, real ? C_OB : 0);
                        else diff_attn_unit<false>(lds, proj, VT, bh >> 3, bh & 7, qb, ac, gsub, phase_tid(wave0), real ? proj : mg, real ? NP : DM, real ? C_OB : 0); }
                }
            }
            if (PH_EN(8) && !(args.flags & FL_SKIP_CROSS)) {
#pragma unroll 1
                for (int repx = 0; repx < REP_X; ++repx) {
                    const int u = bx; const bool realx = repx == REP_X - 1;
                    const int b = u >> 7, h = (u >> 5) & 3, qb = u & 31;
                    { pg8::Gemm g{proj + C_XQ + h * 256, mkraw + (size_t)(b * 256) * 1024 + h * 256, TOK, 256, 256, NP, 1024};
                      LAS float* rkl = (LAS float*)(lds + pg8::STAGE_BYTES);
                      if (tid < 256) rkl[tid] = rs_of(kss[(b * 256 + tid) * 4 + h], 1.f / 256);
                      __syncthreads();
                      pg8::OneUnit S{{b * 32 + qb, 0, 0, 0}, true}; pg8::EpiWrap<EXs<true>> E{EXs<true>{proj, qss, kss, realx ? lsum : nullptr, xsh + l, (unsigned)(uintptr_t)rkl, b, h, LOG2E / 16.f}}; pg8::gemm_phase(lds, g, S, E, phase_tid(wave0)); }
                    __threadfence(); __syncthreads();
                    { pg8::Gemm g{proj + C_P + h * 256, mvT + (size_t)(h * 256) * 512 + b * 256, TOK, 256, 256, NP, 512};
                      pg8::OneUnit S{{b * 32 + qb, 0, 0, 0}, true}; pg8::EpiWrap<EXo> E{EXo{proj, lsum, h, 0}}; pg8::gemm_phase(lds, g, S, E, phase_tid(wave0)); }
                }
            }
        } else if (p == 4) {
            PHASE_TID();
            if (PH_EN(4) && !(args.flags & FL_SKIP_MAIN)) {
#pragma unroll 1
                for (int rep = 0; rep < REP_P4; ++rep) {
                    pg8::Gemm g{proj, Wc_t, TOK, DM, 1024, NP, 1024}; pg8::ChainOrder S; S.base.init(TOK, DM, G, bx);
                    pg8::EpiChain E{mg, proj}; pg8::gemm_phase(lds, g, S, E, phase_tid(wave0));
                }
            }
        } else if (p == 5) {
            PHASE_TID();
            if (PH_EN(5) && !(args.flags & FL_SKIP_MAIN)) {
#pragma unroll 1
                for (int rep = 0; rep < REP_P5; ++rep) { const bool real = rep == REP_P5 - 1;
                pg8::Gemm g{mg, Wo_t, TOK, DM, DM, DM, DM}; pg8::StaticOrder S; S.init(TOK, DM, G, bx);
                pg8::EpiWrap<ERes> E{ERes{l == 0 ? x_in : xcur, real ? xcur : (float*)(ws + WS_PROJ + 192 * MiB), real ? xb : (bf16_t*)(ws + WS_PROJ + 320 * MiB), real ? ssb + (size_t)(2 * l + 1) * TOK : nullptr}}; pg8::gemm_phase(lds, g, S, E, phase_tid(wave0)); }
            }
        } else if (p == 6) {
            PHASE_TID();
            if (PH_EN(6) && !(args.flags & FL_SKIP_MAIN)) {
#pragma unroll 1
                for (int rep = 0; rep < REP_GU; ++rep) {
                pg8::Gemm g{xb, Wgu_t, TOK, 2 * DFF, DM, DM, DM}; pg8::StaticOrder S; S.init(TOK, 2 * DFF, G, bx);
                pg8::EpiWrap<EGU> E{EGU{hb, ssb + (size_t)(2 * l + 1) * TOK}}; pg8::gemm_phase(lds, g, S, E, phase_tid(wave0)); }
            }
        } else {
            PHASE_TID();
            if (PH_EN(7) && !(args.flags & FL_SKIP_MAIN)) {
#pragma unroll 1
                for (int rep = 0; rep < REP_P7; ++rep) { const bool real = rep == REP_P7 - 1;
                pg8::Gemm g{hb, Wdn_t, TOK, DM, DFF, DFF, DFF}; pg8::StaticOrder S; S.init(TOK, DM, G, bx);
                pg8::EpiWrap<ERes> E{ERes{xcur, real ? xcur : (float*)(ws + WS_PROJ + 192 * MiB), real ? xb : (bf16_t*)(ws + WS_PROJ + 320 * MiB), (real && l == 0) ? ssb + (size_t)2 * TOK : nullptr}}; pg8::gemm_phase(lds, g, S, E, phase_tid(wave0)); }
            }
        }
        if (ph + 1 < args.hi) { if (!(args.flags & FL_XCDBAR) || ph == args.lo) grid.sync(); else xcd_barrier(xbar); }
    }
}

template <class E> static void launch_naive(const bf16_t* A, int lda, const bf16_t* Bt, int ldb, int M, int N, int K, E e, hipStream_t st) {
    const size_t n = (size_t)(M / 32) * (E::PAIRED ? (N / 256) * 4 : N / 32);
    hipLaunchKernelGGL(naive_gemm<E>, dim3((unsigned)((n + 3) / 4)), dim3(256), 0, st, A, Bt, e, lda, ldb, M, N, K, 0);
}

extern "C" void kernel_launch(void* const* d_in, const int* in_sizes, int n_in, void* d_out, int out_size, void* d_ws, size_t ws_size, hipStream_t stream) {
    static int grid = 0;
    if (grid == 0) {
        if (n_in != 21 || out_size != TOK * DM || ws_size < WS_END) { fprintf(stderr, "kernel_launch: unexpected shapes / workspace (%d inputs, out %d, ws %zu < %zu)\n", n_in, out_size, ws_size, (size_t)WS_END); grid = -1; return; }
        int dev = 0, cus = 0, per_cu = 0;
        hipGetDevice(&dev); hipDeviceGetAttribute(&cus, hipDeviceAttributeMultiprocessorCount, dev);
        hipFuncSetAttribute((const void*)mega, hipFuncAttributeMaxDynamicSharedMemorySize, LDS_BYTES);
        hipOccupancyMaxActiveBlocksPerMultiprocessor(&per_cu, (const void*)mega, 512, LDS_BYTES);
        if (per_cu < 1) per_cu = 1;
        grid = cus * per_cu; if (grid > 256) grid = 256;
        if (grid != 256) { fprintf(stderr, "kernel_launch: needs 256 co-resident workgroups, got %d\n", grid); grid = -1; return; }
        (void)hipGetLastError();
    }
    if (grid < 0) return;
    unsigned char* ws = (unsigned char*)d_ws;
    Args a{};
    for (int i = 0; i < 21; ++i) a.in[i] = d_in[i];
    a.out = (float*)d_out; a.ws = ws;
    float* ssb = (float*)(ws + WS_SS); float* qssb = (float*)(ws + WS_QSS); float* lsumb = (float*)(ws + WS_LSUM); float* kssb = (float*)(ws + WS_KSS); float* ssmem = (float*)(ws + WS_SSMEM);
    bf16_t* memb = (bf16_t*)(ws + WS_MEMB); bf16_t* mkraw = (bf16_t*)(ws + WS_MKRAW); bf16_t* mvT = (bf16_t*)(ws + WS_MVT);
    bf16_t* Win_t = (bf16_t*)(ws + WS_WIN); bf16_t* Wc_t = (bf16_t*)(ws + WS_WC); bf16_t* Wd_t = (bf16_t*)(ws + WS_WD); bf16_t* Wx_t = (bf16_t*)(ws + WS_WX);
    bf16_t* Wmkv_t = (bf16_t*)(ws + WS_WMKV); bf16_t* Wo_t = (bf16_t*)(ws + WS_WO); bf16_t* Wgu_t = (bf16_t*)(ws + WS_WGU); bf16_t* Wdn_t = (bf16_t*)(ws + WS_WDN);
    bf16_t* proj = (bf16_t*)(ws + WS_PROJ); bf16_t* VT = (bf16_t*)(ws + WS_VT); bf16_t* xb = (bf16_t*)(ws + WS_XB); bf16_t* mg = (bf16_t*)(ws + WS_MG); bf16_t* hb = (bf16_t*)(ws + WS_H);
    const float* x_in = (const float*)d_in[0]; float* xcur = (float*)d_out;

    static Args store[NPHASE + 1]; int nco = 0;
    auto coop = [&](int lo, int hi, int flags) {
        a.lo = lo; a.hi = hi; a.flags = flags; store[nco] = a;
        void* kargs[] = {&store[nco]}; ++nco;
        hipError_t e = hipSuccess;
        if (hi - lo == 1) hipLaunchKernelGGL(mega, dim3(grid), dim3(512), LDS_BYTES, stream, store[nco - 1]);
        else e = hipLaunchCooperativeKernel((const void*)mega, dim3(grid), dim3(512), kargs, LDS_BYTES, stream);
        if (e != hipSuccess) fprintf(stderr, "cooperative launch failed: %s (grid %d)\n", hipGetErrorString(e), grid);
    };
    auto is_naive = [](int p) { return p != 0 && ((NAIVE_MASK >> p) & 1); };
    int ph = 0;
#ifndef STOP_PH
#define STOP_PH NPHASE
#endif
    while (ph < STOP_PH) {
        const int l = ph >> 3, p = ph & 7;
#ifndef SKIP_PH
#define SKIP_PH 0x0
#endif
        if ((SKIP_PH >> p) & 1) { ++ph; continue; }
        const bool cross_naive = (NAIVE_MASK >> 8) & 1;
        const bool pure_fast = !is_naive(p) && !(p == 3 && cross_naive);
        if (pure_fast) {
            int e = ph + 1;
            while (e < STOP_PH) { const int q = e & 7; if (is_naive(q) || (q == 3 && cross_naive)) break; ++e; }
            const bool whole = (ph == 0 && e == NPHASE);
            if (whole) (void)hipMemsetAsync(ws + WS_BAR, 0, WS_BAR_BYTES, stream);
            coop(ph, e, whole ? FL_XCDBAR : 0); ph = e; continue;
        }
        const float* gq_x = (const float*)d_in[14] + l * 256; const float* gk_x = (const float*)d_in[15] + l * 256;
        float* qss = qssb + (size_t)l * TOK * 4; float* lsum = lsumb + (size_t)l * TOK * 4; float* kss = kssb + l * 2048;
        const float* ss0 = ssb + (size_t)(2 * l) * TOK; float* ss1 = ssb + (size_t)(2 * l + 1) * TOK;
        if (p == 1) {
            launch_naive(xb, DM, Win_t, DM, TOK, NP, DM, EIn{proj, ss0, gq_x, gk_x, qss}, stream);
            launch_naive(Win_t + (size_t)NP * DM, DM, xb, DM, 1024, TOK, DM, EColScale{VT, ss0, TOK, 0}, stream);
        } else if (p == 2) {
            coop(ph, ph + 1, FL_SKIP_MEMKV);
            launch_naive(memb, DM, Wmkv_t, DM, 512, 1024, DM, EMemK{mkraw, ssmem, kss}, stream);
            launch_naive(Wmkv_t + (size_t)1024 * DM, DM, memb, DM, 1024, 512, DM, EColScale{mvT, ssmem, 512, 0}, stream);
        } else if (p == 3) {
            const bool attn_naive = is_naive(3);
            if (!attn_naive || !cross_naive) coop(ph, ph + 1, (attn_naive ? FL_SKIP_ATTN : 0) | (cross_naive ? FL_SKIP_CROSS : 0));
            if (attn_naive && !(DBG_SKIP & 1))
                hipLaunchKernelGGL(naive_diff_attn, dim3(16 * 256), dim3(256), 0, stream, proj, VT, (const float*)d_in[7] + l * 64, (const float*)d_in[8] + l * 64,
                                   (const float*)d_in[9] + l * 256, (const float*)d_in[10] + l * 128, l, 0);
            if (cross_naive && !(DBG_SKIP & 2)) {
                for (int b = 0; b < BATCH; ++b) for (int h = 0; h < 4; ++h) {
                    launch_naive(proj + (size_t)b * SEQ * NP + C_XQ + h * 256, NP, mkraw + (size_t)(b * 256) * 1024 + h * 256, 1024, SEQ, 256, 256,
                                 EXs<false>{proj + (size_t)b * SEQ * NP, qss + (size_t)b * SEQ * 4, kss, lsum + (size_t)b * SEQ * 4, (const float*)(ws + WS_XSH) + l, 0u, b, h, LOG2E / 16.f}, stream);
                }
                for (int b = 0; b < BATCH; ++b) for (int h = 0; h < 4; ++h) {
                    launch_naive(proj + (size_t)b * SEQ * NP + C_P + h * 256, NP, mvT + (size_t)(h * 256) * 512 + b * 256, 512, SEQ, 256, 256,
                                 EXo{proj + (size_t)b * SEQ * NP, lsum + (size_t)b * SEQ * 4, h, 0}, stream);
                }
            }
        } else if (p == 4) {
            launch_naive(proj + C_CA, NP, Wc_t, 1024, TOK, DM, 1024, EMerge{mg, proj, 0, 0}, stream);
            launch_naive(proj + C_OB, NP, Wd_t, 1024, TOK, DM, 1024, EMerge{mg, proj, 1, 0}, stream);
            launch_naive(proj + C_OC, NP, Wx_t, 1024, TOK, DM, 1024, EMerge{mg, proj, 2, 0}, stream);
        } else if (p == 5) {
            launch_naive(mg, DM, Wo_t, DM, TOK, DM, DM, ERes{l == 0 ? x_in : xcur, xcur, xb, ss1}, stream);
        } else if (p == 6) {
            launch_naive(xb, DM, Wgu_t, DM, TOK, 2 * DFF, DM, EGU{hb, ss1}, stream);
        } else if (p == 7) {
            launch_naive(hb, DFF, Wdn_t, DFF, TOK, DM, DFF, ERes{xcur, xcur, xb, l == 0 ? ssb + (size_t)2 * TOK : nullptr}, stream);
        }
        ++ph;
    }
}
```

```cpp
#include <hip/hip_runtime.h>
#include <hip/hip_cooperative_groups.h>
#include <cstdio>
#include <cstdint>
namespace cg = cooperative_groups;

#ifndef NAIVE_MASK
#define NAIVE_MASK 0x0
#endif

#ifndef REP_ATTN
#define REP_ATTN 1
#endif
#ifndef REP_P0
#define REP_P0 1
#endif
#ifndef REP_P1
#define REP_P1 1
#endif
#ifndef REP_P4
#define REP_P4 1
#endif
#ifndef REP_P5
#define REP_P5 1
#endif
#ifndef REP_P7
#define REP_P7 1
#endif
#ifndef REP_P2
#define REP_P2 1
#endif
#ifndef REP_X
#define REP_X 1
#endif
#ifndef REP_GU
#define REP_GU 1
#endif
#ifndef DBG_SKIP
#define DBG_SKIP 0
#endif
#ifndef EN_MASK
#define EN_MASK 0xFFFF
#endif
#define PH_EN(n) (((EN_MASK) >> (n)) & 1)
constexpr int BATCH = 2, SEQ = 8192, DM = 2048, TOK = BATCH * SEQ, NIN = 13312, NP = 12288, DFF = 5632, MEMLEN = 256, DEPTH = 2;
constexpr float EPS = 1e-6f, LOG2E = 1.4426950408889634f;
constexpr int C_CB = 0, C_CC = 1024, C_CX = 2048, C_DQ = 3072, C_DK = 4096, C_XQ = 5120, C_G = 6144;
constexpr int C_CA = 0, C_P = 1024, C_OC = 2048, C_OB = 3072;

typedef unsigned short bf16_t;
typedef float f32x4 __attribute__((ext_vector_type(4)));
typedef float f32x2 __attribute__((ext_vector_type(2)));
typedef float f32x16 __attribute__((ext_vector_type(16)));
typedef unsigned u32x4 __attribute__((ext_vector_type(4)));
typedef unsigned u32x2 __attribute__((ext_vector_type(2)));
typedef short bf16x8 __attribute__((ext_vector_type(8)));
typedef __bf16 bf16x2_t __attribute__((ext_vector_type(2)));
#define LAS __attribute__((address_space(3)))

constexpr size_t MiB = 1u << 20, KiB = 1024;
constexpr size_t WS_SS = 0, WS_QSS = 256 * KiB, WS_LSUM = 768 * KiB, WS_KSS = 1280 * KiB, WS_SSMEM = 1296 * KiB, WS_ZERO_LO = 64 * KiB, WS_ZERO_HI = 1296 * KiB;
constexpr size_t WS_XSH = 1300 * KiB;
constexpr size_t WS_CS = 2 * MiB, WS_MEMB = 4 * MiB, WS_MKRAW = 6 * MiB, WS_MVT = 7 * MiB;
constexpr size_t WS_WIN = 8 * MiB, WS_WC = 60 * MiB, WS_WD = 64 * MiB, WS_WX = 68 * MiB, WS_WMKV = 72 * MiB, WS_WO = 80 * MiB, WS_WGU = 88 * MiB, WS_WDN = 132 * MiB;
constexpr size_t WS_PROJ = 154 * MiB, WS_VT = 538 * MiB, WS_XB = 570 * MiB, WS_MG = 634 * MiB, WS_END = 698 * MiB;
constexpr size_t WS_H = WS_PROJ;

__device__ __forceinline__ unsigned pk2(float lo, float hi) { f32x2 v = {lo, hi}; bf16x2_t b = __builtin_convertvector(v, bf16x2_t); return __builtin_bit_cast(unsigned, b); }
__device__ __forceinline__ u32x4 pack8(f32x4 a, f32x4 b) { u32x4 w; w.x = pk2(a.x, a.y); w.y = pk2(a.z, a.w); w.z = pk2(b.x, b.y); w.w = pk2(b.z, b.w); return w; }
__device__ __forceinline__ float blo(unsigned w) { return __uint_as_float(w << 16); }
__device__ __forceinline__ float bhi(unsigned w) { return __uint_as_float(w & 0xffff0000u); }
__device__ __forceinline__ void unpack8(u32x4 w, f32x4& a, f32x4& b) { a = (f32x4){blo(w.x), bhi(w.x), blo(w.y), bhi(w.y)}; b = (f32x4){blo(w.z), bhi(w.z), blo(w.w), bhi(w.w)}; }
__device__ __forceinline__ int opaque(int v) { asm volatile("" : "+v"(v)); return v; }
__device__ __forceinline__ int phase_tid(int wave0) { int t; asm volatile("v_mbcnt_lo_u32_b32 %0, -1, 0\n\tv_mbcnt_hi_u32_b32 %0, -1, %0" : "=v"(t)); return t | (wave0 << 6); }
__device__ __forceinline__ float sum4(f32x4 v) { return (v.x + v.y) + (v.z + v.w); }
__device__ __forceinline__ float rs_of(float ss, float invn) { return rsqrtf(ss * invn + EPS); }
__constant__ float INVF[8] = {1.0f, 0.1939227432012558f, 0.03760603070259094f, 0.007292664609849453f, 0.0014142135623842478f, 0.00027424818836152554f, 5.3182957344688475e-05f, 1.0313385246263351e-05f};
__device__ __forceinline__ float xor32_sum(float v) { auto rr = __builtin_amdgcn_permlane32_swap(__float_as_uint(v), __float_as_uint(v), false, false); return __uint_as_float(rr[0]) + __uint_as_float(rr[1]); }
__device__ __forceinline__ float xor32_max(float v) { auto rr = __builtin_amdgcn_permlane32_swap(__float_as_uint(v), __float_as_uint(v), false, false); return fmaxf(__uint_as_float(rr[0]), __uint_as_float(rr[1])); }
template <int X> __device__ __forceinline__ float swz_xor(float v) { return __int_as_float(__builtin_amdgcn_ds_swizzle(__float_as_int(v), 0x1f | (X << 10))); }
__device__ __forceinline__ float wave_sum(float v) {
    v += swz_xor<1>(v); v += swz_xor<2>(v); v += swz_xor<4>(v); v += swz_xor<8>(v); v += swz_xor<16>(v); v = xor32_sum(v);
    return v;
}
__device__ __forceinline__ float wave_max(float v) {
    v = fmaxf(v, swz_xor<1>(v)); v = fmaxf(v, swz_xor<2>(v)); v = fmaxf(v, swz_xor<4>(v)); v = fmaxf(v, swz_xor<8>(v)); v = fmaxf(v, swz_xor<16>(v)); v = xor32_max(v);
    return v;
}
__device__ __forceinline__ float sigmoidf_(float v) { return __builtin_amdgcn_rcpf(1.f + __expf(-v)); }

struct EIn {
    static constexpr bool PAIRED = false;
    bf16_t* proj; const float* ss; const float* gq; const float* gk; float* qss;
    __device__ __forceinline__ float* target(int row, int col0) const { return (qss && col0 >= C_XQ && col0 < C_G) ? qss + row * 4 + ((col0 - C_XQ) >> 8) : nullptr; }
    __device__ __forceinline__ float rowscale(int row) const { return rs_of(ss[row], 1.f / DM); }
    __device__ __forceinline__ float apply(int row, int col0, f32x4 a, f32x4 b, float rs) const {
        a *= rs; b *= rs; float s = 0.f;
        if (col0 >= C_G) {
#pragma unroll
            for (int i = 0; i < 4; ++i) { a[i] = sigmoidf_(a[i]); b[i] = sigmoidf_(b[i]); }
        } else if (col0 >= C_XQ) {
            const int d = (col0 - C_XQ) & 255;
            s = sum4(a * a) + sum4(b * b);
            const f32x4 g0 = *(const f32x4*)(gq + d) * *(const f32x4*)(gk + d), g1 = *(const f32x4*)(gq + d + 4) * *(const f32x4*)(gk + d + 4);
            a *= g0; b *= g1;
        }
        *(u32x4*)(proj + (size_t)row * NP + col0) = pack8(a, b);
        return s;
    }
};
struct EColScale {
    static constexpr bool PAIRED = false;
    bf16_t* O; const float* ss; int ldc, pad;
    __device__ __forceinline__ float* target(int, int) const { return nullptr; }
    __device__ __forceinline__ float rowscale(int) const { return 1.f; }
    __device__ __forceinline__ float apply(int row, int col0, f32x4 a, f32x4 b, float) const {
        const f32x4 s0 = *(const f32x4*)(ss + col0), s1 = *(const f32x4*)(ss + col0 + 4);
#pragma unroll
        for (int i = 0; i < 4; ++i) { a[i] *= rs_of(s0[i], 1.f / DM); b[i] *= rs_of(s1[i], 1.f / DM); }
        *(u32x4*)(O + (size_t)row * ldc + col0) = pack8(a, b);
        return 0.f;
    }
};
struct EMemK {
    static constexpr bool PAIRED = false;
    bf16_t* O; const float* ssmem; float* kss;
    __device__ __forceinline__ float* target(int row, int col0) const { return kss ? kss + row * 4 + (col0 >> 8) : nullptr; }
    __device__ __forceinline__ float rowscale(int row) const { return rs_of(ssmem[row], 1.f / DM); }
    __device__ __forceinline__ float apply(int row, int col0, f32x4 a, f32x4 b, float rs) const {
        a *= rs; b *= rs;
        *(u32x4*)(O + (size_t)row * 1024 + col0) = pack8(a, b);
        return sum4(a * a) + sum4(b * b);
    }
};
template <bool LDSRK> struct EXs {
    static constexpr bool PAIRED = false;
    bf16_t* proj; const float* qss; const float* kss; float* lsum; const float* Mxp; unsigned rkl; int b, h; float c;
    __device__ __forceinline__ float* target(int row, int) const { return lsum ? lsum + row * 4 + h : nullptr; }
    __device__ __forceinline__ float rowscale(int row) const { return rs_of(qss[row * 4 + h], 1.f / 256) * c; }
    __device__ __forceinline__ float apply(int row, int col0, f32x4 a, f32x4 bb, float rq) const {
        const float Mx = __hip_atomic_load(Mxp, __ATOMIC_RELAXED, __HIP_MEMORY_SCOPE_AGENT);
        f32x4 k0, k1;
        if constexpr (LDSRK) { const LAS float* rk = (const LAS float*)rkl; k0 = *(const LAS f32x4*)(rk + col0); k1 = *(const LAS f32x4*)(rk + col0 + 4); }
        else {
#pragma unroll
            for (int i = 0; i < 4; ++i) { k0[i] = rs_of(kss[(b * 256 + col0 + i) * 4 + h], 1.f / 256); k1[i] = rs_of(kss[(b * 256 + col0 + 4 + i) * 4 + h], 1.f / 256); }
        }
        float s = 0.f;
#pragma unroll
        for (int i = 0; i < 4; ++i) {
            a[i] = __builtin_amdgcn_exp2f(a[i] * rq * k0[i] - Mx);
            bb[i] = __builtin_amdgcn_exp2f(bb[i] * rq * k1[i] - Mx);
            s += a[i] + bb[i];
        }
        *(u32x4*)(proj + (size_t)row * NP + C_P + h * 256 + col0) = pack8(a, bb);
        return s;
    }
};
struct EXo {
    static constexpr bool PAIRED = false;
    bf16_t* proj; const float* lsum; int h, pad;
    __device__ __forceinline__ float* target(int, int) const { return nullptr; }
    __device__ __forceinline__ float rowscale(int row) const { return 1.f / __hip_atomic_load(lsum + row * 4 + h, __ATOMIC_RELAXED, __HIP_MEMORY_SCOPE_AGENT); }
    __device__ __forceinline__ float apply(int row, int col0, f32x4 a, f32x4 b, float inv) const {
        a *= inv; b *= inv;
        *(u32x4*)(proj + (size_t)row * NP + C_OC + h * 256 + col0) = pack8(a, b);
        return 0.f;
    }
};
struct EMerge {
    static constexpr bool PAIRED = false;
    bf16_t* mg; const bf16_t* proj; int gi, pad;
    __device__ __forceinline__ float* target(int, int) const { return nullptr; }
    __device__ __forceinline__ float rowscale(int) const { return 1.f; }
    __device__ __forceinline__ float apply(int row, int col0, f32x4 a, f32x4 b, float) const {
        f32x4 g0, g1; unpack8(*(const u32x4*)(proj + (size_t)row * NP + C_G + gi * 2048 + col0), g0, g1);
        a *= g0; b *= g1;
        bf16_t* p = mg + (size_t)row * DM + col0;
        if (gi > 0) { f32x4 m0, m1; unpack8(*(const u32x4*)p, m0, m1); a += m0; b += m1; }
        *(u32x4*)p = pack8(a, b);
        return 0.f;
    }
};
struct ERes {
    static constexpr bool PAIRED = false;
    const float* xin; float* xout; bf16_t* xb; float* ssn;
    __device__ __forceinline__ float* target(int row, int) const { return ssn ? ssn + row : nullptr; }
    __device__ __forceinline__ float rowscale(int) const { return 1.f; }
    __device__ __forceinline__ float apply(int row, int col0, f32x4 a, f32x4 b, float) const {
        const size_t off = (size_t)row * DM + col0;
        a += *(const f32x4*)(xin + off); b += *(const f32x4*)(xin + off + 4);
        *(f32x4*)(xout + off) = a; *(f32x4*)(xout + off + 4) = b;
        *(u32x4*)(xb + off) = pack8(a, b);
        return sum4(a * a) + sum4(b * b);
    }
};
struct EGU {
    static constexpr bool PAIRED = true;
    bf16_t* H; const float* ss;
    __device__ __forceinline__ float rowscale(int row) const { return rs_of(ss[row], 1.f / DM); }
    __device__ __forceinline__ void apply2(int row, int lcol0, f32x4 a0, f32x4 a1, f32x4 b0, f32x4 b1, float rs) const {
#pragma unroll
        for (int i = 0; i < 4; ++i) {
            const float x = a0[i] * rs, y = a1[i] * rs;
            a0[i] = x * sigmoidf_(x) * (b0[i] * rs); a1[i] = y * sigmoidf_(y) * (b1[i] * rs);
        }
        *(u32x4*)(H + (size_t)row * DFF + lcol0) = pack8(a0, a1);
    }
};

__device__ __forceinline__ float dot8(u32x4 a, u32x4 b) {
    float s = blo(a.x) * blo(b.x); s += bhi(a.x) * bhi(b.x); s += blo(a.y) * blo(b.y); s += bhi(a.y) * bhi(b.y);
    s += blo(a.z) * blo(b.z); s += bhi(a.z) * bhi(b.z); s += blo(a.w) * blo(b.w); s += bhi(a.w) * bhi(b.w); return s;
}
__device__ __forceinline__ int pi32(int i) { return (i & 0x13) | ((i & 4) << 1) | ((i & 8) >> 1); }
template <class E> __global__ void __launch_bounds__(256) naive_gemm(const bf16_t* A, const bf16_t* Bt, E e, int lda, int ldb, int M, int N, int K, int pad) {
    const int lane = threadIdx.x & 63, i32 = lane & 31, hi = lane >> 5;
    const int nct = E::PAIRED ? (N / 256) * 4 : N / 32;
    const long w = (long)blockIdx.x * 4 + (threadIdx.x >> 6); if (w >= (long)(M / 32) * nct) return;
    const int mt = (int)(w / nct), ct = (int)(w % nct), row0 = mt * 32;
    const int pcol = E::PAIRED ? (ct >> 2) * 256 + (ct & 3) * 32 : ct * 32, lcol = E::PAIRED ? (ct >> 2) * 128 + (ct & 3) * 32 : pcol;
    const bf16_t* ap = A + (size_t)(row0 + i32) * lda + 8 * hi;
    const bf16_t* bp = Bt + (size_t)(pcol + pi32(i32)) * ldb + 8 * hi;
    f32x16 acc, acc2;
#pragma unroll
    for (int r = 0; r < 16; ++r) { acc[r] = 0.f; acc2[r] = 0.f; }
    for (int k = 0; k < K; k += 16) {
        const bf16x8 af = *(const bf16x8*)(ap + k), bf = *(const bf16x8*)(bp + k);
        acc = __builtin_amdgcn_mfma_f32_32x32x16_bf16(bf, af, acc, 0, 0, 0);
        if constexpr (E::PAIRED) { const bf16x8 bf2 = *(const bf16x8*)(bp + (size_t)128 * ldb + k); acc2 = __builtin_amdgcn_mfma_f32_32x32x16_bf16(bf2, af, acc2, 0, 0, 0); }
    }
    const int row = row0 + i32;
#pragma unroll
    for (int hf = 0; hf < 2; ++hf) {
        const f32x4 a = {acc[8 * hf], acc[8 * hf + 1], acc[8 * hf + 2], acc[8 * hf + 3]}, b = {acc[8 * hf + 4], acc[8 * hf + 5], acc[8 * hf + 6], acc[8 * hf + 7]};
        if constexpr (E::PAIRED) { const f32x4 c = {acc2[8 * hf], acc2[8 * hf + 1], acc2[8 * hf + 2], acc2[8 * hf + 3]}, d = {acc2[8 * hf + 4], acc2[8 * hf + 5], acc2[8 * hf + 6], acc2[8 * hf + 7]};
            e.apply2(row, lcol + 16 * hf + 8 * hi, a, b, c, d, e.rowscale(row)); }
        else { const float sp = e.apply(row, lcol + 16 * hf + 8 * hi, a, b, e.rowscale(row)); float* tg = e.target(row, lcol + 16 * hf + 8 * hi); if (tg) atomicAdd(tg, sp); }
    }
}

struct AttnConsts { float Mfix, lam, osc; };
__device__ __forceinline__ AttnConsts attn_consts(const float* gq, const float* gk, const float* lv, int layer, int lane) {
    AttnConsts c;
    const float mq = wave_max(fabsf(gq[lane])), mk = wave_max(fabsf(gk[lane]));
    c.Mfix = 8.f * mq * mk * LOG2E;
    const float s1 = wave_sum(lv[lane] * lv[64 + lane]), s2 = wave_sum(lv[128 + lane] * lv[192 + lane]);
    const float lam_init = 0.8f - 0.6f * expf(-0.3f * (float)layer);
    c.lam = expf(s1) - expf(s2) + lam_init; c.osc = 1.f - lam_init;
    return c;
}
__device__ __forceinline__ float xattn_shift(const float* gq, const float* gk, int lane) {
    float m = 0.f;
#pragma unroll
    for (int j = 0; j < 4; ++j) m = fmaxf(m, fabsf(gq[lane + 64 * j] * gk[lane + 64 * j]));
    return 16.f * wave_max(m) * LOG2E;
}

__global__ void __launch_bounds__(256) naive_diff_attn(bf16_t* proj, const bf16_t* VT, const float* gq, const float* gk, const float* lv, const float* gsub, int layer, int pad) {
    __shared__ float sQ[2][32][65], sK[2][32][65], sV[32][129], sP[2][32][33];
    const int t = threadIdx.x, lane = t & 63;
    const AttnConsts ac = attn_consts(gq, gk, lv, layer, lane);
    const int qt = blockIdx.x & 255, bh = blockIdx.x >> 8, b = bh >> 3, h = bh & 7;
    const size_t rowbase = (size_t)b * SEQ; const int q0 = qt * 32;
    for (int i = t; i < 2 * 32 * 64; i += 256) { const int c = i >> 11, r = (i >> 6) & 31, d = i & 63;
        sQ[c][r][d] = blo(proj[(rowbase + q0 + r) * NP + C_DQ + h * 128 + c * 64 + d]); }
    const int c = t >> 7, qr = (t & 127) >> 2, g4 = t & 3;
    float o[32]; float l = 0.f;
#pragma unroll
    for (int i = 0; i < 32; ++i) o[i] = 0.f;
    for (int kt = 0; kt <= qt; ++kt) {
        const int kv0 = kt * 32;
        __syncthreads();
        for (int i = t; i < 2 * 32 * 64; i += 256) { const int cc = i >> 11, r = (i >> 6) & 31, d = i & 63;
            sK[cc][r][d] = blo(proj[(rowbase + kv0 + r) * NP + C_DK + h * 128 + cc * 64 + d]); }
        for (int i = t; i < 32 * 128; i += 256) { const int d = i >> 5, r = i & 31;
            sV[r][d] = blo(VT[(size_t)(h * 128 + d) * TOK + rowbase + kv0 + r]); }
        __syncthreads();
#pragma unroll
        for (int j = 0; j < 8; ++j) { const int kv = g4 * 8 + j; float s = 0.f;
            for (int d = 0; d < 64; ++d) s += sQ[c][qr][d] * sK[c][kv][d];
            float p = __builtin_amdgcn_exp2f(s - ac.Mfix); if (kv0 + kv > q0 + qr) p = 0.f;
            sP[c][qr][kv] = p; }
        __syncthreads();
        for (int kv = 0; kv < 32; ++kv) { const float p = sP[c][qr][kv]; l += p;
#pragma unroll
            for (int i = 0; i < 32; ++i) o[i] += p * sV[kv][g4 * 32 + i]; }
    }
    __syncthreads();
    const float inv = 1.f / l;
    if (c == 1) {
#pragma unroll
        for (int i = 0; i < 32; ++i) sV[qr][g4 * 32 + i] = o[i] * inv; }
    __syncthreads();
    if (c == 0) {
        float ss = 0.f;
#pragma unroll
        for (int i = 0; i < 32; ++i) { o[i] = o[i] * inv - ac.lam * sV[qr][g4 * 32 + i]; ss += o[i] * o[i]; }
        ss += __shfl_xor(ss, 1); ss += __shfl_xor(ss, 2);
        const float rs = rs_of(ss, 1.f / 128) * ac.osc;
#pragma unroll
        for (int i = 0; i < 32; i += 2) {
            const int d = g4 * 32 + i;
            *(unsigned*)(proj + (rowbase + q0 + qr) * NP + C_OB + h * 128 + d) = pk2(o[i] * rs * gsub[d], o[i + 1] * rs * gsub[d + 1]);
        }
    }
}

namespace pg8 {
constexpr int BM = 256, BK = 64, HALF = 128, HTB = HALF * BK * 2, STAGE_BYTES = 8 * HTB, NXCD = 8, WGM = 8;
__host__ __device__ __forceinline__ int lds_byte(int r, int c) { const int st = (r >> 4) * 2 + (c >> 5), rr = r & 15, cc = c & 31, ob = rr * 64 + cc * 2; return st * 1024 + (ob ^ (((ob >> 9) & 1) << 5)); }
__host__ __device__ __forceinline__ void stage_rc(int b, int& R, int& C) { const int st = b / 1024, sb = b % 1024, swz = sb ^ (((sb >> 9) & 1) << 5); R = (st >> 1) * 16 + swz / 64; C = (st & 1) * 32 + (swz % 64) / 2; }
__host__ __device__ __forceinline__ int perm32(int rho) { const int n = rho >> 4, i = rho & 15; return 8 * (i >> 2) + 4 * n + (i & 3); }
struct Unit { int pm, pn, aoff, gi; };
struct Gemm { const bf16_t* A; const bf16_t* Bt; int M, N, K, lda, ldb; };
struct StaticOrder {
    int nM, nN, nwg, G, c;
    __device__ void init(int M, int N, int G_, int c_) { nM = M / BM; nN = N / BM; nwg = nM * nN; G = G_; c = c_; }
    __device__ bool next(int i, Unit& u) const {
        const long L = (long)i * G + c; if (L >= nwg || c >= G) return false;
        int wgid = (int)L; { const int q = nwg / NXCD, r = nwg % NXCD, xcd = wgid % NXCD, off = wgid / NXCD; wgid = (xcd < r ? xcd * (q + 1) : r * (q + 1) + (xcd - r) * q) + off; }
        const int nig = WGM * nN, gid = wgid / nig, fm = gid * WGM, gsz = (nM - fm) < WGM ? (nM - fm) : WGM;
        u.pm = fm + ((wgid % nig) % gsz); u.pn = (wgid % nig) / gsz; u.aoff = 0; u.gi = 0; return true;
    }
};
struct OneUnit { Unit u; bool valid; __device__ bool next(int i, Unit& o) const { if (i || !valid) return false; o = u; return true; } };

template <class F> struct EpiWrap {
    F f;
    __device__ __forceinline__ bool zero_after(const Unit&) const { return true; }
    __device__ __forceinline__ void operator()(f32x4 (&acc)[2][2][4][2], const Unit& u, int wr, int wc, int fr, int fq) const {
        float rsv[2][4];
#pragma unroll
        for (int ai = 0; ai < 2; ++ai)
#pragma unroll
            for (int m = 0; m < 4; ++m) rsv[ai][m] = f.rowscale(u.pm * BM + ai * HALF + wr * 64 + m * 16 + fr);
#pragma unroll
        for (int ai = 0; ai < 2; ++ai)
#pragma unroll
            for (int m = 0; m < 4; ++m) {
                const int row = u.pm * BM + ai * HALF + wr * 64 + m * 16 + fr;
                if constexpr (F::PAIRED) f.apply2(row, u.pn * 128 + wc * 32 + 8 * fq, acc[ai][0][m][0], acc[ai][0][m][1], acc[ai][1][m][0], acc[ai][1][m][1], rsv[ai][m]);
                else {
                    float sp = 0.f;
#pragma unroll
                    for (int bj = 0; bj < 2; ++bj) sp += f.apply(row, u.pn * BM + bj * HALF + wc * 32 + 8 * fq, acc[ai][bj][m][0], acc[ai][bj][m][1], rsv[ai][m]);
                    float* tg = f.target(row, u.pn * BM + wc * 32 + 8 * fq);
                    if (tg) { sp += swz_xor<16>(sp); sp = xor32_sum(sp); if (fq == 0) atomicAdd(tg, sp); }
                }
                if (m & 1) asm volatile("" ::: "memory");
            }
    }
};

struct ChainOrder {
    StaticOrder base;
    __device__ bool next(int j, Unit& u) const {
        const int i = j / 3, gi = j - 3 * i; Unit t;
        if (!base.next(i, t)) return false;
        u.pm = t.pm; u.pn = gi * 8 + t.pn; u.aoff = (gi == 0) ? C_CA : (gi == 1) ? C_OB : C_OC; u.gi = gi; return true;
    }
};
struct EpiChain {
    bf16_t* mg; const bf16_t* proj;
    __device__ __forceinline__ bool zero_after(const Unit& u) const { return u.gi == 2; }
    __device__ __forceinline__ void operator()(f32x4 (&acc)[2][2][4][2], const Unit& u, int wr, int wc, int fr, int fq) const {
        const int pn = u.pn & 7, gi = u.gi;
#pragma unroll
        for (int ai = 0; ai < 2; ++ai)
#pragma unroll
            for (int m = 0; m < 4; ++m) {
                const int row = u.pm * BM + ai * HALF + wr * 64 + m * 16 + fr;
#pragma unroll
                for (int bj = 0; bj < 2; ++bj) {
                    const int col0 = pn * BM + bj * HALF + wc * 32 + 8 * fq;
                    const bf16_t* gp = proj + (size_t)row * NP + C_G + gi * 2048 + col0;
                    f32x4 g0, g1; unpack8(*(const u32x4*)gp, g0, g1);
                    if (gi < 2) {
                        f32x4 n0, n1; unpack8(*(const u32x4*)(gp + 2048), n0, n1);
#pragma unroll
                        for (int i = 0; i < 4; ++i) { g0[i] *= __builtin_amdgcn_rcpf(fmaxf(n0[i], 1e-30f)); g1[i] *= __builtin_amdgcn_rcpf(fmaxf(n1[i], 1e-30f)); }
                        acc[ai][bj][m][0] *= g0; acc[ai][bj][m][1] *= g1;
                    } else {
                        *(u32x4*)(mg + (size_t)row * DM + col0) = pack8(acc[ai][bj][m][0] * g0, acc[ai][bj][m][1] * g1);
                    }
                }
                asm volatile("" ::: "memory");
            }
    }
};

template <class Epi, class Sched>
__device__ __forceinline__ void gemm_phase(LAS unsigned char* lds, const Gemm g, const Sched& S, const Epi& E, const int tid) {
    const int wid = __builtin_amdgcn_readfirstlane(tid >> 6), lane = tid & 63, wr = wid >> 2, wc = wid & 3, fr = lane & 15, fq = lane >> 4;
    const int K = g.K, nt = K / BK;
    unsigned voffA[2], voffB[2];
#pragma unroll
    for (int i = 0; i < 2; ++i) { int R, C; stage_rc(tid * 16 + i * 8192, R, C); const int Rb = (R & ~31) + perm32(R & 31);
        voffA[i] = (unsigned)(R * g.lda + C) * 2u; voffB[i] = (unsigned)(Rb * g.ldb + C) * 2u; }
    const size_t kstep = (size_t)(BK * 2);
    const size_t hstepA = (size_t)HALF * g.lda * 2, hstepB = (size_t)HALF * g.ldb * 2, tstepA = 2 * hstepA, tstepB = 2 * hstepB;
    const unsigned ldsw = (unsigned)wid * 1024u;
    const int aoff = lds_byte(wr * 64 + fr, fq * 8), boff = lds_byte(wc * 32 + fr, fq * 8);
#define PG8_SA(b, h) (((b) * 2 + (h)) * HTB)
#define PG8_SB(b, h) ((4 + (b) * 2 + (h)) * HTB)
#define PG8_STAGE(bufoff, gbase, voff) do { _Pragma("unroll") for (int _i = 0; _i < 2; ++_i) \
        __builtin_amdgcn_global_load_lds((const unsigned*)((const char*)(gbase) + (voff)[_i]), (LAS unsigned*)(lds + (bufoff) + ldsw + _i * 8192), 16, 0, 0); } while (0)
#define PG8_LDA(dst, b, h) do { _Pragma("unroll") for (int m = 0; m < 4; ++m) _Pragma("unroll") for (int k = 0; k < 2; ++k) dst[m][k] = *(const LAS bf16x8*)(lds + PG8_SA(b, h) + aoff + m * 2048 + k * 1024); } while (0)
#define PG8_LDB(dst, b, h) do { _Pragma("unroll") for (int n = 0; n < 2; ++n) _Pragma("unroll") for (int k = 0; k < 2; ++k) dst[n][k] = *(const LAS bf16x8*)(lds + PG8_SB(b, h) + boff + n * 2048 + k * 1024); } while (0)
#define PG8_MMA(ai, bj, At, Bt) do { __builtin_amdgcn_s_setprio(1); _Pragma("unroll") for (int m = 0; m < 4; ++m) _Pragma("unroll") for (int n = 0; n < 2; ++n) _Pragma("unroll") for (int k = 0; k < 2; ++k) \
        acc[ai][bj][m][n] = __builtin_amdgcn_mfma_f32_16x16x32_bf16(Bt[n][k], At[m][k], acc[ai][bj][m][n], 0, 0, 0); __builtin_amdgcn_s_setprio(0); } while (0)
#define PG8_WAIT_V(n) asm volatile("s_waitcnt vmcnt(" #n ")" ::: "memory")
#define PG8_WAIT_L(n) asm volatile("s_waitcnt lgkmcnt(" #n ")" ::: "memory")
#define PG8_BAR __builtin_amdgcn_s_barrier()
#define PG8_SCHED __builtin_amdgcn_sched_barrier(0)
    Unit cur, nxt; int ui = 0;
    if (!S.next(0, cur)) return;
    f32x4 acc[2][2][4][2];
#pragma unroll
    for (int a = 0; a < 2; ++a)
#pragma unroll
        for (int b = 0; b < 2; ++b)
#pragma unroll
            for (int m = 0; m < 4; ++m)
#pragma unroll
                for (int n = 0; n < 2; ++n) acc[a][b][m][n] = (f32x4){0.f, 0.f, 0.f, 0.f};
    bf16x8 At[4][2], B0[2][2], B1[2][2];
    const char* cA = (const char*)g.A + (size_t)cur.pm * tstepA + (size_t)cur.aoff * 2; const char* cB = (const char*)g.Bt + (size_t)cur.pn * tstepB;
    PG8_STAGE(PG8_SB(0, 0), cB, voffB); PG8_STAGE(PG8_SB(0, 1), cB + hstepB, voffB); PG8_STAGE(PG8_SA(0, 0), cA, voffA); PG8_STAGE(PG8_SA(0, 1), cA + hstepA, voffA);
    if (wr == 1) PG8_BAR;
    PG8_WAIT_V(2); PG8_BAR;
    PG8_STAGE(PG8_SB(1, 0), cB + kstep, voffB); PG8_STAGE(PG8_SA(1, 0), cA + kstep, voffA); PG8_STAGE(PG8_SB(1, 1), cB + hstepB + kstep, voffB);
    PG8_WAIT_V(6); PG8_BAR;
    for (;;) {
        const bool has_next = S.next(ui + 1, nxt);
        const char* nA = has_next ? (const char*)g.A + (size_t)nxt.pm * tstepA + (size_t)nxt.aoff * 2 : cA; const char* nB = has_next ? (const char*)g.Bt + (size_t)nxt.pn * tstepB : cB;
        for (int t = 0; t < nt; t += 2) {
            const bool last = (t == nt - 2);
            const char* a1 = cA + (size_t)(t + 1) * kstep;
            const char* a2 = last ? nA : cA + (size_t)(t + 2) * kstep; const char* b2 = last ? nB : cB + (size_t)(t + 2) * kstep;
            const char* a3 = a2 + kstep; const char* b3 = b2 + kstep;
            PG8_LDB(B0, 0, 0); PG8_LDB(B1, 0, 1); PG8_SCHED; PG8_LDA(At, 0, 0); PG8_STAGE(PG8_SA(1, 1), a1 + hstepA, voffA);
            PG8_WAIT_V(8); PG8_WAIT_L(0); PG8_BAR; PG8_MMA(0, 0, At, B0); PG8_MMA(0, 1, At, B1); PG8_BAR; PG8_SCHED;
            PG8_LDA(At, 0, 1); PG8_STAGE(PG8_SB(0, 0), b2, voffB); PG8_STAGE(PG8_SB(0, 1), b2 + hstepB, voffB); PG8_STAGE(PG8_SA(0, 0), a2, voffA);
            PG8_WAIT_V(8); PG8_WAIT_L(0); PG8_BAR; PG8_MMA(1, 0, At, B0); PG8_MMA(1, 1, At, B1); PG8_BAR; PG8_SCHED;
            PG8_LDB(B0, 1, 0); PG8_LDB(B1, 1, 1); PG8_SCHED; PG8_LDA(At, 1, 0); PG8_STAGE(PG8_SA(0, 1), a2 + hstepA, voffA);
            PG8_WAIT_V(8); PG8_WAIT_L(0); PG8_BAR; PG8_MMA(0, 0, At, B0); PG8_MMA(0, 1, At, B1); PG8_BAR; PG8_SCHED;
            PG8_LDA(At, 1, 1); PG8_STAGE(PG8_SB(1, 0), b3, voffB); PG8_STAGE(PG8_SB(1, 1), b3 + hstepB, voffB); PG8_STAGE(PG8_SA(1, 0), a3, voffA);
            PG8_WAIT_V(8); PG8_WAIT_L(0); PG8_BAR; PG8_MMA(1, 0, At, B0); PG8_MMA(1, 1, At, B1); PG8_BAR; PG8_SCHED;
        }
        if (wr == 0) PG8_BAR;
        E(acc, cur, wr, wc, fr, fq);
        if (!has_next) break;
        if (E.zero_after(cur))
#pragma unroll
        for (int a = 0; a < 2; ++a)
#pragma unroll
            for (int b = 0; b < 2; ++b)
#pragma unroll
                for (int m = 0; m < 4; ++m)
#pragma unroll
                    for (int n = 0; n < 2; ++n) acc[a][b][m][n] = (f32x4){0.f, 0.f, 0.f, 0.f};
        cur = nxt; cA = nA; cB = nB; ++ui;
        if (wr == 1) PG8_BAR;
    }
    PG8_WAIT_V(0);
    PG8_BAR;
#undef PG8_SA
#undef PG8_SB
#undef PG8_STAGE
#undef PG8_LDA
#undef PG8_LDB
#undef PG8_MMA
#undef PG8_WAIT_V
#undef PG8_WAIT_L
#undef PG8_BAR
#undef PG8_SCHED
}
}

__device__ __forceinline__ void glds16(const void* gsrc, unsigned lds_dst) { unsigned keep;
    asm volatile("s_mov_b32 %0, m0\n\ts_mov_b32 m0, %2\n\ts_nop 0\n\tglobal_load_lds_dwordx4 %1, off\n\ts_mov_b32 m0, %0" : "=&s"(keep) : "v"(gsrc), "s"(lds_dst) : "memory"); }
constexpr int ATT_LDS = 65536;
template <bool NOSHIFT> __device__ __forceinline__ void diff_attn_unit(LAS unsigned char* lds, bf16_t* proj, const bf16_t* VT, int b, int h, int qb, const AttnConsts ac, const float* gsub, const int tid, bf16_t* obuf, int opitch, int ocol) {
    const int lane = tid & 63, wid = __builtin_amdgcn_readfirstlane(tid >> 6), wq = wid & 3, c = wid >> 2, i32 = lane & 31, hi = lane >> 5;
    const size_t rowbase = (size_t)b * SEQ; const int q0 = qb * 128, qrow = q0 + 32 * wq + i32;
    bf16x8 qf[4];
    { const bf16_t* qp = proj + (rowbase + qrow) * NP + C_DQ + h * 128 + c * 64 + hi * 8;
#pragma unroll
      for (int ks = 0; ks < 4; ++ks) qf[ks] = *(const bf16x8*)(qp + 16 * ks); }
    const unsigned lds0 = (unsigned)(uintptr_t)lds;
    const int krow_s = 4 * wid + (lane >> 4), vd_s = 8 * wid + (lane >> 3);
    const bf16_t* kg = proj + (rowbase + krow_s) * NP + C_DK + h * 128 + (((lane & 15) ^ (krow_s & 15)) * 8);
    const bf16_t* vg = VT + (size_t)(h * 128 + vd_s) * TOK + rowbase + (((lane & 7) ^ ((vd_s >> 1) & 7)) * 8);
    const unsigned kdst = lds0 + wid * 1024, vdst = lds0 + 65536 + wid * 1024;
#define ATT_ISSUE(tt) do { const unsigned so_ = ((tt) & 3) * 16384; const bf16_t* kp_ = kg + (size_t)(tt) * 64 * NP; const bf16_t* vp_ = vg + (size_t)(tt) * 64; \
        glds16(kp_, (unsigned)__builtin_amdgcn_readfirstlane(kdst + so_)); glds16(kp_ + (size_t)32 * NP, (unsigned)__builtin_amdgcn_readfirstlane(kdst + so_ + 8192)); \
        glds16(vp_, (unsigned)__builtin_amdgcn_readfirstlane(vdst + so_)); glds16(vp_ + (size_t)64 * TOK, (unsigned)__builtin_amdgcn_readfirstlane(vdst + so_ + 8192)); } while (0)
#define ATT_WAITBAR(N) asm volatile("s_waitcnt vmcnt(" #N ") lgkmcnt(0)\n\ts_barrier" ::: "memory")
    const int krow = pi32(i32);
    int koff[2][4];
#pragma unroll
    for (int mt = 0; mt < 2; ++mt)
#pragma unroll
        for (int ks = 0; ks < 4; ++ks) { const int r = 32 * mt + krow; koff[mt][ks] = r * 256 + (((8 * c + 2 * ks + hi) ^ (r & 15)) * 16); }
    const int NT = 2 * qb + 2;
    f32x16 o[4];
#pragma unroll
    for (int dt = 0; dt < 4; ++dt)
#pragma unroll
        for (int r = 0; r < 16; ++r) o[dt][r] = 0.f;
    float l = 0.f;
    bf16x8 pf[4];
#pragma unroll
    for (int kk = 0; kk < 4; ++kk) pf[kk] = (bf16x8){0, 0, 0, 0, 0, 0, 0, 0};
    const int qmax = q0 + 32 * wq + 31;
#define ATT_LDV(dst, slot, kk) do { _Pragma("unroll") for (int dt = 0; dt < 4; ++dt) { const int d = 32 * dt + i32; \
        dst[dt] = *(const LAS bf16x8*)(lds + 65536 + (slot) + d * 128 + (((2 * (kk) + hi) ^ ((d >> 1) & 7)) * 16)); } } while (0)
#define ATT_MMV(src, kk) do { __builtin_amdgcn_s_setprio(1); _Pragma("unroll") for (int dt = 0; dt < 4; ++dt) o[dt] = __builtin_amdgcn_mfma_f32_32x32x16_bf16(src[dt], pf[kk], o[dt], 0, 0, 0); __builtin_amdgcn_s_setprio(0); } while (0)
#define ATT_SB __builtin_amdgcn_sched_barrier(0)
#define ATT_PV(slot) do { bf16x8 va[4], vb[4]; ATT_LDV(va, slot, 0); ATT_SB; ATT_LDV(vb, slot, 1); ATT_SB; ATT_MMV(va, 0); ATT_SB; ATT_LDV(va, slot, 2); ATT_SB; ATT_MMV(vb, 1); ATT_SB; \
        ATT_LDV(vb, slot, 3); ATT_SB; ATT_MMV(va, 2); ATT_SB; ATT_MMV(vb, 3); ATT_SB; } while (0)
    ATT_ISSUE(0); ATT_ISSUE(1);
    ATT_WAITBAR(4);
    for (int t = 0; t < NT; ++t) {
        const int bo = (t & 3) * 16384, sl_cur = bo, sl_prev = ((t - 1) & 3) * 16384;
        if (t + 2 < NT) ATT_ISSUE(t + 2);
        const int kv0 = 64 * t;
        if (c == 1 && t >= 1 && kv0 - 64 <= qmax) ATT_PV(sl_prev);
        if (kv0 <= qmax) {
            f32x16 p[2];
            bf16x8 kf[2][4];
#pragma unroll
            for (int mt = 0; mt < 2; ++mt)
#pragma unroll
                for (int ks = 0; ks < 4; ++ks) kf[mt][ks] = *(const LAS bf16x8*)(lds + bo + koff[mt][ks]);
            if constexpr (!NOSHIFT) {
#pragma unroll
                for (int mt = 0; mt < 2; ++mt)
#pragma unroll
                    for (int r = 0; r < 16; ++r) p[mt][r] = -ac.Mfix;
            }
            ATT_SB;
            __builtin_amdgcn_s_setprio(1);
#pragma unroll
            for (int ks = 0; ks < 4; ++ks)
#pragma unroll
                for (int mt = 0; mt < 2; ++mt) {
                    if (NOSHIFT && ks == 0) { const f32x16 z = {0.f, 0.f, 0.f, 0.f, 0.f, 0.f, 0.f, 0.f, 0.f, 0.f, 0.f, 0.f, 0.f, 0.f, 0.f, 0.f}; p[mt] = __builtin_amdgcn_mfma_f32_32x32x16_bf16(kf[mt][ks], qf[ks], z, 0, 0, 0); }
                    else p[mt] = __builtin_amdgcn_mfma_f32_32x32x16_bf16(kf[mt][ks], qf[ks], p[mt], 0, 0, 0);
                }
            __builtin_amdgcn_s_setprio(0);
            ATT_SB;
            const bool diag = (t >= 2 * qb);
            if (diag) {
                const int qrel = qrow - kv0 - 8 * hi;
#pragma unroll
                for (int mt = 0; mt < 2; ++mt)
#pragma unroll
                    for (int r = 0; r < 16; ++r) { float v = __builtin_amdgcn_exp2f(p[mt][r]); if (32 * mt + 16 * (r >> 3) + (r & 7) > qrel) v = 0.f; p[mt][r] = v; l += v; }
            } else {
#pragma unroll
                for (int mt = 0; mt < 2; ++mt)
#pragma unroll
                    for (int r = 0; r < 16; ++r) { const float v = __builtin_amdgcn_exp2f(p[mt][r]); p[mt][r] = v; l += v; }
            }
            asm volatile("" ::: "memory");
#pragma unroll
            for (int kk = 0; kk < 4; ++kk) { const int mt = kk >> 1, r0 = 8 * (kk & 1); u32x4 w;
                w.x = pk2(p[mt][r0], p[mt][r0 + 1]); w.y = pk2(p[mt][r0 + 2], p[mt][r0 + 3]); w.z = pk2(p[mt][r0 + 4], p[mt][r0 + 5]); w.w = pk2(p[mt][r0 + 6], p[mt][r0 + 7]);
                pf[kk] = __builtin_bit_cast(bf16x8, w); }
            if (c == 0) ATT_PV(sl_cur);
        }
        if (t + 2 < NT) ATT_WAITBAR(4); else ATT_WAITBAR(0);
    }
    if (c == 1 && 64 * (NT - 1) <= qmax) ATT_PV(((NT - 1) & 3) * 16384);
#undef ATT_ISSUE
#undef ATT_WAITBAR
#undef ATT_PV
#undef ATT_LDV
#undef ATT_MMV
#undef ATT_SB
    l = xor32_sum(l);
    const float inv = 1.f / l;
    LAS float* xch = (LAS float*)lds + (size_t)wq * 4096 + lane;
    if (c == 1) {
#pragma unroll
        for (int dt = 0; dt < 4; ++dt)
#pragma unroll
            for (int r = 0; r < 16; ++r) xch[(dt * 16 + r) * 64] = o[dt][r] * inv;
    }
    __syncthreads();
    if (c == 0) {
        float ss = 0.f;
#pragma unroll
        for (int dt = 0; dt < 4; ++dt)
#pragma unroll
            for (int r = 0; r < 16; ++r) { const float v = o[dt][r] * inv - ac.lam * xch[(dt * 16 + r) * 64]; o[dt][r] = v; ss += v * v; }
        ss = xor32_sum(ss);
        const float rs = rs_of(ss, 1.f / 128) * ac.osc;
        bf16_t* op = obuf + (rowbase + qrow) * opitch + ocol + h * 128;
#pragma unroll
        for (int dt = 0; dt < 4; ++dt)
#pragma unroll
            for (int rg = 0; rg < 4; ++rg) { const int d = 32 * dt + 8 * rg + 4 * hi; const f32x4 g = *(const f32x4*)(gsub + d);
                u32x2 w; w.x = pk2(o[dt][4 * rg] * rs * g.x, o[dt][4 * rg + 1] * rs * g.y); w.y = pk2(o[dt][4 * rg + 2] * rs * g.z, o[dt][4 * rg + 3] * rs * g.w);
                *(u32x2*)(op + d) = w; }
    }
    __syncthreads();
}

__device__ __forceinline__ int maprow(int mode, int n) {
    if (mode == 1) { if (n < 5120) return n; if (n < 6144) return 12288 + (n - 5120); if (n < 7168) return 5120 + (n - 6144); return 6144 + (n - 7168); }
    if (mode == 2) { if (n < DFF) return (n >> 7) * 256 + (n & 127); const int m = n - DFF; return (m >> 7) * 256 + 128 + (m & 127); }
    return n;
}
__device__ __forceinline__ void conv_item(const float* W, int K, int N, bf16_t* Wt, const float* g, int mode, int item, int lane) {
    const int nkc = K >> 7, nb = item / nkc, kc = item - nb * nkc, n0 = nb * 64, k0 = kc * 128, kgp = lane >> 4, nq = lane & 15;
    const int drow = maprow(mode, n0) + 4 * nq;
#pragma unroll 2
    for (int it = 0; it < 4; ++it) {
        const int kb = k0 + it * 32 + kgp * 8;
        f32x4 v[8];
#pragma unroll
        for (int j = 0; j < 8; ++j) v[j] = *(const f32x4*)(W + (size_t)(kb + j) * N + n0 + 4 * nq);
        if (g) {
            const f32x4 g0 = *(const f32x4*)(g + kb), g1 = *(const f32x4*)(g + kb + 4);
#pragma unroll
            for (int j = 0; j < 4; ++j) { v[j] *= g0[j]; v[4 + j] *= g1[j]; }
        }
#pragma unroll
        for (int i = 0; i < 4; ++i) {
            u32x4 o; o.x = pk2(v[0][i], v[1][i]); o.y = pk2(v[2][i], v[3][i]); o.z = pk2(v[4][i], v[5][i]); o.w = pk2(v[6][i], v[7][i]);
            *(u32x4*)(Wt + (size_t)(drow + i) * K + kb) = o;
        }
    }
}
__device__ __forceinline__ void row_to_bf16(const float* xr, bf16_t* orow, float* ssout, int lane) {
    float s = 0.f;
#pragma unroll
    for (int j = 0; j < 8; ++j) { const f32x4 v = *(const f32x4*)(xr + 4 * lane + 256 * j); s += sum4(v * v);
        u32x2 w; w.x = pk2(v.x, v.y); w.y = pk2(v.z, v.w); *(u32x2*)(orow + 4 * lane + 256 * j) = w; }
    s = wave_sum(s);
    if (lane == 0) *ssout = s;
}

#define XB_TMO      128
#define XB_XCNT(j)  (256  + 64 * (j))
#define XB_XSUB(j)  (1280 + 64 * (j))
#define XB_XGEN(j)  (2304 + 64 * (j))
#define XB_TOP      3328
#define XB_TOPGEN   3392
#define XCD_BAR_WORDS 3456
#define XB_SPIN_CAP (1u << 18)
__device__ __forceinline__ unsigned xb_ld(unsigned* p)              { return __hip_atomic_load(p, __ATOMIC_RELAXED, __HIP_MEMORY_SCOPE_AGENT); }
__device__ __forceinline__ unsigned xb_add(unsigned* p, unsigned v) { return __hip_atomic_fetch_add(p, v, __ATOMIC_RELAXED, __HIP_MEMORY_SCOPE_AGENT); }
__device__ __forceinline__ unsigned xb_xcc_id() { return (unsigned)__builtin_amdgcn_s_getreg((3 << 11) | 20) & 0xFu; }
#define XB_SPIN(cond, bar) do { unsigned _sp = 0; while (cond) { __builtin_amdgcn_s_sleep(1); \
    if ((++_sp & 255u) == 0u) { if (xb_ld(&(bar)[XB_TMO])) break; if (_sp > XB_SPIN_CAP) { atomicAdd(&(bar)[XB_TMO], 1u); break; } } } } while (0)
struct XcdBarrier { unsigned* bar; unsigned x; volatile LAS unsigned* st; };
__device__ __forceinline__ XcdBarrier xcd_barrier_post(unsigned* bar, volatile LAS unsigned* st) {
    XcdBarrier b; b.bar = bar; b.x = xb_xcc_id(); b.st = st;
    if (threadIdx.x == 0) (void)xb_add(&bar[XB_XCNT(b.x)], 1u);
    return b;
}
__device__ __forceinline__ void xcd_barrier_complete(unsigned* bar, unsigned x, unsigned& nloc, unsigned& nx) {
    const unsigned G = gridDim.x * gridDim.y * gridDim.z;
    unsigned sum, cnt, mine, sp = 0u;
    for (;;) {
        sum = 0u; cnt = 0u; mine = 0u;
#pragma unroll
        for (unsigned j = 0; j < 16; ++j) { const unsigned c = xb_ld(&bar[XB_XCNT(j)]); sum += c; cnt += (c > 0u) ? 1u : 0u; mine = (j == x) ? c : mine; }
        if (sum == G) break;
        __builtin_amdgcn_s_sleep(1);
        if ((++sp & 255u) == 0u) { if (xb_ld(&bar[XB_TMO])) break; if (sp > XB_SPIN_CAP) { atomicAdd(&bar[XB_TMO], 1u); break; } }
    }
    nloc = mine > 0u ? mine : 1u; nx = cnt > 0u ? cnt : 1u;
}
__device__ __forceinline__ void xcd_barrier(const XcdBarrier& b) {
    asm volatile("s_waitcnt vmcnt(0)" ::: "memory");
    __syncthreads();
    if (threadIdx.x == 0) {
        unsigned* bar = b.bar;
        __builtin_amdgcn_s_waitcnt(0);
        unsigned nloc = b.st[0], nx = b.st[1];
        if (nloc == 0u) { xcd_barrier_complete(bar, b.x, nloc, nx); b.st[0] = nloc; b.st[1] = nx; }
        const unsigned old = xb_add(&bar[XB_XSUB(b.x)], 1u);
        const unsigned gen = old / nloc;
        if (old + 1u == (gen + 1u) * nloc) {
            __builtin_amdgcn_fence(__ATOMIC_RELEASE, "agent");
            asm volatile("s_waitcnt vmcnt(0)" ::: "memory");
            const unsigned og = xb_add(&bar[XB_TOP], 1u);
            const unsigned tg = og / nx;
            if (og + 1u == (tg + 1u) * nx) xb_add(&bar[XB_TOPGEN], 1u);
            else XB_SPIN(xb_ld(&bar[XB_TOPGEN]) == tg, bar);
            __builtin_amdgcn_fence(__ATOMIC_ACQUIRE, "agent");
            xb_add(&bar[XB_XGEN(b.x)], 1u);
            asm volatile("s_waitcnt vmcnt(0)" ::: "memory");
        } else {
            XB_SPIN(xb_ld(&bar[XB_XGEN(b.x)]) == gen, bar);
            __builtin_amdgcn_fence(__ATOMIC_ACQUIRE, "agent");
            asm volatile("s_waitcnt vmcnt(0)" ::: "memory");
        }
    }
    __syncthreads();
}

struct Args { const void* in[21]; float* out; unsigned char* ws; int lo, hi, flags, pad; };
constexpr int NPHASE = 16;
constexpr int FL_SKIP_MEMKV = 1, FL_SKIP_ATTN = 2, FL_SKIP_CROSS = 4, FL_SKIP_MAIN = 8, FL_XCDBAR = 16;
constexpr int LDS_BYTES = pg8::STAGE_BYTES + 2048;
constexpr size_t WS_BAR = 1400 * KiB, WS_BAR_BYTES = 16 * KiB;

__global__ void __launch_bounds__(512, 2) mega(Args args) {
    extern __shared__ __attribute__((aligned(16))) unsigned char lds_raw[];
    LAS unsigned char* lds = (LAS unsigned char*)lds_raw;
    cg::grid_group grid = cg::this_grid();
    constexpr int G = 256;
    const int wave0 = __builtin_amdgcn_readfirstlane(threadIdx.x >> 6);
    volatile LAS unsigned* bst = (volatile LAS unsigned*)(lds + pg8::STAGE_BYTES + 1024);
    if (threadIdx.x < 2) bst[threadIdx.x] = 0u;
    __syncthreads();
    XcdBarrier xbar; xbar.bar = (unsigned*)(args.ws + WS_BAR); xbar.x = 0; xbar.st = bst;
    if (args.flags & FL_XCDBAR) xbar = xcd_barrier_post((unsigned*)(args.ws + WS_BAR), bst);
    for (int ph = args.lo; ph < args.hi; ++ph) {
        int bx_ = blockIdx.x; asm volatile("" : "+s"(bx_)); const int bx = bx_, vcu = (bx % 8) * (G / 8) + bx / 8;
        unsigned char* ws = args.ws; asm volatile("" : "+s"(ws));
        constexpr int NGW = G * 8;
        const float* x_in = (const float*)args.in[0]; const float* mem = (const float*)args.in[1]; const int* positions = (const int*)args.in[2];
        float* xcur = args.out;
        float* ssb = (float*)(ws + WS_SS); float* qssb = (float*)(ws + WS_QSS); float* lsumb = (float*)(ws + WS_LSUM); float* kssb = (float*)(ws + WS_KSS); float* ssmem = (float*)(ws + WS_SSMEM);
        float* cs = (float*)(ws + WS_CS); float* xsh = (float*)(ws + WS_XSH);
        bf16_t* memb = (bf16_t*)(ws + WS_MEMB); bf16_t* mkraw = (bf16_t*)(ws + WS_MKRAW); bf16_t* mvT = (bf16_t*)(ws + WS_MVT);
        bf16_t* Win_t = (bf16_t*)(ws + WS_WIN); bf16_t* Wc_t = (bf16_t*)(ws + WS_WC); bf16_t* Wd_t = (bf16_t*)(ws + WS_WD); bf16_t* Wx_t = (bf16_t*)(ws + WS_WX);
        bf16_t* Wmkv_t = (bf16_t*)(ws + WS_WMKV); bf16_t* Wo_t = (bf16_t*)(ws + WS_WO); bf16_t* Wgu_t = (bf16_t*)(ws + WS_WGU); bf16_t* Wdn_t = (bf16_t*)(ws + WS_WDN);
        bf16_t* proj = (bf16_t*)(ws + WS_PROJ); bf16_t* VT = (bf16_t*)(ws + WS_VT); bf16_t* xb = (bf16_t*)(ws + WS_XB); bf16_t* mg = (bf16_t*)(ws + WS_MG); bf16_t* hb = (bf16_t*)(ws + WS_H);

        const int l = ph >> 3, p = ph & 7;
        const int wave = wave0, gw = vcu * 8 + wave;
#define PHASE_TID() const int tid = phase_tid(wave0), lane = tid & 63
        const float* gq_x = (const float*)args.in[14] + l * 256; const float* gk_x = (const float*)args.in[15] + l * 256;
        float* qss = qssb + (size_t)l * TOK * 4; float* lsum = lsumb + (size_t)l * TOK * 4; float* kss = kssb + l * 2048;
        if (p == 0) {
            PHASE_TID();
            const float* g_mix = (const float*)args.in[3] + l * DM; const float* g_mem = (const float*)args.in[12] + l * DM; const float* g_ffn = (const float*)args.in[18] + l * DM;
            const float* w_in = (const float*)args.in[4] + (size_t)l * DM * NIN; const float* w_co = (const float*)args.in[6] + (size_t)l * 1024 * DM;
            const float* w_do = (const float*)args.in[11] + (size_t)l * 1024 * DM; const float* w_mkv = (const float*)args.in[13] + (size_t)l * DM * 2048;
            const float* w_xo = (const float*)args.in[16] + (size_t)l * 1024 * DM; const float* w_o = (const float*)args.in[17] + (size_t)l * DM * DM;
            const float* w_gu = (const float*)args.in[19] + (size_t)l * DM * 2 * DFF; const float* w_dn = (const float*)args.in[20] + (size_t)l * DFF * DM;
            constexpr int I_IN = (NIN / 64) * (DM / 128), I_B = (DM / 64) * (1024 / 128), I_SQ = (DM / 64) * (DM / 128), I_GU = (2 * DFF / 64) * (DM / 128), I_DN = (DM / 64) * (DFF / 128);
            constexpr int NIT = I_IN + 3 * I_B + 2 * I_SQ + I_GU + I_DN;
#pragma unroll 1
            for (int rep = 0; rep < REP_P0; ++rep)
            for (int it = gw; it < NIT; it += NGW) {
                int r = it;
                if (r < I_IN) { conv_item(w_in, DM, NIN, Win_t, g_mix, 1, r, lane); continue; } r -= I_IN;
                if (r < I_GU) { conv_item(w_gu, DM, 2 * DFF, Wgu_t, g_ffn, 2, r, lane); continue; } r -= I_GU;
                if (r < I_DN) { conv_item(w_dn, DFF, DM, Wdn_t, nullptr, 0, r, lane); continue; } r -= I_DN;
                if (r < I_SQ) { conv_item(w_mkv, DM, 2048, Wmkv_t, g_mem, 0, r, lane); continue; } r -= I_SQ;
                if (r < I_SQ) { conv_item(w_o, DM, DM, Wo_t, nullptr, 0, r, lane); continue; } r -= I_SQ;
                if (r < I_B) { conv_item(w_co, 1024, DM, Wc_t, nullptr, 0, r, lane); continue; } r -= I_B;
                if (r < I_B) { conv_item(w_do, 1024, DM, Wd_t, nullptr, 0, r, lane); continue; } r -= I_B;
                conv_item(w_xo, 1024, DM, Wx_t, nullptr, 0, r, lane);
            }
            if (l == 0) {
                for (int m = gw; m < TOK; m += NGW) row_to_bf16(x_in + (size_t)m * DM, xb + (size_t)m * DM, ssb + m, lane);
                for (int m = gw; m < BATCH * MEMLEN; m += NGW) row_to_bf16(mem + (size_t)m * DM, memb + (size_t)m * DM, ssmem + m, lane);
                { unsigned* z = (unsigned*)(ws + WS_ZERO_LO); const int nz = (int)((WS_ZERO_HI - WS_ZERO_LO) / 4);
                  for (int i = bx * 512 + tid; i < nz; i += G * 512) z[i] = 0u; }
                for (int i = bx * 512 + tid; i < TOK * 8; i += G * 512) {
                    const int row = i >> 3, k = i & 7;
                    const float ang = (float)positions[row] * INVF[k];
                    const float kk = rintf(ang * 0.15915494309189535f);
                    float rr = fmaf(-kk, 6.2831854820251465f, ang); rr = fmaf(-kk, -1.7484556000744883e-07f, rr);
                    const float fr = rr * 0.15915494309189535f;
                    cs[row * 16 + k] = __builtin_amdgcn_cosf(fr); cs[row * 16 + 8 + k] = __builtin_amdgcn_sinf(fr);
                }
            }
        } else if (p == 1) {
            PHASE_TID();
            if (PH_EN(1) && !(args.flags & FL_SKIP_MAIN)) {
#pragma unroll 1
                for (int rep = 0; rep < REP_P1; ++rep)
                { pg8::Gemm g{xb, Win_t, TOK, NP, DM, DM, DM}; pg8::StaticOrder S; S.init(TOK, NP, G, bx);
                  pg8::EpiWrap<EIn> E{EIn{proj, ssb + (size_t)(2 * l) * TOK, gq_x, gk_x, rep == REP_P1 - 1 ? qss : nullptr}}; pg8::gemm_phase(lds, g, S, E, phase_tid(wave0)); }
                { pg8::Gemm g{Win_t + (size_t)NP * DM, xb, 1024, TOK, DM, DM, DM}; pg8::StaticOrder S; S.init(1024, TOK, G, bx);
                  pg8::EpiWrap<EColScale> E{EColScale{VT, ssb + (size_t)(2 * l) * TOK, TOK, 0}}; pg8::gemm_phase(lds, g, S, E, phase_tid(wave0)); }
            }
        } else if (p == 2) {
            PHASE_TID();
            const bool do_mkv = !(args.flags & FL_SKIP_MEMKV) && G >= 32;
            if (bx == G - 1 && wave == 0) { const float mx = xattn_shift(gq_x, gk_x, lane); if (lane == 0) xsh[l] = mx; }
#pragma unroll 1
            for (int rep2 = 0; rep2 < REP_P2; ++rep2) { const bool real2 = rep2 == REP_P2 - 1;
            if (PH_EN(2) && do_mkv && bx < 16) {
                if (bx < 8) { pg8::Gemm g{memb, Wmkv_t, 512, 1024, DM, DM, DM}; pg8::StaticOrder S; S.init(512, 1024, 8, bx);
                    pg8::EpiWrap<EMemK> E{EMemK{mkraw, ssmem, real2 ? kss : nullptr}}; pg8::gemm_phase(lds, g, S, E, phase_tid(wave0)); }
                else { pg8::Gemm g{Wmkv_t + (size_t)1024 * DM, memb, 1024, 512, DM, DM, DM}; pg8::StaticOrder S; S.init(1024, 512, 8, bx - 8);
                    pg8::EpiWrap<EColScale> E{EColScale{mvT, ssmem, 512, 0}}; pg8::gemm_phase(lds, g, S, E, phase_tid(wave0)); }
            } else {
                const int nb0 = do_mkv ? 16 : 0, NW2 = (G - nb0) * 8, gw2 = (bx - nb0) * 8 + wave;
                const float* gqd = (const float*)args.in[7] + l * 64; const float* gkd = (const float*)args.in[8] + l * 64; const float* cw = (const float*)args.in[5] + l * 3 * 1024;
#pragma unroll 1
                for (int base = gw2; base < 2 * TOK; base += 4 * NW2) {
                    u32x4 wv[4][2];
#pragma unroll
                    for (int j4 = 0; j4 < 4; ++j4) { const int tk = min(base + j4 * NW2, 2 * TOK - 1);
                        const bf16_t* pp = proj + (size_t)(tk >> 1) * NP + ((tk & 1) ? C_DK : C_DQ) + lane * 16; wv[j4][0] = *(const u32x4*)pp; wv[j4][1] = *(const u32x4*)(pp + 8); }
#pragma unroll
                    for (int j4 = 0; j4 < 4; ++j4) { const int tk = base + j4 * NW2;
                        if (tk < 2 * TOK) {
                            const int row = tk >> 1, which = tk & 1, j = lane & 3;
                            bf16_t* pp = proj + (size_t)row * NP + (which ? C_DK : C_DQ) + lane * 16;
                            f32x4 f0, f1, f2, f3; unpack8(wv[j4][0], f0, f1); unpack8(wv[j4][1], f2, f3);
                            float ss = sum4(f0 * f0) + sum4(f1 * f1) + sum4(f2 * f2) + sum4(f3 * f3);
                            ss += swz_xor<1>(ss); ss += swz_xor<2>(ss);
                            const float rs = rs_of(ss, 1.f / 64);
                            const float* gg = (which ? gkd : gqd) + 16 * j;
                            f0 *= *(const f32x4*)gg * rs; f1 *= *(const f32x4*)(gg + 4) * rs; f2 *= *(const f32x4*)(gg + 8) * rs; f3 *= *(const f32x4*)(gg + 12) * rs;
                            if (j == 0) {
                                const float* cr = cs + (size_t)row * 16;
                                const f32x4 c0 = *(const f32x4*)cr, c1 = *(const f32x4*)(cr + 4), s0 = *(const f32x4*)(cr + 8), s1 = *(const f32x4*)(cr + 12);
                                const f32x4 a0 = f0 * c0 - f2 * s0, a1 = f1 * c1 - f3 * s1, b0 = f2 * c0 + f0 * s0, b1 = f3 * c1 + f1 * s1;
                                f0 = a0; f1 = a1; f2 = b0; f3 = b1;
                            }
                            if (!which) { const float sc = 0.125f * LOG2E; f0 *= sc; f1 *= sc; f2 *= sc; f3 *= sc; }
                            bf16_t* po = real2 ? pp : mg + (size_t)row * DM + lane * 16; *(u32x4*)po = pack8(f0, f1); *(u32x4*)(po + 8) = pack8(f2, f3);
                        } }
                }
#pragma unroll 1
                for (int base = gw2; base < 2 * TOK; base += 2 * NW2) {
                    u32x4 vc[2][3], vx[2][3], vb[2];
#pragma unroll
                    for (int j2 = 0; j2 < 2; ++j2) { const int tk = min(base + j2 * NW2, 2 * TOK - 1);
                        const int id = tk * 64 + lane, row = id >> 7, ch = (id & 127) * 8, sq = row & (SEQ - 1); const bf16_t* pr = proj + (size_t)row * NP;
#pragma unroll
                        for (int jj = 0; jj < 3; ++jj) { const bf16_t* q = pr - (size_t)((sq - 2 + jj >= 0) ? (2 - jj) : 0) * NP; vc[j2][jj] = *(const u32x4*)(q + C_CC + ch); vx[j2][jj] = *(const u32x4*)(q + C_CX + ch); }
                        vb[j2] = *(const u32x4*)(pr + C_CB + ch); }
#pragma unroll
                    for (int j2 = 0; j2 < 2; ++j2) { const int tk = base + j2 * NW2;
                        if (tk < 2 * TOK) { const int id = tk * 64 + lane, row = id >> 7, ch = (id & 127) * 8, sq = row & (SEQ - 1);
                            f32x4 u0 = {0.f, 0.f, 0.f, 0.f}, u1 = u0;
#pragma unroll
                            for (int jj = 0; jj < 3; ++jj) {
                                if (sq - 2 + jj >= 0) { f32x4 a0, a1, b0, b1; unpack8(vc[j2][jj], a0, a1); unpack8(vx[j2][jj], b0, b1);
                                    u0 += *(const f32x4*)(cw + jj * 1024 + ch) * (a0 * b0); u1 += *(const f32x4*)(cw + jj * 1024 + ch + 4) * (a1 * b1); } }
                            f32x4 g0, g1; unpack8(vb[j2], g0, g1);
                            *(u32x4*)(real2 ? proj + (size_t)row * NP + C_CA + ch : mg + (size_t)row * DM + 1024 + ch) = pack8(g0 * u0, g1 * u1);
                        } }
                }
            }
            }
        } else if (p == 3) {
            PHASE_TID();
            if (PH_EN(3) && !(args.flags & FL_SKIP_ATTN)) {
                const AttnConsts ac = attn_consts((const float*)args.in[7] + l * 64, (const float*)args.in[8] + l * 64, (const float*)args.in[9] + l * 256, l, lane);
                const float* gsub = (const float*)args.in[10] + l * 128;
#pragma unroll 1
                for (int rep = 0; rep < REP_ATTN; ++rep) {
                    const bool real = (rep == REP_ATTN - 1);
                    const int v = vcu, bh = v >> 4, s = v & 15;
#pragma unroll 1
                    for (int i = 0; i < 4; ++i) { const int qb = (i == 0) ? 63 - s : (i == 1) ? 32 + s : (i == 2) ? 31 - s : s;
                        if (ac.Mfix <= 40.f) diff_attn_unit<true>(lds, proj, VT, bh >> 3, bh & 7, qb, ac, gsub, phase_tid(wave0), real ? proj : mg, real ? NP : DM, real ? C_OB : 0);
                        else diff_attn_unit<false>(lds, proj, VT, bh >> 3, bh & 7, qb, ac, gsub, phase_tid(wave0), real ? proj : mg, real ? NP : DM, real ? C_OB : 0); }
                }
            }
            if (PH_EN(8) && !(args.flags & FL_SKIP_CROSS)) {
#pragma unroll 1
                for (int repx = 0; repx < REP_X; ++repx) {
                    const int u = bx; const bool realx = repx == REP_X - 1;
                    const int b = u >> 7, h = (u >> 5) & 3, qb = u & 31;
                    { pg8::Gemm g{proj + C_XQ + h * 256, mkraw + (size_t)(b * 256) * 1024 + h * 256, TOK, 256, 256, NP, 1024};
                      LAS float* rkl = (LAS float*)(lds + pg8::STAGE_BYTES);
                      if (tid < 256) rkl[tid] = rs_of(kss[(b * 256 + tid) * 4 + h], 1.f / 256);
                      __syncthreads();
                      pg8::OneUnit S{{b * 32 + qb, 0, 0, 0}, true}; pg8::EpiWrap<EXs<true>> E{EXs<true>{proj, qss, kss, realx ? lsum : nullptr, xsh + l, (unsigned)(uintptr_t)rkl, b, h, LOG2E / 16.f}}; pg8::gemm_phase(lds, g, S, E, phase_tid(wave0)); }
                    __threadfence(); __syncthreads();
                    { pg8::Gemm g{proj + C_P + h * 256, mvT + (size_t)(h * 256) * 512 + b * 256, TOK, 256, 256, NP, 512};
                      pg8::OneUnit S{{b * 32 + qb, 0, 0, 0}, true}; pg8::EpiWrap<EXo> E{EXo{proj, lsum, h, 0}}; pg8::gemm_phase(lds, g, S, E, phase_tid(wave0)); }
                }
            }
        } else if (p == 4) {
            PHASE_TID();
            if (PH_EN(4) && !(args.flags & FL_SKIP_MAIN)) {
#pragma unroll 1
                for (int rep = 0; rep < REP_P4; ++rep) {
                    pg8::Gemm g{proj, Wc_t, TOK, DM, 1024, NP, 1024}; pg8::ChainOrder S; S.base.init(TOK, DM, G, bx);
                    pg8::EpiChain E{mg, proj}; pg8::gemm_phase(lds, g, S, E, phase_tid(wave0));
                }
            }
        } else if (p == 5) {
            PHASE_TID();
            if (PH_EN(5) && !(args.flags & FL_SKIP_MAIN)) {
#pragma unroll 1
                for (int rep = 0; rep < REP_P5; ++rep) { const bool real = rep == REP_P5 - 1;
                pg8::Gemm g{mg, Wo_t, TOK, DM, DM, DM, DM}; pg8::StaticOrder S; S.init(TOK, DM, G, bx);
                pg8::EpiWrap<ERes> E{ERes{l == 0 ? x_in : xcur, real ? xcur : (float*)(ws + WS_PROJ + 192 * MiB), real ? xb : (bf16_t*)(ws + WS_PROJ + 320 * MiB), real ? ssb + (size_t)(2 * l + 1) * TOK : nullptr}}; pg8::gemm_phase(lds, g, S, E, phase_tid(wave0)); }
            }
        } else if (p == 6) {
            PHASE_TID();
            if (PH_EN(6) && !(args.flags & FL_SKIP_MAIN)) {
#pragma unroll 1
                for (int rep = 0; rep < REP_GU; ++rep) {
                pg8::Gemm g{xb, Wgu_t, TOK, 2 * DFF, DM, DM, DM}; pg8::StaticOrder S; S.init(TOK, 2 * DFF, G, bx);
                pg8::EpiWrap<EGU> E{EGU{hb, ssb + (size_t)(2 * l + 1) * TOK}}; pg8::gemm_phase(lds, g, S, E, phase_tid(wave0)); }
            }
        } else {
            PHASE_TID();
            if (PH_EN(7) && !(args.flags & FL_SKIP_MAIN)) {
#pragma unroll 1
                for (int rep = 0; rep < REP_P7; ++rep) { const bool real = rep == REP_P7 - 1;
                pg8::Gemm g{hb, Wdn_t, TOK, DM, DFF, DFF, DFF}; pg8::StaticOrder S; S.init(TOK, DM, G, bx);
                pg8::EpiWrap<ERes> E{ERes{xcur, real ? xcur : (float*)(ws + WS_PROJ + 192 * MiB), real ? xb : (bf16_t*)(ws + WS_PROJ + 320 * MiB), (real && l == 0) ? ssb + (size_t)2 * TOK : nullptr}}; pg8::gemm_phase(lds, g, S, E, phase_tid(wave0)); }
            }
        }
        if (ph + 1 < args.hi) { if (!(args.flags & FL_XCDBAR) || ph == args.lo) grid.sync(); else xcd_barrier(xbar); }
    }
}

template <class E> static void launch_naive(const bf16_t* A, int lda, const bf16_t* Bt, int ldb, int M, int N, int K, E e, hipStream_t st) {
    const size_t n = (size_t)(M / 32) * (E::PAIRED ? (N / 256) * 4 : N / 32);
    hipLaunchKernelGGL(naive_gemm<E>, dim3((unsigned)((n + 3) / 4)), dim3(256), 0, st, A, Bt, e, lda, ldb, M, N, K, 0);
}

extern "C" void kernel_launch(void* const* d_in, const int* in_sizes, int n_in, void* d_out, int out_size, void* d_ws, size_t ws_size, hipStream_t stream) {
    static int grid = 0;
    if (grid == 0) {
        if (n_in != 21 || out_size != TOK * DM || ws_size < WS_END) { fprintf(stderr, "kernel_launch: unexpected shapes / workspace (%d inputs, out %d, ws %zu < %zu)\n", n_in, out_size, ws_size, (size_t)WS_END); grid = -1; return; }
        int dev = 0, cus = 0, per_cu = 0;
        hipGetDevice(&dev); hipDeviceGetAttribute(&cus, hipDeviceAttributeMultiprocessorCount, dev);
        hipFuncSetAttribute((const void*)mega, hipFuncAttributeMaxDynamicSharedMemorySize, LDS_BYTES);
        hipOccupancyMaxActiveBlocksPerMultiprocessor(&per_cu, (const void*)mega, 512, LDS_BYTES);
        if (per_cu < 1) per_cu = 1;
        grid = cus * per_cu; if (grid > 256) grid = 256;
        if (grid != 256) { fprintf(stderr, "kernel_launch: needs 256 co-resident workgroups, got %d\n", grid); grid = -1; return; }
        (void)hipGetLastError();
    }
    if (grid < 0) return;
    unsigned char* ws = (unsigned char*)d_ws;
    Args a{};
    for (int i = 0; i < 21; ++i) a.in[i] = d_in[i];
    a.out = (float*)d_out; a.ws = ws;
    float* ssb = (float*)(ws + WS_SS); float* qssb = (float*)(ws + WS_QSS); float* lsumb = (float*)(ws + WS_LSUM); float* kssb = (float*)(ws + WS_KSS); float* ssmem = (float*)(ws + WS_SSMEM);
    bf16_t* memb = (bf16_t*)(ws + WS_MEMB); bf16_t* mkraw = (bf16_t*)(ws + WS_MKRAW); bf16_t* mvT = (bf16_t*)(ws + WS_MVT);
    bf16_t* Win_t = (bf16_t*)(ws + WS_WIN); bf16_t* Wc_t = (bf16_t*)(ws + WS_WC); bf16_t* Wd_t = (bf16_t*)(ws + WS_WD); bf16_t* Wx_t = (bf16_t*)(ws + WS_WX);
    bf16_t* Wmkv_t = (bf16_t*)(ws + WS_WMKV); bf16_t* Wo_t = (bf16_t*)(ws + WS_WO); bf16_t* Wgu_t = (bf16_t*)(ws + WS_WGU); bf16_t* Wdn_t = (bf16_t*)(ws + WS_WDN);
    bf16_t* proj = (bf16_t*)(ws + WS_PROJ); bf16_t* VT = (bf16_t*)(ws + WS_VT); bf16_t* xb = (bf16_t*)(ws + WS_XB); bf16_t* mg = (bf16_t*)(ws + WS_MG); bf16_t* hb = (bf16_t*)(ws + WS_H);
    const float* x_in = (const float*)d_in[0]; float* xcur = (float*)d_out;

    static Args store[NPHASE + 1]; int nco = 0;
    auto coop = [&](int lo, int hi, int flags) {
        a.lo = lo; a.hi = hi; a.flags = flags; store[nco] = a;
        void* kargs[] = {&store[nco]}; ++nco;
        hipError_t e = hipSuccess;
        if (hi - lo == 1) hipLaunchKernelGGL(mega, dim3(grid), dim3(512), LDS_BYTES, stream, store[nco - 1]);
        else e = hipLaunchCooperativeKernel((const void*)mega, dim3(grid), dim3(512), kargs, LDS_BYTES, stream);
        if (e != hipSuccess) fprintf(stderr, "cooperative launch failed: %s (grid %d)\n", hipGetErrorString(e), grid);
    };
    auto is_naive = [](int p) { return p != 0 && ((NAIVE_MASK >> p) & 1); };
    int ph = 0;
#ifndef STOP_PH
#define STOP_PH NPHASE
#endif
    while (ph < STOP_PH) {
        const int l = ph >> 3, p = ph & 7;
#ifndef SKIP_PH
#define SKIP_PH 0x0
#endif
        if ((SKIP_PH >> p) & 1) { ++ph; continue; }
        const bool cross_naive = (NAIVE_MASK >> 8) & 1;
        const bool pure_fast = !is_naive(p) && !(p == 3 && cross_naive);
        if (pure_fast) {
            int e = ph + 1;
            while (e < STOP_PH) { const int q = e & 7; if (is_naive(q) || (q == 3 && cross_naive)) break; ++e; }
            const bool whole = (ph == 0 && e == NPHASE);
            if (whole) (void)hipMemsetAsync(ws + WS_BAR, 0, WS_BAR_BYTES, stream);
            coop(ph, e, whole ? FL_XCDBAR : 0); ph = e; continue;
        }
        const float* gq_x = (const float*)d_in[14] + l * 256; const float* gk_x = (const float*)d_in[15] + l * 256;
        float* qss = qssb + (size_t)l * TOK * 4; float* lsum = lsumb + (size_t)l * TOK * 4; float* kss = kssb + l * 2048;
        const float* ss0 = ssb + (size_t)(2 * l) * TOK; float* ss1 = ssb + (size_t)(2 * l + 1) * TOK;
        if (p == 1) {
            launch_naive(xb, DM, Win_t, DM, TOK, NP, DM, EIn{proj, ss0, gq_x, gk_x, qss}, stream);
            launch_naive(Win_t + (size_t)NP * DM, DM, xb, DM, 1024, TOK, DM, EColScale{VT, ss0, TOK, 0}, stream);
        } else if (p == 2) {
            coop(ph, ph + 1, FL_SKIP_MEMKV);
            launch_naive(memb, DM, Wmkv_t, DM, 512, 1024, DM, EMemK{mkraw, ssmem, kss}, stream);
            launch_naive(Wmkv_t + (size_t)1024 * DM, DM, memb, DM, 1024, 512, DM, EColScale{mvT, ssmem, 512, 0}, stream);
        } else if (p == 3) {
            const bool attn_naive = is_naive(3);
            if (!attn_naive || !cross_naive) coop(ph, ph + 1, (attn_naive ? FL_SKIP_ATTN : 0) | (cross_naive ? FL_SKIP_CROSS : 0));
            if (attn_naive && !(DBG_SKIP & 1))
                hipLaunchKernelGGL(naive_diff_attn, dim3(16 * 256), dim3(256), 0, stream, proj, VT, (const float*)d_in[7] + l * 64, (const float*)d_in[8] + l * 64,
                                   (const float*)d_in[9] + l * 256, (const float*)d_in[10] + l * 128, l, 0);
            if (cross_naive && !(DBG_SKIP & 2)) {
                for (int b = 0; b < BATCH; ++b) for (int h = 0; h < 4; ++h) {
                    launch_naive(proj + (size_t)b * SEQ * NP + C_XQ + h * 256, NP, mkraw + (size_t)(b * 256) * 1024 + h * 256, 1024, SEQ, 256, 256,
                                 EXs<false>{proj + (size_t)b * SEQ * NP, qss + (size_t)b * SEQ * 4, kss, lsum + (size_t)b * SEQ * 4, (const float*)(ws + WS_XSH) + l, 0u, b, h, LOG2E / 16.f}, stream);
                }
                for (int b = 0; b < BATCH; ++b) for (int h = 0; h < 4; ++h) {
                    launch_naive(proj + (size_t)b * SEQ * NP + C_P + h * 256, NP, mvT + (size_t)(h * 256) * 512 + b * 256, 512, SEQ, 256, 256,
                                 EXo{proj + (size_t)b * SEQ * NP, lsum + (size_t)b * SEQ * 4, h, 0}, stream);
                }
            }
        } else if (p == 4) {
            launch_naive(proj + C_CA, NP, Wc_t, 1024, TOK, DM, 1024, EMerge{mg, proj, 0, 0}, stream);
            launch_naive(proj + C_OB, NP, Wd_t, 1024, TOK, DM, 1024, EMerge{mg, proj, 1, 0}, stream);
            launch_naive(proj + C_OC, NP, Wx_t, 1024, TOK, DM, 1024, EMerge{mg, proj, 2, 0}, stream);
        } else if (p == 5) {
            launch_naive(mg, DM, Wo_t, DM, TOK, DM, DM, ERes{l == 0 ? x_in : xcur, xcur, xb, ss1}, stream);
        } else if (p == 6) {
            launch_naive(xb, DM, Wgu_t, DM, TOK, 2 * DFF, DM, EGU{hb, ss1}, stream);
        } else if (p == 7) {
            launch_naive(hb, DFF, Wdn_t, DFF, TOK, DM, DFF, ERes{xcur, xcur, xb, l == 0 ? ssb + (size_t)2 * TOK : nullptr}, stream);
        }
        ++ph;
    }
}
```

```cpp
#include <hip/hip_runtime.h>
#include <hip/hip_cooperative_groups.h>
#include <cstdio>
#include <cstdint>
namespace cg = cooperative_groups;

#ifndef NAIVE_MASK
#define NAIVE_MASK 0x0
#endif

#ifndef REP_ATTN
#define REP_ATTN 1
#endif
#ifndef REP_P0
#define REP_P0 1
#endif
#ifndef REP_P1
#define REP_P1 1
#endif
#ifndef REP_P4
#define REP_P4 1
#endif
#ifndef REP_P5
#define REP_P5 1
#endif
#ifndef REP_P7
#define REP_P7 1
#endif
#ifndef REP_P2
#define REP_P2 1
#endif
#ifndef REP_X
#define REP_X 1
#endif
#ifndef REP_GU
#define REP_GU 1
#endif
#ifndef DBG_SKIP
#define DBG_SKIP 0
#endif
#ifndef EN_MASK
#define EN_MASK 0xFFFF
#endif
#define PH_EN(n) (((EN_MASK) >> (n)) & 1)
constexpr int BATCH = 2, SEQ = 8192, DM = 2048, TOK = BATCH * SEQ, NIN = 13312, NP = 12288, DFF = 5632, MEMLEN = 256, DEPTH = 2;
constexpr float EPS = 1e-6f, LOG2E = 1.4426950408889634f;
constexpr int C_CB = 0, C_CC = 1024, C_CX = 2048, C_DQ = 3072, C_DK = 4096, C_XQ = 5120, C_G = 6144;
constexpr int C_CA = 0, C_P = 1024, C_OC = 2048, C_OB = 3072;

typedef unsigned short bf16_t;
typedef float f32x4 __attribute__((ext_vector_type(4)));
typedef float f32x2 __attribute__((ext_vector_type(2)));
typedef float f32x16 __attribute__((ext_vector_type(16)));
typedef unsigned u32x4 __attribute__((ext_vector_type(4)));
typedef unsigned u32x2 __attribute__((ext_vector_type(2)));
typedef short bf16x8 __attribute__((ext_vector_type(8)));
typedef __bf16 bf16x2_t __attribute__((ext_vector_type(2)));
#define LAS __attribute__((address_space(3)))

constexpr size_t MiB = 1u << 20, KiB = 1024;
constexpr size_t WS_SS = 0, WS_QSS = 256 * KiB, WS_LSUM = 768 * KiB, WS_KSS = 1280 * KiB, WS_SSMEM = 1296 * KiB, WS_ZERO_LO = 64 * KiB, WS_ZERO_HI = 1296 * KiB;
constexpr size_t WS_XSH = 1300 * KiB;
constexpr size_t WS_CS = 2 * MiB, WS_MEMB = 4 * MiB, WS_MKRAW = 6 * MiB, WS_MVT = 7 * MiB;
constexpr size_t WS_WIN = 8 * MiB, WS_WC = 60 * MiB, WS_WD = 64 * MiB, WS_WX = 68 * MiB, WS_WMKV = 72 * MiB, WS_WO = 80 * MiB, WS_WGU = 88 * MiB, WS_WDN = 132 * MiB;
constexpr size_t WS_PROJ = 154 * MiB, WS_VT = 538 * MiB, WS_XB = 570 * MiB, WS_MG = 634 * MiB, WS_END = 698 * MiB;
constexpr size_t WS_H = WS_PROJ;

__device__ __forceinline__ unsigned pk2(float lo, float hi) { f32x2 v = {lo, hi}; bf16x2_t b = __builtin_convertvector(v, bf16x2_t); return __builtin_bit_cast(unsigned, b); }
__device__ __forceinline__ u32x4 pack8(f32x4 a, f32x4 b) { u32x4 w; w.x = pk2(a.x, a.y); w.y = pk2(a.z, a.w); w.z = pk2(b.x, b.y); w.w = pk2(b.z, b.w); return w; }
__device__ __forceinline__ float blo(unsigned w) { return __uint_as_float(w << 16); }
__device__ __forceinline__ float bhi(unsigned w) { return __uint_as_float(w & 0xffff0000u); }
__device__ __forceinline__ void unpack8(u32x4 w, f32x4& a, f32x4& b) { a = (f32x4){blo(w.x), bhi(w.x), blo(w.y), bhi(w.y)}; b = (f32x4){blo(w.z), bhi(w.z), blo(w.w), bhi(w.w)}; }
__device__ __forceinline__ int opaque(int v) { asm volatile("" : "+v"(v)); return v; }
__device__ __forceinline__ int phase_tid(int wave0) { int t; asm volatile("v_mbcnt_lo_u32_b32 %0, -1, 0\n\tv_mbcnt_hi_u32_b32 %0, -1, %0" : "=v"(t)); return t | (wave0 << 6); }
__device__ __forceinline__ float sum4(f32x4 v) { return (v.x + v.y) + (v.z + v.w); }
__device__ __forceinline__ float rs_of(float ss, float invn) { return rsqrtf(ss * invn + EPS); }
__constant__ float INVF[8] = {1.0f, 0.1939227432012558f, 0.03760603070259094f, 0.007292664609849453f, 0.0014142135623842478f, 0.00027424818836152554f, 5.3182957344688475e-05f, 1.0313385246263351e-05f};
__device__ __forceinline__ float xor32_sum(float v) { auto rr = __builtin_amdgcn_permlane32_swap(__float_as_uint(v), __float_as_uint(v), false, false); return __uint_as_float(rr[0]) + __uint_as_float(rr[1]); }
__device__ __forceinline__ float xor32_max(float v) { auto rr = __builtin_amdgcn_permlane32_swap(__float_as_uint(v), __float_as_uint(v), false, false); return fmaxf(__uint_as_float(rr[0]), __uint_as_float(rr[1])); }
template <int X> __device__ __forceinline__ float swz_xor(float v) { return __int_as_float(__builtin_amdgcn_ds_swizzle(__float_as_int(v), 0x1f | (X << 10))); }
__device__ __forceinline__ float wave_sum(float v) {
    v += swz_xor<1>(v); v += swz_xor<2>(v); v += swz_xor<4>(v); v += swz_xor<8>(v); v += swz_xor<16>(v); v = xor32_sum(v);
    return v;
}
__device__ __forceinline__ float wave_max(float v) {
    v = fmaxf(v, swz_xor<1>(v)); v = fmaxf(v, swz_xor<2>(v)); v = fmaxf(v, swz_xor<4>(v)); v = fmaxf(v, swz_xor<8>(v)); v = fmaxf(v, swz_xor<16>(v)); v = xor32_max(v);
    return v;
}
__device__ __forceinline__ float sigmoidf_(float v) { return __builtin_amdgcn_rcpf(1.f + __expf(-v)); }

struct EIn {
    static constexpr bool PAIRED = false;
    bf16_t* proj; const float* ss; const float* gq; const float* gk; float* qss;
    __device__ __forceinline__ float* target(int row, int col0) const { return (qss && col0 >= C_XQ && col0 < C_G) ? qss + row * 4 + ((col0 - C_XQ) >> 8) : nullptr; }
    __device__ __forceinline__ float rowscale(int row) const { return rs_of(ss[row], 1.f / DM); }
    __device__ __forceinline__ float apply(int row, int col0, f32x4 a, f32x4 b, float rs) const {
        a *= rs; b *= rs; float s = 0.f;
        if (col0 >= C_G) {
#pragma unroll
            for (int i = 0; i < 4; ++i) { a[i] = sigmoidf_(a[i]); b[i] = sigmoidf_(b[i]); }
        } else if (col0 >= C_XQ) {
            const int d = (col0 - C_XQ) & 255;
            s = sum4(a * a) + sum4(b * b);
            const f32x4 g0 = *(const f32x4*)(gq + d) * *(const f32x4*)(gk + d), g1 = *(const f32x4*)(gq + d + 4) * *(const f32x4*)(gk + d + 4);
            a *= g0; b *= g1;
        }
        *(u32x4*)(proj + (size_t)row * NP + col0) = pack8(a, b);
        return s;
    }
};
struct EColScale {
    static constexpr bool PAIRED = false;
    bf16_t* O; const float* ss; int ldc, pad;
    __device__ __forceinline__ float* target(int, int) const { return nullptr; }
    __device__ __forceinline__ float rowscale(int) const { return 1.f; }
    __device__ __forceinline__ float apply(int row, int col0, f32x4 a, f32x4 b, float) const {
        const f32x4 s0 = *(const f32x4*)(ss + col0), s1 = *(const f32x4*)(ss + col0 + 4);
#pragma unroll
        for (int i = 0; i < 4; ++i) { a[i] *= rs_of(s0[i], 1.f / DM); b[i] *= rs_of(s1[i], 1.f / DM); }
        *(u32x4*)(O + (size_t)row * ldc + col0) = pack8(a, b);
        return 0.f;
    }
};
struct EMemK {
    static constexpr bool PAIRED = false;
    bf16_t* O; const float* ssmem; float* kss;
    __device__ __forceinline__ float* target(int row, int col0) const { return kss ? kss + row * 4 + (col0 >> 8) : nullptr; }
    __device__ __forceinline__ float rowscale(int row) const { return rs_of(ssmem[row], 1.f / DM); }
    __device__ __forceinline__ float apply(int row, int col0, f32x4 a, f32x4 b, float rs) const {
        a *= rs; b *= rs;
        *(u32x4*)(O + (size_t)row * 1024 + col0) = pack8(a, b);
        return sum4(a * a) + sum4(b * b);
    }
};
template <bool LDSRK> struct EXs {
    static constexpr bool PAIRED = false;
    bf16_t* proj; const float* qss; const float* kss; float* lsum; const float* Mxp; unsigned rkl; int b, h; float c;
    __device__ __forceinline__ float* target(int row, int) const { return lsum ? lsum + row * 4 + h : nullptr; }
    __device__ __forceinline__ float rowscale(int row) const { return rs_of(qss[row * 4 + h], 1.f / 256) * c; }
    __device__ __forceinline__ float apply(int row, int col0, f32x4 a, f32x4 bb, float rq) const {
        const float Mx = __hip_atomic_load(Mxp, __ATOMIC_RELAXED, __HIP_MEMORY_SCOPE_AGENT);
        f32x4 k0, k1;
        if constexpr (LDSRK) { const LAS float* rk = (const LAS float*)rkl; k0 = *(const LAS f32x4*)(rk + col0); k1 = *(const LAS f32x4*)(rk + col0 + 4); }
        else {
#pragma unroll
            for (int i = 0; i < 4; ++i) { k0[i] = rs_of(kss[(b * 256 + col0 + i) * 4 + h], 1.f / 256); k1[i] = rs_of(kss[(b * 256 + col0 + 4 + i) * 4 + h], 1.f / 256); }
        }
        float s = 0.f;
#pragma unroll
        for (int i = 0; i < 4; ++i) {
            a[i] = __builtin_amdgcn_exp2f(a[i] * rq * k0[i] - Mx);
            bb[i] = __builtin_amdgcn_exp2f(bb[i] * rq * k1[i] - Mx);
            s += a[i] + bb[i];
        }
        *(u32x4*)(proj + (size_t)row * NP + C_P + h * 256 + col0) = pack8(a, bb);
        return s;
    }
};
struct EXo {
    static constexpr bool PAIRED = false;
    bf16_t* proj; const float* lsum; int h, pad;
    __device__ __forceinline__ float* target(int, int) const { return nullptr; }
    __device__ __forceinline__ float rowscale(int row) const { return 1.f / __hip_atomic_load(lsum + row * 4 + h, __ATOMIC_RELAXED, __HIP_MEMORY_SCOPE_AGENT); }
    __device__ __forceinline__ float apply(int row, int col0, f32x4 a, f32x4 b, float inv) const {
        a *= inv; b *= inv;
        *(u32x4*)(proj + (size_t)row * NP + C_OC + h * 256 + col0) = pack8(a, b);
        return 0.f;
    }
};
struct EMerge {
    static constexpr bool PAIRED = false;
    bf16_t* mg; const bf16_t* proj; int gi, pad;
    __device__ __forceinline__ float* target(int, int) const { return nullptr; }
    __device__ __forceinline__ float rowscale(int) const { return 1.f; }
    __device__ __forceinline__ float apply(int row, int col0, f32x4 a, f32x4 b, float) const {
        f32x4 g0, g1; unpack8(*(const u32x4*)(proj + (size_t)row * NP + C_G + gi * 2048 + col0), g0, g1);
        a *= g0; b *= g1;
        bf16_t* p = mg + (size_t)row * DM + col0;
        if (gi > 0) { f32x4 m0, m1; unpack8(*(const u32x4*)p, m0, m1); a += m0; b += m1; }
        *(u32x4*)p = pack8(a, b);
        return 0.f;
    }
};
struct ERes {
    static constexpr bool PAIRED = false;
    const float* xin; float* xout; bf16_t* xb; float* ssn;
    __device__ __forceinline__ float* target(int row, int) const { return ssn ? ssn + row : nullptr; }
    __device__ __forceinline__ float rowscale(int) const { return 1.f; }
    __device__ __forceinline__ float apply(int row, int col0, f32x4 a, f32x4 b, float) const {
        const size_t off = (size_t)row * DM + col0;
        a += *(const f32x4*)(xin + off); b += *(const f32x4*)(xin + off + 4);
        *(f32x4*)(xout + off) = a; *(f32x4*)(xout + off + 4) = b;
        *(u32x4*)(xb + off) = pack8(a, b);
        return sum4(a * a) + sum4(b * b);
    }
};
struct EGU {
    static constexpr bool PAIRED = true;
    bf16_t* H; const float* ss;
    __device__ __forceinline__ float rowscale(int row) const { return rs_of(ss[row], 1.f / DM); }
    __device__ __forceinline__ void apply2(int row, int lcol0, f32x4 a0, f32x4 a1, f32x4 b0, f32x4 b1, float rs) const {
#pragma unroll
        for (int i = 0; i < 4; ++i) {
            const float x = a0[i] * rs, y = a1[i] * rs;
            a0[i] = x * sigmoidf_(x) * (b0[i] * rs); a1[i] = y * sigmoidf_(y) * (b1[i] * rs);
        }
        *(u32x4*)(H + (size_t)row * DFF + lcol0) = pack8(a0, a1);
    }
};

__device__ __forceinline__ float dot8(u32x4 a, u32x4 b) {
    float s = blo(a.x) * blo(b.x); s += bhi(a.x) * bhi(b.x); s += blo(a.y) * blo(b.y); s += bhi(a.y) * bhi(b.y);
    s += blo(a.z) * blo(b.z); s += bhi(a.z) * bhi(b.z); s += blo(a.w) * blo(b.w); s += bhi(a.w) * bhi(b.w); return s;
}
__device__ __forceinline__ int pi32(int i) { return (i & 0x13) | ((i & 4) << 1) | ((i & 8) >> 1); }
template <class E> __global__ void __launch_bounds__(256) naive_gemm(const bf16_t* A, const bf16_t* Bt, E e, int lda, int ldb, int M, int N, int K, int pad) {
    const int lane = threadIdx.x & 63, i32 = lane & 31, hi = lane >> 5;
    const int nct = E::PAIRED ? (N / 256) * 4 : N / 32;
    const long w = (long)blockIdx.x * 4 + (threadIdx.x >> 6); if (w >= (long)(M / 32) * nct) return;
    const int mt = (int)(w / nct), ct = (int)(w % nct), row0 = mt * 32;
    const int pcol = E::PAIRED ? (ct >> 2) * 256 + (ct & 3) * 32 : ct * 32, lcol = E::PAIRED ? (ct >> 2) * 128 + (ct & 3) * 32 : pcol;
    const bf16_t* ap = A + (size_t)(row0 + i32) * lda + 8 * hi;
    const bf16_t* bp = Bt + (size_t)(pcol + pi32(i32)) * ldb + 8 * hi;
    f32x16 acc, acc2;
#pragma unroll
    for (int r = 0; r < 16; ++r) { acc[r] = 0.f; acc2[r] = 0.f; }
    for (int k = 0; k < K; k += 16) {
        const bf16x8 af = *(const bf16x8*)(ap + k), bf = *(const bf16x8*)(bp + k);
        acc = __builtin_amdgcn_mfma_f32_32x32x16_bf16(bf, af, acc, 0, 0, 0);
        if constexpr (E::PAIRED) { const bf16x8 bf2 = *(const bf16x8*)(bp + (size_t)128 * ldb + k); acc2 = __builtin_amdgcn_mfma_f32_32x32x16_bf16(bf2, af, acc2, 0, 0, 0); }
    }
    const int row = row0 + i32;
#pragma unroll
    for (int hf = 0; hf < 2; ++hf) {
        const f32x4 a = {acc[8 * hf], acc[8 * hf + 1], acc[8 * hf + 2], acc[8 * hf + 3]}, b = {acc[8 * hf + 4], acc[8 * hf + 5], acc[8 * hf + 6], acc[8 * hf + 7]};
        if constexpr (E::PAIRED) { const f32x4 c = {acc2[8 * hf], acc2[8 * hf + 1], acc2[8 * hf + 2], acc2[8 * hf + 3]}, d = {acc2[8 * hf + 4], acc2[8 * hf + 5], acc2[8 * hf + 6], acc2[8 * hf + 7]};
            e.apply2(row, lcol + 16 * hf + 8 * hi, a, b, c, d, e.rowscale(row)); }
        else { const float sp = e.apply(row, lcol + 16 * hf + 8 * hi, a, b, e.rowscale(row)); float* tg = e.target(row, lcol + 16 * hf + 8 * hi); if (tg) atomicAdd(tg, sp); }
    }
}

struct AttnConsts { float Mfix, lam, osc; };
__device__ __forceinline__ AttnConsts attn_consts(const float* gq, const float* gk, const float* lv, int layer, int lane) {
    AttnConsts c;
    const float mq = wave_max(fabsf(gq[lane])), mk = wave_max(fabsf(gk[lane]));
    c.Mfix = 8.f * mq * mk * LOG2E;
    const float s1 = wave_sum(lv[lane] * lv[64 + lane]), s2 = wave_sum(lv[128 + lane] * lv[192 + lane]);
    const float lam_init = 0.8f - 0.6f * expf(-0.3f * (float)layer);
    c.lam = expf(s1) - expf(s2) + lam_init; c.osc = 1.f - lam_init;
    return c;
}
__device__ __forceinline__ float xattn_shift(const float* gq, const float* gk, int lane) {
    float m = 0.f;
#pragma unroll
    for (int j = 0; j < 4; ++j) m = fmaxf(m, fabsf(gq[lane + 64 * j] * gk[lane + 64 * j]));
    return 16.f * wave_max(m) * LOG2E;
}

__global__ void __launch_bounds__(256) naive_diff_attn(bf16_t* proj, const bf16_t* VT, const float* gq, const float* gk, const float* lv, const float* gsub, int layer, int pad) {
    __shared__ float sQ[2][32][65], sK[2][32][65], sV[32][129], sP[2][32][33];
    const int t = threadIdx.x, lane = t & 63;
    const AttnConsts ac = attn_consts(gq, gk, lv, layer, lane);
    const int qt = blockIdx.x & 255, bh = blockIdx.x >> 8, b = bh >> 3, h = bh & 7;
    const size_t rowbase = (size_t)b * SEQ; const int q0 = qt * 32;
    for (int i = t; i < 2 * 32 * 64; i += 256) { const int c = i >> 11, r = (i >> 6) & 31, d = i & 63;
        sQ[c][r][d] = blo(proj[(rowbase + q0 + r) * NP + C_DQ + h * 128 + c * 64 + d]); }
    const int c = t >> 7, qr = (t & 127) >> 2, g4 = t & 3;
    float o[32]; float l = 0.f;
#pragma unroll
    for (int i = 0; i < 32; ++i) o[i] = 0.f;
    for (int kt = 0; kt <= qt; ++kt) {
        const int kv0 = kt * 32;
        __syncthreads();
        for (int i = t; i < 2 * 32 * 64; i += 256) { const int cc = i >> 11, r = (i >> 6) & 31, d = i & 63;
            sK[cc][r][d] = blo(proj[(rowbase + kv0 + r) * NP + C_DK + h * 128 + cc * 64 + d]); }
        for (int i = t; i < 32 * 128; i += 256) { const int d = i >> 5, r = i & 31;
            sV[r][d] = blo(VT[(size_t)(h * 128 + d) * TOK + rowbase + kv0 + r]); }
        __syncthreads();
#pragma unroll
        for (int j = 0; j < 8; ++j) { const int kv = g4 * 8 + j; float s = 0.f;
            for (int d = 0; d < 64; ++d) s += sQ[c][qr][d] * sK[c][kv][d];
            float p = __builtin_amdgcn_exp2f(s - ac.Mfix); if (kv0 + kv > q0 + qr) p = 0.f;
            sP[c][qr][kv] = p; }
        __syncthreads();
        for (int kv = 0; kv < 32; ++kv) { const float p = sP[c][qr][kv]; l += p;
#pragma unroll
            for (int i = 0; i < 32; ++i) o[i] += p * sV[kv][g4 * 32 + i]; }
    }
    __syncthreads();
    const float inv = 1.f / l;
    if (c == 1) {
#pragma unroll
        for (int i = 0; i < 32; ++i) sV[qr][g4 * 32 + i] = o[i] * inv; }
    __syncthreads();
    if (c == 0) {
        float ss = 0.f;
#pragma unroll
        for (int i = 0; i < 32; ++i) { o[i] = o[i] * inv - ac.lam * sV[qr][g4 * 32 + i]; ss += o[i] * o[i]; }
        ss += __shfl_xor(ss, 1); ss += __shfl_xor(ss, 2);
        const float rs = rs_of(ss, 1.f / 128) * ac.osc;
#pragma unroll
        for (int i = 0; i < 32; i += 2) {
            const int d = g4 * 32 + i;
            *(unsigned*)(proj + (rowbase + q0 + qr) * NP + C_OB + h * 128 + d) = pk2(o[i] * rs * gsub[d], o[i + 1] * rs * gsub[d + 1]);
        }
    }
}

namespace pg8 {
constexpr int BM = 256, BK = 64, HALF = 128, HTB = HALF * BK * 2, STAGE_BYTES = 8 * HTB, NXCD = 8, WGM = 8;
__host__ __device__ __forceinline__ int lds_byte(int r, int c) { const int st = (r >> 4) * 2 + (c >> 5), rr = r & 15, cc = c & 31, ob = rr * 64 + cc * 2; return st * 1024 + (ob ^ (((ob >> 9) & 1) << 5)); }
__host__ __device__ __forceinline__ void stage_rc(int b, int& R, int& C) { const int st = b / 1024, sb = b % 1024, swz = sb ^ (((sb >> 9) & 1) << 5); R = (st >> 1) * 16 + swz / 64; C = (st & 1) * 32 + (swz % 64) / 2; }
__host__ __device__ __forceinline__ int perm32(int rho) { const int n = rho >> 4, i = rho & 15; return 8 * (i >> 2) + 4 * n + (i & 3); }
struct Unit { int pm, pn, aoff, gi; };
struct Gemm { const bf16_t* A; const bf16_t* Bt; int M, N, K, lda, ldb; };
struct StaticOrder {
    int nM, nN, nwg, G, c;
    __device__ void init(int M, int N, int G_, int c_) { nM = M / BM; nN = N / BM; nwg = nM * nN; G = G_; c = c_; }
    __device__ bool next(int i, Unit& u) const {
        const long L = (long)i * G + c; if (L >= nwg || c >= G) return false;
        int wgid = (int)L; { const int q = nwg / NXCD, r = nwg % NXCD, xcd = wgid % NXCD, off = wgid / NXCD; wgid = (xcd < r ? xcd * (q + 1) : r * (q + 1) + (xcd - r) * q) + off; }
        const int nig = WGM * nN, gid = wgid / nig, fm = gid * WGM, gsz = (nM - fm) < WGM ? (nM - fm) : WGM;
        u.pm = fm + ((wgid % nig) % gsz); u.pn = (wgid % nig) / gsz; u.aoff = 0; u.gi = 0; return true;
    }
};
struct OneUnit { Unit u; bool valid; __device__ bool next(int i, Unit& o) const { if (i || !valid) return false; o = u; return true; } };

template <class F> struct EpiWrap {
    F f;
    __device__ __forceinline__ bool zero_after(const Unit&) const { return true; }
    __device__ __forceinline__ void operator()(f32x4 (&acc)[2][2][4][2], const Unit& u, int wr, int wc, int fr, int fq) const {
        float rsv[2][4];
#pragma unroll
        for (int ai = 0; ai < 2; ++ai)
#pragma unroll
            for (int m = 0; m < 4; ++m) rsv[ai][m] = f.rowscale(u.pm * BM + ai * HALF + wr * 64 + m * 16 + fr);
#pragma unroll
        for (int ai = 0; ai < 2; ++ai)
#pragma unroll
            for (int m = 0; m < 4; ++m) {
                const int row = u.pm * BM + ai * HALF + wr * 64 + m * 16 + fr;
                if constexpr (F::PAIRED) f.apply2(row, u.pn * 128 + wc * 32 + 8 * fq, acc[ai][0][m][0], acc[ai][0][m][1], acc[ai][1][m][0], acc[ai][1][m][1], rsv[ai][m]);
                else {
                    float sp = 0.f;
#pragma unroll
                    for (int bj = 0; bj < 2; ++bj) sp += f.apply(row, u.pn * BM + bj * HALF + wc * 32 + 8 * fq, acc[ai][bj][m][0], acc[ai][bj][m][1], rsv[ai][m]);
                    float* tg = f.target(row, u.pn * BM + wc * 32 + 8 * fq);
                    if (tg) { sp += swz_xor<16>(sp); sp = xor32_sum(sp); if (fq == 0) atomicAdd(tg, sp); }
                }
                if (m == 3) asm volatile("" ::: "memory");
            }
    }
};

struct ChainOrder {
    StaticOrder base;
    __device__ bool next(int j, Unit& u) const {
        const int i = j / 3, gi = j - 3 * i; Unit t;
        if (!base.next(i, t)) return false;
        u.pm = t.pm; u.pn = gi * 8 + t.pn; u.aoff = (gi == 0) ? C_CA : (gi == 1) ? C_OB : C_OC; u.gi = gi; return true;
    }
};
struct EpiChain {
    bf16_t* mg; const bf16_t* proj;
    __device__ __forceinline__ bool zero_after(const Unit& u) const { return u.gi == 2; }
    __device__ __forceinline__ void operator()(f32x4 (&acc)[2][2][4][2], const Unit& u, int wr, int wc, int fr, int fq) const {
        const int pn = u.pn & 7, gi = u.gi;
#pragma unroll
        for (int ai = 0; ai < 2; ++ai)
#pragma unroll
            for (int m = 0; m < 4; ++m) {
                const int row = u.pm * BM + ai * HALF + wr * 64 + m * 16 + fr;
#pragma unroll
                for (int bj = 0; bj < 2; ++bj) {
                    const int col0 = pn * BM + bj * HALF + wc * 32 + 8 * fq;
                    const bf16_t* gp = proj + (size_t)row * NP + C_G + gi * 2048 + col0;
                    f32x4 g0, g1; unpack8(*(const u32x4*)gp, g0, g1);
                    if (gi < 2) {
                        f32x4 n0, n1; unpack8(*(const u32x4*)(gp + 2048), n0, n1);
#pragma unroll
                        for (int i = 0; i < 4; ++i) { g0[i] *= __builtin_amdgcn_rcpf(fmaxf(n0[i], 1e-30f)); g1[i] *= __builtin_amdgcn_rcpf(fmaxf(n1[i], 1e-30f)); }
                        acc[ai][bj][m][0] *= g0; acc[ai][bj][m][1] *= g1;
                    } else {
                        *(u32x4*)(mg + (size_t)row * DM + col0) = pack8(acc[ai][bj][m][0] * g0, acc[ai][bj][m][1] * g1);
                    }
                }
                if (m == 3) asm volatile("" ::: "memory");
            }
    }
};

template <class Epi, class Sched>
__device__ __forceinline__ void gemm_phase(LAS unsigned char* lds, const Gemm g, const Sched& S, const Epi& E, const int tid) {
    const int wid = __builtin_amdgcn_readfirstlane(tid >> 6), lane = tid & 63, wr = wid >> 2, wc = wid & 3, fr = lane & 15, fq = lane >> 4;
    const int K = g.K, nt = K / BK;
    unsigned voffA[2], voffB[2];
#pragma unroll
    for (int i = 0; i < 2; ++i) { int R, C; stage_rc(tid * 16 + i * 8192, R, C); const int Rb = (R & ~31) + perm32(R & 31);
        voffA[i] = (unsigned)(R * g.lda + C) * 2u; voffB[i] = (unsigned)(Rb * g.ldb + C) * 2u; }
    const size_t kstep = (size_t)(BK * 2);
    const size_t hstepA = (size_t)HALF * g.lda * 2, hstepB = (size_t)HALF * g.ldb * 2, tstepA = 2 * hstepA, tstepB = 2 * hstepB;
    const unsigned ldsw = (unsigned)wid * 1024u;
    const int aoff = lds_byte(wr * 64 + fr, fq * 8), boff = lds_byte(wc * 32 + fr, fq * 8);
#define PG8_SA(b, h) (((b) * 2 + (h)) * HTB)
#define PG8_SB(b, h) ((4 + (b) * 2 + (h)) * HTB)
#define PG8_STAGE(bufoff, gbase, voff) do { _Pragma("unroll") for (int _i = 0; _i < 2; ++_i) \
        __builtin_amdgcn_global_load_lds((const unsigned*)((const char*)(gbase) + (voff)[_i]), (LAS unsigned*)(lds + (bufoff) + ldsw + _i * 8192), 16, 0, 0); } while (0)
#define PG8_LDA(dst, b, h) do { _Pragma("unroll") for (int m = 0; m < 4; ++m) _Pragma("unroll") for (int k = 0; k < 2; ++k) dst[m][k] = *(const LAS bf16x8*)(lds + PG8_SA(b, h) + aoff + m * 2048 + k * 1024); } while (0)
#define PG8_LDB(dst, b, h) do { _Pragma("unroll") for (int n = 0; n < 2; ++n) _Pragma("unroll") for (int k = 0; k < 2; ++k) dst[n][k] = *(const LAS bf16x8*)(lds + PG8_SB(b, h) + boff + n * 2048 + k * 1024); } while (0)
#define PG8_MMA(ai, bj, At, Bt) do { __builtin_amdgcn_s_setprio(1); _Pragma("unroll") for (int m = 0; m < 4; ++m) _Pragma("unroll") for (int n = 0; n < 2; ++n) _Pragma("unroll") for (int k = 0; k < 2; ++k) \
        acc[ai][bj][m][n] = __builtin_amdgcn_mfma_f32_16x16x32_bf16(Bt[n][k], At[m][k], acc[ai][bj][m][n], 0, 0, 0); __builtin_amdgcn_s_setprio(0); } while (0)
#define PG8_WAIT_V(n) asm volatile("s_waitcnt vmcnt(" #n ")" ::: "memory")
#define PG8_WAIT_L(n) asm volatile("s_waitcnt lgkmcnt(" #n ")" ::: "memory")
#define PG8_BAR __builtin_amdgcn_s_barrier()
#define PG8_SCHED __builtin_amdgcn_sched_barrier(0)
    Unit cur, nxt; int ui = 0;
    if (!S.next(0, cur)) return;
    f32x4 acc[2][2][4][2];
#pragma unroll
    for (int a = 0; a < 2; ++a)
#pragma unroll
        for (int b = 0; b < 2; ++b)
#pragma unroll
            for (int m = 0; m < 4; ++m)
#pragma unroll
                for (int n = 0; n < 2; ++n) acc[a][b][m][n] = (f32x4){0.f, 0.f, 0.f, 0.f};
    bf16x8 At[4][2], B0[2][2], B1[2][2];
    const char* cA = (const char*)g.A + (size_t)cur.pm * tstepA + (size_t)cur.aoff * 2; const char* cB = (const char*)g.Bt + (size_t)cur.pn * tstepB;
    PG8_STAGE(PG8_SB(0, 0), cB, voffB); PG8_STAGE(PG8_SB(0, 1), cB + hstepB, voffB); PG8_STAGE(PG8_SA(0, 0), cA, voffA); PG8_STAGE(PG8_SA(0, 1), cA + hstepA, voffA);
    if (wr == 1) PG8_BAR;
    PG8_WAIT_V(2); PG8_BAR;
    PG8_STAGE(PG8_SB(1, 0), cB + kstep, voffB); PG8_STAGE(PG8_SA(1, 0), cA + kstep, voffA); PG8_STAGE(PG8_SB(1, 1), cB + hstepB + kstep, voffB);
    PG8_WAIT_V(6); PG8_BAR;
    for (;;) {
        const bool has_next = S.next(ui + 1, nxt);
        const char* nA = has_next ? (const char*)g.A + (size_t)nxt.pm * tstepA + (size_t)nxt.aoff * 2 : cA; const char* nB = has_next ? (const char*)g.Bt + (size_t)nxt.pn * tstepB : cB;
        for (int t = 0; t < nt; t += 2) {
            const bool last = (t == nt - 2);
            const char* a1 = cA + (size_t)(t + 1) * kstep;
            const char* a2 = last ? nA : cA + (size_t)(t + 2) * kstep; const char* b2 = last ? nB : cB + (size_t)(t + 2) * kstep;
            const char* a3 = a2 + kstep; const char* b3 = b2 + kstep;
            PG8_LDB(B0, 0, 0); PG8_LDB(B1, 0, 1); PG8_SCHED; PG8_LDA(At, 0, 0); PG8_STAGE(PG8_SA(1, 1), a1 + hstepA, voffA);
            PG8_WAIT_V(8); PG8_WAIT_L(0); PG8_BAR; PG8_MMA(0, 0, At, B0); PG8_MMA(0, 1, At, B1); PG8_BAR; PG8_SCHED;
            PG8_LDA(At, 0, 1); PG8_STAGE(PG8_SB(0, 0), b2, voffB); PG8_STAGE(PG8_SB(0, 1), b2 + hstepB, voffB); PG8_STAGE(PG8_SA(0, 0), a2, voffA);
            PG8_WAIT_V(8); PG8_WAIT_L(0); PG8_BAR; PG8_MMA(1, 0, At, B0); PG8_MMA(1, 1, At, B1); PG8_BAR; PG8_SCHED;
            PG8_LDB(B0, 1, 0); PG8_LDB(B1, 1, 1); PG8_SCHED; PG8_LDA(At, 1, 0); PG8_STAGE(PG8_SA(0, 1), a2 + hstepA, voffA);
            PG8_WAIT_V(8); PG8_WAIT_L(0); PG8_BAR; PG8_MMA(0, 0, At, B0); PG8_MMA(0, 1, At, B1); PG8_BAR; PG8_SCHED;
            PG8_LDA(At, 1, 1); PG8_STAGE(PG8_SB(1, 0), b3, voffB); PG8_STAGE(PG8_SB(1, 1), b3 + hstepB, voffB); PG8_STAGE(PG8_SA(1, 0), a3, voffA);
            PG8_WAIT_V(8); PG8_WAIT_L(0); PG8_BAR; PG8_MMA(1, 0, At, B0); PG8_MMA(1, 1, At, B1); PG8_BAR; PG8_SCHED;
        }
        if (wr == 0) PG8_BAR;
        E(acc, cur, wr, wc, fr, fq);
        if (!has_next) break;
        if (E.zero_after(cur))
#pragma unroll
        for (int a = 0; a < 2; ++a)
#pragma unroll
            for (int b = 0; b < 2; ++b)
#pragma unroll
                for (int m = 0; m < 4; ++m)
#pragma unroll
                    for (int n = 0; n < 2; ++n) acc[a][b][m][n] = (f32x4){0.f, 0.f, 0.f, 0.f};
        cur = nxt; cA = nA; cB = nB; ++ui;
        if (wr == 1) PG8_BAR;
    }
    PG8_WAIT_V(0);
    PG8_BAR;
#undef PG8_SA
#undef PG8_SB
#undef PG8_STAGE
#undef PG8_LDA
#undef PG8_LDB
#undef PG8_MMA
#undef PG8_WAIT_V
#undef PG8_WAIT_L
#undef PG8_BAR
#undef PG8_SCHED
}
}

__device__ __forceinline__ void glds16(const void* gsrc, unsigned lds_dst) { unsigned keep;
    asm volatile("s_mov_b32 %0, m0\n\ts_mov_b32 m0, %2\n\ts_nop 0\n\tglobal_load_lds_dwordx4 %1, off\n\ts_mov_b32 m0, %0" : "=&s"(keep) : "v"(gsrc), "s"(lds_dst) : "memory"); }
constexpr int ATT_LDS = 65536;
template <bool NOSHIFT> __device__ __forceinline__ void diff_attn_unit(LAS unsigned char* lds, bf16_t* proj, const bf16_t* VT, int b, int h, int qb, const AttnConsts ac, const float* gsub, const int tid, bf16_t* obuf, int opitch, int ocol) {
    const int lane = tid & 63, wid = __builtin_amdgcn_readfirstlane(tid >> 6), wq = wid & 3, c = wid >> 2, i32 = lane & 31, hi = lane >> 5;
    const size_t rowbase = (size_t)b * SEQ; const int q0 = qb * 128, qrow = q0 + 32 * wq + i32;
    bf16x8 qf[4];
    { const bf16_t* qp = proj + (rowbase + qrow) * NP + C_DQ + h * 128 + c * 64 + hi * 8;
#pragma unroll
      for (int ks = 0; ks < 4; ++ks) qf[ks] = *(const bf16x8*)(qp + 16 * ks); }
    const unsigned lds0 = (unsigned)(uintptr_t)lds;
    const int krow_s = 4 * wid + (lane >> 4), vd_s = 8 * wid + (lane >> 3);
    const bf16_t* kg = proj + (rowbase + krow_s) * NP + C_DK + h * 128 + (((lane & 15) ^ (krow_s & 15)) * 8);
    const bf16_t* vg = VT + (size_t)(h * 128 + vd_s) * TOK + rowbase + (((lane & 7) ^ ((vd_s >> 1) & 7)) * 8);
    const unsigned kdst = lds0 + wid * 1024, vdst = lds0 + 65536 + wid * 1024;
#define ATT_ISSUE(tt) do { const unsigned so_ = ((tt) & 3) * 16384; const bf16_t* kp_ = kg + (size_t)(tt) * 64 * NP; const bf16_t* vp_ = vg + (size_t)(tt) * 64; \
        glds16(kp_, (unsigned)__builtin_amdgcn_readfirstlane(kdst + so_)); glds16(kp_ + (size_t)32 * NP, (unsigned)__builtin_amdgcn_readfirstlane(kdst + so_ + 8192)); \
        glds16(vp_, (unsigned)__builtin_amdgcn_readfirstlane(vdst + so_)); glds16(vp_ + (size_t)64 * TOK, (unsigned)__builtin_amdgcn_readfirstlane(vdst + so_ + 8192)); } while (0)
#define ATT_WAITBAR(N) asm volatile("s_waitcnt vmcnt(" #N ") lgkmcnt(0)\n\ts_barrier" ::: "memory")
    const int krow = pi32(i32);
    int koff[2][4];
#pragma unroll
    for (int mt = 0; mt < 2; ++mt)
#pragma unroll
        for (int ks = 0; ks < 4; ++ks) { const int r = 32 * mt + krow; koff[mt][ks] = r * 256 + (((8 * c + 2 * ks + hi) ^ (r & 15)) * 16); }
    const int NT = 2 * qb + 2;
    f32x16 o[4];
#pragma unroll
    for (int dt = 0; dt < 4; ++dt)
#pragma unroll
        for (int r = 0; r < 16; ++r) o[dt][r] = 0.f;
    float l = 0.f;
    bf16x8 pf[4];
#pragma unroll
    for (int kk = 0; kk < 4; ++kk) pf[kk] = (bf16x8){0, 0, 0, 0, 0, 0, 0, 0};
    const int qmax = q0 + 32 * wq + 31;
#define ATT_LDV(dst, slot, kk) do { _Pragma("unroll") for (int dt = 0; dt < 4; ++dt) { const int d = 32 * dt + i32; \
        dst[dt] = *(const LAS bf16x8*)(lds + 65536 + (slot) + d * 128 + (((2 * (kk) + hi) ^ ((d >> 1) & 7)) * 16)); } } while (0)
#define ATT_MMV(src, kk) do { __builtin_amdgcn_s_setprio(1); _Pragma("unroll") for (int dt = 0; dt < 4; ++dt) o[dt] = __builtin_amdgcn_mfma_f32_32x32x16_bf16(src[dt], pf[kk], o[dt], 0, 0, 0); __builtin_amdgcn_s_setprio(0); } while (0)
#define ATT_SB __builtin_amdgcn_sched_barrier(0)
#define ATT_PV(slot) do { bf16x8 va[4], vb[4]; ATT_LDV(va, slot, 0); ATT_SB; ATT_LDV(vb, slot, 1); ATT_SB; ATT_MMV(va, 0); ATT_SB; ATT_LDV(va, slot, 2); ATT_SB; ATT_MMV(vb, 1); ATT_SB; \
        ATT_LDV(vb, slot, 3); ATT_SB; ATT_MMV(va, 2); ATT_SB; ATT_MMV(vb, 3); ATT_SB; } while (0)
    ATT_ISSUE(0); ATT_ISSUE(1);
    ATT_WAITBAR(4);
    for (int t = 0; t < NT; ++t) {
        const int bo = (t & 3) * 16384, sl_cur = bo, sl_prev = ((t - 1) & 3) * 16384;
        if (t + 2 < NT) ATT_ISSUE(t + 2);
        const int kv0 = 64 * t;
        if (c == 1 && t >= 1 && kv0 - 64 <= qmax) ATT_PV(sl_prev);
        if (kv0 <= qmax) {
            f32x16 p[2];
            bf16x8 kf[2][4];
#pragma unroll
            for (int mt = 0; mt < 2; ++mt)
#pragma unroll
                for (int ks = 0; ks < 4; ++ks) kf[mt][ks] = *(const LAS bf16x8*)(lds + bo + koff[mt][ks]);
            if constexpr (!NOSHIFT) {
#pragma unroll
                for (int mt = 0; mt < 2; ++mt)
#pragma unroll
                    for (int r = 0; r < 16; ++r) p[mt][r] = -ac.Mfix;
            }
            ATT_SB;
            __builtin_amdgcn_s_setprio(1);
#pragma unroll
            for (int ks = 0; ks < 4; ++ks)
#pragma unroll
                for (int mt = 0; mt < 2; ++mt) {
                    if (NOSHIFT && ks == 0) { const f32x16 z = {0.f, 0.f, 0.f, 0.f, 0.f, 0.f, 0.f, 0.f, 0.f, 0.f, 0.f, 0.f, 0.f, 0.f, 0.f, 0.f}; p[mt] = __builtin_amdgcn_mfma_f32_32x32x16_bf16(kf[mt][ks], qf[ks], z, 0, 0, 0); }
                    else p[mt] = __builtin_amdgcn_mfma_f32_32x32x16_bf16(kf[mt][ks], qf[ks], p[mt], 0, 0, 0);
                }
            __builtin_amdgcn_s_setprio(0);
            ATT_SB;
            const bool diag = (t >= 2 * qb);
            if (diag) {
                const int qrel = qrow - kv0 - 8 * hi;
#pragma unroll
                for (int mt = 0; mt < 2; ++mt)
#pragma unroll
                    for (int r = 0; r < 16; ++r) { float v = __builtin_amdgcn_exp2f(p[mt][r]); if (32 * mt + 16 * (r >> 3) + (r & 7) > qrel) v = 0.f; p[mt][r] = v; l += v; }
            } else {
#pragma unroll
                for (int mt = 0; mt < 2; ++mt)
#pragma unroll
                    for (int r = 0; r < 16; ++r) { const float v = __builtin_amdgcn_exp2f(p[mt][r]); p[mt][r] = v; l += v; }
            }
            asm volatile("" ::: "memory");
#pragma unroll
            for (int kk = 0; kk < 4; ++kk) { const int mt = kk >> 1, r0 = 8 * (kk & 1); u32x4 w;
                w.x = pk2(p[mt][r0], p[mt][r0 + 1]); w.y = pk2(p[mt][r0 + 2], p[mt][r0 + 3]); w.z = pk2(p[mt][r0 + 4], p[mt][r0 + 5]); w.w = pk2(p[mt][r0 + 6], p[mt][r0 + 7]);
                pf[kk] = __builtin_bit_cast(bf16x8, w); }
            if (c == 0) ATT_PV(sl_cur);
        }
        if (t + 2 < NT) ATT_WAITBAR(4); else ATT_WAITBAR(0);
    }
    if (c == 1 && 64 * (NT - 1) <= qmax) ATT_PV(((NT - 1) & 3) * 16384);
#undef ATT_ISSUE
#undef ATT_WAITBAR
#undef ATT_PV
#undef ATT_LDV
#undef ATT_MMV
#undef ATT_SB
    l = xor32_sum(l);
    const float inv = 1.f / l;
    LAS float* xch = (LAS float*)lds + (size_t)wq * 4096 + lane;
    if (c == 1) {
#pragma unroll
        for (int dt = 0; dt < 4; ++dt)
#pragma unroll
            for (int r = 0; r < 16; ++r) xch[(dt * 16 + r) * 64] = o[dt][r] * inv;
    }
    __syncthreads();
    if (c == 0) {
        float ss = 0.f;
#pragma unroll
        for (int dt = 0; dt < 4; ++dt)
#pragma unroll
            for (int r = 0; r < 16; ++r) { const float v = o[dt][r] * inv - ac.lam * xch[(dt * 16 + r) * 64]; o[dt][r] = v; ss += v * v; }
        ss = xor32_sum(ss);
        const float rs = rs_of(ss, 1.f / 128) * ac.osc;
        bf16_t* op = obuf + (rowbase + qrow) * opitch + ocol + h * 128;
#pragma unroll
        for (int dt = 0; dt < 4; ++dt)
#pragma unroll
            for (int rg = 0; rg < 4; ++rg) { const int d = 32 * dt + 8 * rg + 4 * hi; const f32x4 g = *(const f32x4*)(gsub + d);
                u32x2 w; w.x = pk2(o[dt][4 * rg] * rs * g.x, o[dt][4 * rg + 1] * rs * g.y); w.y = pk2(o[dt][4 * rg + 2] * rs * g.z, o[dt][4 * rg + 3] * rs * g.w);
                *(u32x2*)(op + d) = w; }
    }
    __syncthreads();
}

__device__ __forceinline__ int maprow(int mode, int n) {
    if (mode == 1) { if (n < 5120) return n; if (n < 6144) return 12288 + (n - 5120); if (n < 7168) return 5120 + (n - 6144); return 6144 + (n - 7168); }
    if (mode == 2) { if (n < DFF) return (n >> 7) * 256 + (n & 127); const int m = n - DFF; return (m >> 7) * 256 + 128 + (m & 127); }
    return n;
}
__device__ __forceinline__ void conv_item(const float* W, int K, int N, bf16_t* Wt, const float* g, int mode, int item, int lane) {
    const int nkc = K >> 7, nb = item / nkc, kc = item - nb * nkc, n0 = nb * 64, k0 = kc * 128, kgp = lane >> 4, nq = lane & 15;
    const int drow = maprow(mode, n0) + 4 * nq;
#pragma unroll 2
    for (int it = 0; it < 4; ++it) {
        const int kb = k0 + it * 32 + kgp * 8;
        f32x4 v[8];
#pragma unroll
        for (int j = 0; j < 8; ++j) v[j] = *(const f32x4*)(W + (size_t)(kb + j) * N + n0 + 4 * nq);
        if (g) {
            const f32x4 g0 = *(const f32x4*)(g + kb), g1 = *(const f32x4*)(g + kb + 4);
#pragma unroll
            for (int j = 0; j < 4; ++j) { v[j] *= g0[j]; v[4 + j] *= g1[j]; }
        }
#pragma unroll
        for (int i = 0; i < 4; ++i) {
            u32x4 o; o.x = pk2(v[0][i], v[1][i]); o.y = pk2(v[2][i], v[3][i]); o.z = pk2(v[4][i], v[5][i]); o.w = pk2(v[6][i], v[7][i]);
            *(u32x4*)(Wt + (size_t)(drow + i) * K + kb) = o;
        }
    }
}
__device__ __forceinline__ void row_to_bf16(const float* xr, bf16_t* orow, float* ssout, int lane) {
    float s = 0.f;
#pragma unroll
    for (int j = 0; j < 8; ++j) { const f32x4 v = *(const f32x4*)(xr + 4 * lane + 256 * j); s += sum4(v * v);
        u32x2 w; w.x = pk2(v.x, v.y); w.y = pk2(v.z, v.w); *(u32x2*)(orow + 4 * lane + 256 * j) = w; }
    s = wave_sum(s);
    if (lane == 0) *ssout = s;
}

#define XB_TMO      128
#define XB_XCNT(j)  (256  + 64 * (j))
#define XB_XSUB(j)  (1280 + 64 * (j))
#define XB_XGEN(j)  (2304 + 64 * (j))
#define XB_TOP      3328
#define XB_TOPGEN   3392
#define XCD_BAR_WORDS 3456
#define XB_SPIN_CAP (1u << 18)
__device__ __forceinline__ unsigned xb_ld(unsigned* p)              { return __hip_atomic_load(p, __ATOMIC_RELAXED, __HIP_MEMORY_SCOPE_AGENT); }
__device__ __forceinline__ unsigned xb_add(unsigned* p, unsigned v) { return __hip_atomic_fetch_add(p, v, __ATOMIC_RELAXED, __HIP_MEMORY_SCOPE_AGENT); }
__device__ __forceinline__ unsigned xb_xcc_id() { return (unsigned)__builtin_amdgcn_s_getreg((3 << 11) | 20) & 0xFu; }
#define XB_SPIN(cond, bar) do { unsigned _sp = 0; while (cond) { __builtin_amdgcn_s_sleep(1); \
    if ((++_sp & 255u) == 0u) { if (xb_ld(&(bar)[XB_TMO])) break; if (_sp > XB_SPIN_CAP) { atomicAdd(&(bar)[XB_TMO], 1u); break; } } } } while (0)
struct XcdBarrier { unsigned* bar; unsigned x; volatile LAS unsigned* st; };
__device__ __forceinline__ XcdBarrier xcd_barrier_post(unsigned* bar, volatile LAS unsigned* st) {
    XcdBarrier b; b.bar = bar; b.x = xb_xcc_id(); b.st = st;
    if (threadIdx.x == 0) (void)xb_add(&bar[XB_XCNT(b.x)], 1u);
    return b;
}
__device__ __forceinline__ void xcd_barrier_complete(unsigned* bar, unsigned x, unsigned& nloc, unsigned& nx) {
    const unsigned G = gridDim.x * gridDim.y * gridDim.z;
    unsigned sum, cnt, mine, sp = 0u;
    for (;;) {
        sum = 0u; cnt = 0u; mine = 0u;
#pragma unroll
        for (unsigned j = 0; j < 16; ++j) { const unsigned c = xb_ld(&bar[XB_XCNT(j)]); sum += c; cnt += (c > 0u) ? 1u : 0u; mine = (j == x) ? c : mine; }
        if (sum == G) break;
        __builtin_amdgcn_s_sleep(1);
        if ((++sp & 255u) == 0u) { if (xb_ld(&bar[XB_TMO])) break; if (sp > XB_SPIN_CAP) { atomicAdd(&bar[XB_TMO], 1u); break; } }
    }
    nloc = mine > 0u ? mine : 1u; nx = cnt > 0u ? cnt : 1u;
}
__device__ __forceinline__ void xcd_barrier(const XcdBarrier& b) {
    asm volatile("s_waitcnt vmcnt(0)" ::: "memory");
    __syncthreads();
    if (threadIdx.x == 0) {
        unsigned* bar = b.bar;
        __builtin_amdgcn_s_waitcnt(0);
        unsigned nloc = b.st[0], nx = b.st[1];
        if (nloc == 0u) { xcd_barrier_complete(bar, b.x, nloc, nx); b.st[0] = nloc; b.st[1] = nx; }
        const unsigned old = xb_add(&bar[XB_XSUB(b.x)], 1u);
        const unsigned gen = old / nloc;
        if (old + 1u == (gen + 1u) * nloc) {
            __builtin_amdgcn_fence(__ATOMIC_RELEASE, "agent");
            asm volatile("s_waitcnt vmcnt(0)" ::: "memory");
            const unsigned og = xb_add(&bar[XB_TOP], 1u);
            const unsigned tg = og / nx;
            if (og + 1u == (tg + 1u) * nx) xb_add(&bar[XB_TOPGEN], 1u);
            else XB_SPIN(xb_ld(&bar[XB_TOPGEN]) == tg, bar);
            __builtin_amdgcn_fence(__ATOMIC_ACQUIRE, "agent");
            xb_add(&bar[XB_XGEN(b.x)], 1u);
            asm volatile("s_waitcnt vmcnt(0)" ::: "memory");
        } else {
            XB_SPIN(xb_ld(&bar[XB_XGEN(b.x)]) == gen, bar);
            __builtin_amdgcn_fence(__ATOMIC_ACQUIRE, "agent");
            asm volatile("s_waitcnt vmcnt(0)" ::: "memory");
        }
    }
    __syncthreads();
}

struct Args { const void* in[21]; float* out; unsigned char* ws; int lo, hi, flags, pad; };
constexpr int NPHASE = 16;
constexpr int FL_SKIP_MEMKV = 1, FL_SKIP_ATTN = 2, FL_SKIP_CROSS = 4, FL_SKIP_MAIN = 8, FL_XCDBAR = 16;
constexpr int LDS_BYTES = pg8::STAGE_BYTES + 2048;
constexpr size_t WS_BAR = 1400 * KiB, WS_BAR_BYTES = 16 * KiB;

__global__ void __launch_bounds__(512, 2) mega(Args args) {
    extern __shared__ __attribute__((aligned(16))) unsigned char lds_raw[];
    LAS unsigned char* lds = (LAS unsigned char*)lds_raw;
    cg::grid_group grid = cg::this_grid();
    constexpr int G = 256;
    const int wave0 = __builtin_amdgcn_readfirstlane(threadIdx.x >> 6);
    volatile LAS unsigned* bst = (volatile LAS unsigned*)(lds + pg8::STAGE_BYTES + 1024);
    if (threadIdx.x < 2) bst[threadIdx.x] = 0u;
    __syncthreads();
    XcdBarrier xbar; xbar.bar = (unsigned*)(args.ws + WS_BAR); xbar.x = 0; xbar.st = bst;
    if (args.flags & FL_XCDBAR) xbar = xcd_barrier_post((unsigned*)(args.ws + WS_BAR), bst);
    for (int ph = args.lo; ph < args.hi; ++ph) {
        int bx_ = blockIdx.x; asm volatile("" : "+s"(bx_)); const int bx = bx_, vcu = (bx % 8) * (G / 8) + bx / 8;
        unsigned char* ws = args.ws; asm volatile("" : "+s"(ws));
        constexpr int NGW = G * 8;
        const float* x_in = (const float*)args.in[0]; const float* mem = (const float*)args.in[1]; const int* positions = (const int*)args.in[2];
        float* xcur = args.out;
        float* ssb = (float*)(ws + WS_SS); float* qssb = (float*)(ws + WS_QSS); float* lsumb = (float*)(ws + WS_LSUM); float* kssb = (float*)(ws + WS_KSS); float* ssmem = (float*)(ws + WS_SSMEM);
        float* cs = (float*)(ws + WS_CS); float* xsh = (float*)(ws + WS_XSH);
        bf16_t* memb = (bf16_t*)(ws + WS_MEMB); bf16_t* mkraw = (bf16_t*)(ws + WS_MKRAW); bf16_t* mvT = (bf16_t*)(ws + WS_MVT);
        bf16_t* Win_t = (bf16_t*)(ws + WS_WIN); bf16_t* Wc_t = (bf16_t*)(ws + WS_WC); bf16_t* Wd_t = (bf16_t*)(ws + WS_WD); bf16_t* Wx_t = (bf16_t*)(ws + WS_WX);
        bf16_t* Wmkv_t = (bf16_t*)(ws + WS_WMKV); bf16_t* Wo_t = (bf16_t*)(ws + WS_WO); bf16_t* Wgu_t = (bf16_t*)(ws + WS_WGU); bf16_t* Wdn_t = (bf16_t*)(ws + WS_WDN);
        bf16_t* proj = (bf16_t*)(ws + WS_PROJ); bf16_t* VT = (bf16_t*)(ws + WS_VT); bf16_t* xb = (bf16_t*)(ws + WS_XB); bf16_t* mg = (bf16_t*)(ws + WS_MG); bf16_t* hb = (bf16_t*)(ws + WS_H);

        const int l = ph >> 3, p = ph & 7;
        const int wave = wave0, gw = vcu * 8 + wave;
#define PHASE_TID() const int tid = phase_tid(wave0), lane = tid & 63
        const float* gq_x = (const float*)args.in[14] + l * 256; const float* gk_x = (const float*)args.in[15] + l * 256;
        float* qss = qssb + (size_t)l * TOK * 4; float* lsum = lsumb + (size_t)l * TOK * 4; float* kss = kssb + l * 2048;
        if (p == 0) {
            PHASE_TID();
            const float* g_mix = (const float*)args.in[3] + l * DM; const float* g_mem = (const float*)args.in[12] + l * DM; const float* g_ffn = (const float*)args.in[18] + l * DM;
            const float* w_in = (const float*)args.in[4] + (size_t)l * DM * NIN; const float* w_co = (const float*)args.in[6] + (size_t)l * 1024 * DM;
            const float* w_do = (const float*)args.in[11] + (size_t)l * 1024 * DM; const float* w_mkv = (const float*)args.in[13] + (size_t)l * DM * 2048;
            const float* w_xo = (const float*)args.in[16] + (size_t)l * 1024 * DM; const float* w_o = (const float*)args.in[17] + (size_t)l * DM * DM;
            const float* w_gu = (const float*)args.in[19] + (size_t)l * DM * 2 * DFF; const float* w_dn = (const float*)args.in[20] + (size_t)l * DFF * DM;
            constexpr int I_IN = (NIN / 64) * (DM / 128), I_B = (DM / 64) * (1024 / 128), I_SQ = (DM / 64) * (DM / 128), I_GU = (2 * DFF / 64) * (DM / 128), I_DN = (DM / 64) * (DFF / 128);
            constexpr int NIT = I_IN + 3 * I_B + 2 * I_SQ + I_GU + I_DN;
#pragma unroll 1
            for (int rep = 0; rep < REP_P0; ++rep)
            for (int it = gw; it < NIT; it += NGW) {
                int r = it;
                if (r < I_IN) { conv_item(w_in, DM, NIN, Win_t, g_mix, 1, r, lane); continue; } r -= I_IN;
                if (r < I_GU) { conv_item(w_gu, DM, 2 * DFF, Wgu_t, g_ffn, 2, r, lane); continue; } r -= I_GU;
                if (r < I_DN) { conv_item(w_dn, DFF, DM, Wdn_t, nullptr, 0, r, lane); continue; } r -= I_DN;
                if (r < I_SQ) { conv_item(w_mkv, DM, 2048, Wmkv_t, g_mem, 0, r, lane); continue; } r -= I_SQ;
                if (r < I_SQ) { conv_item(w_o, DM, DM, Wo_t, nullptr, 0, r, lane); continue; } r -= I_SQ;
                if (r < I_B) { conv_item(w_co, 1024, DM, Wc_t, nullptr, 0, r, lane); continue; } r -= I_B;
                if (r < I_B) { conv_item(w_do, 1024, DM, Wd_t, nullptr, 0, r, lane); continue; } r -= I_B;
                conv_item(w_xo, 1024, DM, Wx_t, nullptr, 0, r, lane);
            }
            if (l == 0) {
                for (int m = gw; m < TOK; m += NGW) row_to_bf16(x_in + (size_t)m * DM, xb + (size_t)m * DM, ssb + m, lane);
                for (int m = gw; m < BATCH * MEMLEN; m += NGW) row_to_bf16(mem + (size_t)m * DM, memb + (size_t)m * DM, ssmem + m, lane);
                { unsigned* z = (unsigned*)(ws + WS_ZERO_LO); const int nz = (int)((WS_ZERO_HI - WS_ZERO_LO) / 4);
                  for (int i = bx * 512 + tid; i < nz; i += G * 512) z[i] = 0u; }
                for (int i = bx * 512 + tid; i < TOK * 8; i += G * 512) {
                    const int row = i >> 3, k = i & 7;
                    const float ang = (float)positions[row] * INVF[k];
                    const float kk = rintf(ang * 0.15915494309189535f);
                    float rr = fmaf(-kk, 6.2831854820251465f, ang); rr = fmaf(-kk, -1.7484556000744883e-07f, rr);
                    const float fr = rr * 0.15915494309189535f;
                    cs[row * 16 + k] = __builtin_amdgcn_cosf(fr); cs[row * 16 + 8 + k] = __builtin_amdgcn_sinf(fr);
                }
            }
        } else if (p == 1) {
            PHASE_TID();
            if (PH_EN(1) && !(args.flags & FL_SKIP_MAIN)) {
#pragma unroll 1
                for (int rep = 0; rep < REP_P1; ++rep)
                { pg8::Gemm g{xb, Win_t, TOK, NP, DM, DM, DM}; pg8::StaticOrder S; S.init(TOK, NP, G, bx);
                  pg8::EpiWrap<EIn> E{EIn{proj, ssb + (size_t)(2 * l) * TOK, gq_x, gk_x, rep == REP_P1 - 1 ? qss : nullptr}}; pg8::gemm_phase(lds, g, S, E, phase_tid(wave0)); }
                { pg8::Gemm g{Win_t + (size_t)NP * DM, xb, 1024, TOK, DM, DM, DM}; pg8::StaticOrder S; S.init(1024, TOK, G, bx);
                  pg8::EpiWrap<EColScale> E{EColScale{VT, ssb + (size_t)(2 * l) * TOK, TOK, 0}}; pg8::gemm_phase(lds, g, S, E, phase_tid(wave0)); }
            }
        } else if (p == 2) {
            PHASE_TID();
            const bool do_mkv = !(args.flags & FL_SKIP_MEMKV) && G >= 32;
            if (bx == G - 1 && wave == 0) { const float mx = xattn_shift(gq_x, gk_x, lane); if (lane == 0) xsh[l] = mx; }
#pragma unroll 1
            for (int rep2 = 0; rep2 < REP_P2; ++rep2) { const bool real2 = rep2 == REP_P2 - 1;
            if (PH_EN(2) && do_mkv && bx < 16) {
                if (bx < 8) { pg8::Gemm g{memb, Wmkv_t, 512, 1024, DM, DM, DM}; pg8::StaticOrder S; S.init(512, 1024, 8, bx);
                    pg8::EpiWrap<EMemK> E{EMemK{mkraw, ssmem, real2 ? kss : nullptr}}; pg8::gemm_phase(lds, g, S, E, phase_tid(wave0)); }
                else { pg8::Gemm g{Wmkv_t + (size_t)1024 * DM, memb, 1024, 512, DM, DM, DM}; pg8::StaticOrder S; S.init(1024, 512, 8, bx - 8);
                    pg8::EpiWrap<EColScale> E{EColScale{mvT, ssmem, 512, 0}}; pg8::gemm_phase(lds, g, S, E, phase_tid(wave0)); }
            } else {
                const int nb0 = do_mkv ? 16 : 0, NW2 = (G - nb0) * 8, gw2 = (bx - nb0) * 8 + wave;
                const float* gqd = (const float*)args.in[7] + l * 64; const float* gkd = (const float*)args.in[8] + l * 64; const float* cw = (const float*)args.in[5] + l * 3 * 1024;
#pragma unroll 1
                for (int base = gw2; base < 2 * TOK; base += 4 * NW2) {
                    u32x4 wv[4][2];
#pragma unroll
                    for (int j4 = 0; j4 < 4; ++j4) { const int tk = min(base + j4 * NW2, 2 * TOK - 1);
                        const bf16_t* pp = proj + (size_t)(tk >> 1) * NP + ((tk & 1) ? C_DK : C_DQ) + lane * 16; wv[j4][0] = *(const u32x4*)pp; wv[j4][1] = *(const u32x4*)(pp + 8); }
#pragma unroll
                    for (int j4 = 0; j4 < 4; ++j4) { const int tk = base + j4 * NW2;
                        if (tk < 2 * TOK) {
                            const int row = tk >> 1, which = tk & 1, j = lane & 3;
                            bf16_t* pp = proj + (size_t)row * NP + (which ? C_DK : C_DQ) + lane * 16;
                            f32x4 f0, f1, f2, f3; unpack8(wv[j4][0], f0, f1); unpack8(wv[j4][1], f2, f3);
                            float ss = sum4(f0 * f0) + sum4(f1 * f1) + sum4(f2 * f2) + sum4(f3 * f3);
                            ss += swz_xor<1>(ss); ss += swz_xor<2>(ss);
                            const float rs = rs_of(ss, 1.f / 64);
                            const float* gg = (which ? gkd : gqd) + 16 * j;
                            f0 *= *(const f32x4*)gg * rs; f1 *= *(const f32x4*)(gg + 4) * rs; f2 *= *(const f32x4*)(gg + 8) * rs; f3 *= *(const f32x4*)(gg + 12) * rs;
                            if (j == 0) {
                                const float* cr = cs + (size_t)row * 16;
                                const f32x4 c0 = *(const f32x4*)cr, c1 = *(const f32x4*)(cr + 4), s0 = *(const f32x4*)(cr + 8), s1 = *(const f32x4*)(cr + 12);
                                const f32x4 a0 = f0 * c0 - f2 * s0, a1 = f1 * c1 - f3 * s1, b0 = f2 * c0 + f0 * s0, b1 = f3 * c1 + f1 * s1;
                                f0 = a0; f1 = a1; f2 = b0; f3 = b1;
                            }
                            if (!which) { const float sc = 0.125f * LOG2E; f0 *= sc; f1 *= sc; f2 *= sc; f3 *= sc; }
                            bf16_t* po = real2 ? pp : mg + (size_t)row * DM + lane * 16; *(u32x4*)po = pack8(f0, f1); *(u32x4*)(po + 8) = pack8(f2, f3);
                        } }
                }
#pragma unroll 1
                for (int base = gw2; base < 2 * TOK; base += 2 * NW2) {
                    u32x4 vc[2][3], vx[2][3], vb[2];
#pragma unroll
                    for (int j2 = 0; j2 < 2; ++j2) { const int tk = min(base + j2 * NW2, 2 * TOK - 1);
                        const int id = tk * 64 + lane, row = id >> 7, ch = (id & 127) * 8, sq = row & (SEQ - 1); const bf16_t* pr = proj + (size_t)row * NP;
#pragma unroll
                        for (int jj = 0; jj < 3; ++jj) { const bf16_t* q = pr - (size_t)((sq - 2 + jj >= 0) ? (2 - jj) : 0) * NP; vc[j2][jj] = *(const u32x4*)(q + C_CC + ch); vx[j2][jj] = *(const u32x4*)(q + C_CX + ch); }
                        vb[j2] = *(const u32x4*)(pr + C_CB + ch); }
#pragma unroll
                    for (int j2 = 0; j2 < 2; ++j2) { const int tk = base + j2 * NW2;
                        if (tk < 2 * TOK) { const int id = tk * 64 + lane, row = id >> 7, ch = (id & 127) * 8, sq = row & (SEQ - 1);
                            f32x4 u0 = {0.f, 0.f, 0.f, 0.f}, u1 = u0;
#pragma unroll
                            for (int jj = 0; jj < 3; ++jj) {
                                if (sq - 2 + jj >= 0) { f32x4 a0, a1, b0, b1; unpack8(vc[j2][jj], a0, a1); unpack8(vx[j2][jj], b0, b1);
                                    u0 += *(const f32x4*)(cw + jj * 1024 + ch) * (a0 * b0); u1 += *(const f32x4*)(cw + jj * 1024 + ch + 4) * (a1 * b1); } }
                            f32x4 g0, g1; unpack8(vb[j2], g0, g1);
                            *(u32x4*)(real2 ? proj + (size_t)row * NP + C_CA + ch : mg + (size_t)row * DM + 1024 + ch) = pack8(g0 * u0, g1 * u1);
                        } }
                }
            }
            }
        } else if (p == 3) {
            PHASE_TID();
            if (PH_EN(3) && !(args.flags & FL_SKIP_ATTN)) {
                const AttnConsts ac = attn_consts((const float*)args.in[7] + l * 64, (const float*)args.in[8] + l * 64, (const float*)args.in[9] + l * 256, l, lane);
                const float* gsub = (const float*)args.in[10] + l * 128;
#pragma unroll 1
                for (int rep = 0; rep < REP_ATTN; ++rep) {
                    const bool real = (rep == REP_ATTN - 1);
                    const int v = vcu, bh = v >> 4, s = v & 15;
#pragma unroll 1
                    for (int i = 0; i < 4; ++i) { const int qb = (i == 0) ? 63 - s : (i == 1) ? 32 + s : (i == 2) ? 31 - s : s;
                        if (ac.Mfix <= 40.f) diff_attn_unit<true>(lds, proj, VT, bh >> 3, bh & 7, qb, ac, gsub, phase_tid(wave0), real ? proj : mg, real ? NP : DM, real ? C_OB : 0);
                        else diff_attn_unit<false>(lds, proj, VT, bh >> 3, bh & 7, qb, ac, gsub, phase_tid(wave0), real ? proj : mg, real ? NP : DM, real ? C_OB : 0); }
                }
            }
            if (PH_EN(8) && !(args.flags & FL_SKIP_CROSS)) {
#pragma unroll 1
                for (int repx = 0; repx < REP_X; ++repx) {
                    const int u = bx; const bool realx = repx == REP_X - 1;
                    const int b = u >> 7, h = (u >> 5) & 3, qb = u & 31;
                    { pg8::Gemm g{proj + C_XQ + h * 256, mkraw + (size_t)(b * 256) * 1024 + h * 256, TOK, 256, 256, NP, 1024};
                      LAS float* rkl = (LAS float*)(lds + pg8::STAGE_BYTES);
                      if (tid < 256) rkl[tid] = rs_of(kss[(b * 256 + tid) * 4 + h], 1.f / 256);
                      __syncthreads();
                      pg8::OneUnit S{{b * 32 + qb, 0, 0, 0}, true}; pg8::EpiWrap<EXs<true>> E{EXs<true>{proj, qss, kss, realx ? lsum : nullptr, xsh + l, (unsigned)(uintptr_t)rkl, b, h, LOG2E / 16.f}}; pg8::gemm_phase(lds, g, S, E, phase_tid(wave0)); }
                    __threadfence(); __syncthreads();
                    { pg8::Gemm g{proj + C_P + h * 256, mvT + (size_t)(h * 256) * 512 + b * 256, TOK, 256, 256, NP, 512};
                      pg8::OneUnit S{{b * 32 + qb, 0, 0, 0}, true}; pg8::EpiWrap<EXo> E{EXo{proj, lsum, h, 0}}; pg8::gemm_phase(lds, g, S, E, phase_tid(wave0)); }
                }
            }
        } else if (p == 4) {
            PHASE_TID();
            if (PH_EN(4) && !(args.flags & FL_SKIP_MAIN)) {
#pragma unroll 1
                for (int rep = 0; rep < REP_P4; ++rep) {
                    pg8::Gemm g{proj, Wc_t, TOK, DM, 1024, NP, 1024}; pg8::ChainOrder S; S.base.init(TOK, DM, G, bx);
                    pg8::EpiChain E{mg, proj}; pg8::gemm_phase(lds, g, S, E, phase_tid(wave0));
                }
            }
        } else if (p == 5) {
            PHASE_TID();
            if (PH_EN(5) && !(args.flags & FL_SKIP_MAIN)) {
#pragma unroll 1
                for (int rep = 0; rep < REP_P5; ++rep) { const bool real = rep == REP_P5 - 1;
                pg8::Gemm g{mg, Wo_t, TOK, DM, DM, DM, DM}; pg8::StaticOrder S; S.init(TOK, DM, G, bx);
                pg8::EpiWrap<ERes> E{ERes{l == 0 ? x_in : xcur, real ? xcur : (float*)(ws + WS_PROJ + 192 * MiB), real ? xb : (bf16_t*)(ws + WS_PROJ + 320 * MiB), real ? ssb + (size_t)(2 * l + 1) * TOK : nullptr}}; pg8::gemm_phase(lds, g, S, E, phase_tid(wave0)); }
            }
        } else if (p == 6) {
            PHASE_TID();
            if (PH_EN(6) && !(args.flags & FL_SKIP_MAIN)) {
#pragma unroll 1
                for (int rep = 0; rep < REP_GU; ++rep) {
                pg8::Gemm g{xb, Wgu_t, TOK, 2 * DFF, DM, DM, DM}; pg8::StaticOrder S; S.init(TOK, 2 * DFF, G, bx);
                pg8::EpiWrap<EGU> E{EGU{hb, ssb + (size_t)(2 * l + 1) * TOK}}; pg8::gemm_phase(lds, g, S, E, phase_tid(wave0)); }
            }
        } else {
            PHASE_TID();
            if (PH_EN(7) && !(args.flags & FL_SKIP_MAIN)) {
#pragma unroll 1
                for (int rep = 0; rep < REP_P7; ++rep) { const bool real = rep == REP_P7 - 1;
                pg8::Gemm g{hb, Wdn_t, TOK, DM, DFF, DFF, DFF}; pg8::StaticOrder S; S.init(TOK, DM, G, bx);
                pg8::EpiWrap<ERes> E{ERes{xcur, real ? xcur : (float*)(ws + WS_PROJ + 192 * MiB), real ? xb : (bf16_t*)(ws + WS_PROJ + 320 * MiB), (real && l == 0) ? ssb + (size_t)2 * TOK : nullptr}}; pg8::gemm_phase(lds, g, S, E, phase_tid(wave0)); }
            }
        }
        if (ph + 1 < args.hi) { if (!(args.flags & FL_XCDBAR) || ph == args.lo) grid.sync(); else xcd_barrier(xbar); }
    }
}

template <class E> static void launch_naive(const bf16_t* A, int lda, const bf16_t* Bt, int ldb, int M, int N, int K, E e, hipStream_t st) {
    const size_t n = (size_t)(M / 32) * (E::PAIRED ? (N / 256) * 4 : N / 32);
    hipLaunchKernelGGL(naive_gemm<E>, dim3((unsigned)((n + 3) / 4)), dim3(256), 0, st, A, Bt, e, lda, ldb, M, N, K, 0);
}

extern "C" void kernel_launch(void* const* d_in, const int* in_sizes, int n_in, void* d_out, int out_size, void* d_ws, size_t ws_size, hipStream_t stream) {
    static int grid = 0;
    if (grid == 0) {
        if (n_in != 21 || out_size != TOK * DM || ws_size < WS_END) { fprintf(stderr, "kernel_launch: unexpected shapes / workspace (%d inputs, out %d, ws %zu < %zu)\n", n_in, out_size, ws_size, (size_t)WS_END); grid = -1; return; }
        int dev = 0, cus = 0, per_cu = 0;
        hipGetDevice(&dev); hipDeviceGetAttribute(&cus, hipDeviceAttributeMultiprocessorCount, dev);
        hipFuncSetAttribute((const void*)mega, hipFuncAttributeMaxDynamicSharedMemorySize, LDS_BYTES);
        hipOccupancyMaxActiveBlocksPerMultiprocessor(&per_cu, (const void*)mega, 512, LDS_BYTES);
        if (per_cu < 1) per_cu = 1;
        grid = cus * per_cu; if (grid > 256) grid = 256;
        if (grid != 256) { fprintf(stderr, "kernel_launch: needs 256 co-resident workgroups, got %d\n", grid); grid = -1; return; }
        (void)hipGetLastError();
    }
    if (grid < 0) return;
    unsigned char* ws = (unsigned char*)d_ws;
    Args a{};
    for (int i = 0; i < 21; ++i) a.in[i] = d_in[i];
    a.out = (float*)d_out; a.ws = ws;
    float* ssb = (float*)(ws + WS_SS); float* qssb = (float*)(ws + WS_QSS); float* lsumb = (float*)(ws + WS_LSUM); float* kssb = (float*)(ws + WS_KSS); float* ssmem = (float*)(ws + WS_SSMEM);
    bf16_t* memb = (bf16_t*)(ws + WS_MEMB); bf16_t* mkraw = (bf16_t*)(ws + WS_MKRAW); bf16_t* mvT = (bf16_t*)(ws + WS_MVT);
    bf16_t* Win_t = (bf16_t*)(ws + WS_WIN); bf16_t* Wc_t = (bf16_t*)(ws + WS_WC); bf16_t* Wd_t = (bf16_t*)(ws + WS_WD); bf16_t* Wx_t = (bf16_t*)(ws + WS_WX);
    bf16_t* Wmkv_t = (bf16_t*)(ws + WS_WMKV); bf16_t* Wo_t = (bf16_t*)(ws + WS_WO); bf16_t* Wgu_t = (bf16_t*)(ws + WS_WGU); bf16_t* Wdn_t = (bf16_t*)(ws + WS_WDN);
    bf16_t* proj = (bf16_t*)(ws + WS_PROJ); bf16_t* VT = (bf16_t*)(ws + WS_VT); bf16_t* xb = (bf16_t*)(ws + WS_XB); bf16_t* mg = (bf16_t*)(ws + WS_MG); bf16_t* hb = (bf16_t*)(ws + WS_H);
    const float* x_in = (const float*)d_in[0]; float* xcur = (float*)d_out;

    static Args store[NPHASE + 1]; int nco = 0;
    auto coop = [&](int lo, int hi, int flags) {
        a.lo = lo; a.hi = hi; a.flags = flags; store[nco] = a;
        void* kargs[] = {&store[nco]}; ++nco;
        hipError_t e = hipSuccess;
        if (hi - lo == 1) hipLaunchKernelGGL(mega, dim3(grid), dim3(512), LDS_BYTES, stream, store[nco - 1]);
        else e = hipLaunchCooperativeKernel((const void*)mega, dim3(grid), dim3(512), kargs, LDS_BYTES, stream);
        if (e != hipSuccess) fprintf(stderr, "cooperative launch failed: %s (grid %d)\n", hipGetErrorString(e), grid);
    };
    auto is_naive = [](int p) { return p != 0 && ((NAIVE_MASK >> p) & 1); };
    int ph = 0;
#ifndef STOP_PH
#define STOP_PH NPHASE
#endif
    while (ph < STOP_PH) {
        const int l = ph >> 3, p = ph & 7;
#ifndef SKIP_PH
#define SKIP_PH 0x0
#endif
        if ((SKIP_PH >> p) & 1) { ++ph; continue; }
        const bool cross_naive = (NAIVE_MASK >> 8) & 1;
        const bool pure_fast = !is_naive(p) && !(p == 3 && cross_naive);
        if (pure_fast) {
            int e = ph + 1;
            while (e < STOP_PH) { const int q = e & 7; if (is_naive(q) || (q == 3 && cross_naive)) break; ++e; }
            const bool whole = (ph == 0 && e == NPHASE);
            if (whole) (void)hipMemsetAsync(ws + WS_BAR, 0, WS_BAR_BYTES, stream);
            coop(ph, e, whole ? FL_XCDBAR : 0); ph = e; continue;
        }
        const float* gq_x = (const float*)d_in[14] + l * 256; const float* gk_x = (const float*)d_in[15] + l * 256;
        float* qss = qssb + (size_t)l * TOK * 4; float* lsum = lsumb + (size_t)l * TOK * 4; float* kss = kssb + l * 2048;
        const float* ss0 = ssb + (size_t)(2 * l) * TOK; float* ss1 = ssb + (size_t)(2 * l + 1) * TOK;
        if (p == 1) {
            launch_naive(xb, DM, Win_t, DM, TOK, NP, DM, EIn{proj, ss0, gq_x, gk_x, qss}, stream);
            launch_naive(Win_t + (size_t)NP * DM, DM, xb, DM, 1024, TOK, DM, EColScale{VT, ss0, TOK, 0}, stream);
        } else if (p == 2) {
            coop(ph, ph + 1, FL_SKIP_MEMKV);
            launch_naive(memb, DM, Wmkv_t, DM, 512, 1024, DM, EMemK{mkraw, ssmem, kss}, stream);
            launch_naive(Wmkv_t + (size_t)1024 * DM, DM, memb, DM, 1024, 512, DM, EColScale{mvT, ssmem, 512, 0}, stream);
        } else if (p == 3) {
            const bool attn_naive = is_naive(3);
            if (!attn_naive || !cross_naive) coop(ph, ph + 1, (attn_naive ? FL_SKIP_ATTN : 0) | (cross_naive ? FL_SKIP_CROSS : 0));
            if (attn_naive && !(DBG_SKIP & 1))
                hipLaunchKernelGGL(naive_diff_attn, dim3(16 * 256), dim3(256), 0, stream, proj, VT, (const float*)d_in[7] + l * 64, (const float*)d_in[8] + l * 64,
                                   (const float*)d_in[9] + l * 256, (const float*)d_in[10] + l * 128, l, 0);
            if (cross_naive && !(DBG_SKIP & 2)) {
                for (int b = 0; b < BATCH; ++b) for (int h = 0; h < 4; ++h) {
                    launch_naive(proj + (size_t)b * SEQ * NP + C_XQ + h * 256, NP, mkraw + (size_t)(b * 256) * 1024 + h * 256, 1024, SEQ, 256, 256,
                                 EXs<false>{proj + (size_t)b * SEQ * NP, qss + (size_t)b * SEQ * 4, kss, lsum + (size_t)b * SEQ * 4, (const float*)(ws + WS_XSH) + l, 0u, b, h, LOG2E / 16.f}, stream);
                }
                for (int b = 0; b < BATCH; ++b) for (int h = 0; h < 4; ++h) {
                    launch_naive(proj + (size_t)b * SEQ * NP + C_P + h * 256, NP, mvT + (size_t)(h * 256) * 512 + b * 256, 512, SEQ, 256, 256,
                                 EXo{proj + (size_t)b * SEQ * NP, lsum + (size_t)b * SEQ * 4, h, 0}, stream);
                }
            }
        } else if (p == 4) {
            launch_naive(proj + C_CA, NP, Wc_t, 1024, TOK, DM, 1024, EMerge{mg, proj, 0, 0}, stream);
            launch_naive(proj + C_OB, NP, Wd_t, 1024, TOK, DM, 1024, EMerge{mg, proj, 1, 0}, stream);
            launch_naive(proj + C_OC, NP, Wx_t, 1024, TOK, DM, 1024, EMerge{mg, proj, 2, 0}, stream);
        } else if (p == 5) {
            launch_naive(mg, DM, Wo_t, DM, TOK, DM, DM, ERes{l == 0 ? x_in : xcur, xcur, xb, ss1}, stream);
        } else if (p == 6) {
            launch_naive(xb, DM, Wgu_t, DM, TOK, 2 * DFF, DM, EGU{hb, ss1}, stream);
        } else if (p == 7) {
            launch_naive(hb, DFF, Wdn_t, DFF, TOK, DM, DFF, ERes{xcur, xcur, xb, l == 0 ? ssb + (size_t)2 * TOK : nullptr}, stream);
        }
        ++ph;
    }
}
```

```cpp
#include <hip/hip_runtime.h>
#include <hip/hip_cooperative_groups.h>
#include <cstdio>
#include <cstdint>
namespace cg = cooperative_groups;

#ifndef NAIVE_MASK
#define NAIVE_MASK 0x0
#endif

#ifndef REP_ATTN
#define REP_ATTN 1
#endif
#ifndef REP_P0
#define REP_P0 1
#endif
#ifndef REP_P1
#define REP_P1 1
#endif
#ifndef REP_P4
#define REP_P4 1
#endif
#ifndef REP_P5
#define REP_P5 1
#endif
#ifndef REP_P7
#define REP_P7 1
#endif
#ifndef REP_P2
#define REP_P2 1
#endif
#ifndef REP_X
#define REP_X 1
#endif
#ifndef REP_GU
#define REP_GU 1
#endif
#ifndef DBG_SKIP
#define DBG_SKIP 0
#endif
#ifndef EN_MASK
#define EN_MASK 0xFFFF
#endif
#define PH_EN(n) (((EN_MASK) >> (n)) & 1)
constexpr int BATCH = 2, SEQ = 8192, DM = 2048, TOK = BATCH * SEQ, NIN = 13312, NP = 12288, DFF = 5632, MEMLEN = 256, DEPTH = 2;
constexpr float EPS = 1e-6f, LOG2E = 1.4426950408889634f;
constexpr int C_CB = 0, C_CC = 1024, C_CX = 2048, C_DQ = 3072, C_DK = 4096, C_XQ = 5120, C_G = 6144;
constexpr int C_CA = 0, C_P = 1024, C_OC = 2048, C_OB = 3072;

typedef unsigned short bf16_t;
typedef float f32x4 __attribute__((ext_vector_type(4)));
typedef float f32x2 __attribute__((ext_vector_type(2)));
typedef float f32x16 __attribute__((ext_vector_type(16)));
typedef unsigned u32x4 __attribute__((ext_vector_type(4)));
typedef unsigned u32x2 __attribute__((ext_vector_type(2)));
typedef short bf16x8 __attribute__((ext_vector_type(8)));
typedef __bf16 bf16x2_t __attribute__((ext_vector_type(2)));
#define LAS __attribute__((address_space(3)))

constexpr size_t MiB = 1u << 20, KiB = 1024;
constexpr size_t WS_SS = 0, WS_QSS = 256 * KiB, WS_LSUM = 768 * KiB, WS_KSS = 1280 * KiB, WS_SSMEM = 1296 * KiB, WS_ZERO_LO = 64 * KiB, WS_ZERO_HI = 1296 * KiB;
constexpr size_t WS_XSH = 1300 * KiB;
constexpr size_t WS_CS = 2 * MiB, WS_MEMB = 4 * MiB, WS_MKRAW = 6 * MiB, WS_MVT = 7 * MiB;
constexpr size_t WS_WIN = 8 * MiB, WS_WC = 60 * MiB, WS_WD = 64 * MiB, WS_WX = 68 * MiB, WS_WMKV = 72 * MiB, WS_WO = 80 * MiB, WS_WGU = 88 * MiB, WS_WDN = 132 * MiB;
constexpr size_t WS_PROJ = 154 * MiB, WS_VT = 538 * MiB, WS_XB = 570 * MiB, WS_MG = 634 * MiB, WS_END = 698 * MiB;
constexpr size_t WS_H = WS_PROJ;

__device__ __forceinline__ unsigned pk2(float lo, float hi) { f32x2 v = {lo, hi}; bf16x2_t b = __builtin_convertvector(v, bf16x2_t); return __builtin_bit_cast(unsigned, b); }
__device__ __forceinline__ u32x4 pack8(f32x4 a, f32x4 b) { u32x4 w; w.x = pk2(a.x, a.y); w.y = pk2(a.z, a.w); w.z = pk2(b.x, b.y); w.w = pk2(b.z, b.w); return w; }
__device__ __forceinline__ float blo(unsigned w) { return __uint_as_float(w << 16); }
__device__ __forceinline__ float bhi(unsigned w) { return __uint_as_float(w & 0xffff0000u); }
__device__ __forceinline__ void unpack8(u32x4 w, f32x4& a, f32x4& b) { a = (f32x4){blo(w.x), bhi(w.x), blo(w.y), bhi(w.y)}; b = (f32x4){blo(w.z), bhi(w.z), blo(w.w), bhi(w.w)}; }
__device__ __forceinline__ int opaque(int v) { asm volatile("" : "+v"(v)); return v; }
__device__ __forceinline__ int phase_tid(int wave0) { int t; asm volatile("v_mbcnt_lo_u32_b32 %0, -1, 0\n\tv_mbcnt_hi_u32_b32 %0, -1, %0" : "=v"(t)); return t | (wave0 << 6); }
__device__ __forceinline__ float sum4(f32x4 v) { return (v.x + v.y) + (v.z + v.w); }
__device__ __forceinline__ float rs_of(float ss, float invn) { return rsqrtf(ss * invn + EPS); }
__constant__ float INVF[8] = {1.0f, 0.1939227432012558f, 0.03760603070259094f, 0.007292664609849453f, 0.0014142135623842478f, 0.00027424818836152554f, 5.3182957344688475e-05f, 1.0313385246263351e-05f};
__device__ __forceinline__ float xor32_sum(float v) { auto rr = __builtin_amdgcn_permlane32_swap(__float_as_uint(v), __float_as_uint(v), false, false); return __uint_as_float(rr[0]) + __uint_as_float(rr[1]); }
__device__ __forceinline__ float xor32_max(float v) { auto rr = __builtin_amdgcn_permlane32_swap(__float_as_uint(v), __float_as_uint(v), false, false); return fmaxf(__uint_as_float(rr[0]), __uint_as_float(rr[1])); }
template <int X> __device__ __forceinline__ float swz_xor(float v) { return __int_as_float(__builtin_amdgcn_ds_swizzle(__float_as_int(v), 0x1f | (X << 10))); }
__device__ __forceinline__ float wave_sum(float v) {
    v += swz_xor<1>(v); v += swz_xor<2>(v); v += swz_xor<4>(v); v += swz_xor<8>(v); v += swz_xor<16>(v); v = xor32_sum(v);
    return v;
}
__device__ __forceinline__ float wave_max(float v) {
    v = fmaxf(v, swz_xor<1>(v)); v = fmaxf(v, swz_xor<2>(v)); v = fmaxf(v, swz_xor<4>(v)); v = fmaxf(v, swz_xor<8>(v)); v = fmaxf(v, swz_xor<16>(v)); v = xor32_max(v);
    return v;
}
__device__ __forceinline__ float sigmoidf_(float v) { return __builtin_amdgcn_rcpf(1.f + __expf(-v)); }

struct EIn {
    static constexpr bool PAIRED = false;
    bf16_t* proj; const float* ss; const float* gq; const float* gk; float* qss;
    __device__ __forceinline__ float* target(int row, int col0) const { return (qss && col0 >= C_XQ && col0 < C_G) ? qss + row * 4 + ((col0 - C_XQ) >> 8) : nullptr; }
    __device__ __forceinline__ float rowscale(int row) const { return rs_of(ss[row], 1.f / DM); }
    __device__ __forceinline__ float apply(int row, int col0, f32x4 a, f32x4 b, float rs) const {
        a *= rs; b *= rs; float s = 0.f;
        if (col0 >= C_G) {
#pragma unroll
            for (int i = 0; i < 4; ++i) { a[i] = sigmoidf_(a[i]); b[i] = sigmoidf_(b[i]); }
        } else if (col0 >= C_XQ) {
            const int d = (col0 - C_XQ) & 255;
            s = sum4(a * a) + sum4(b * b);
            const f32x4 g0 = *(const f32x4*)(gq + d) * *(const f32x4*)(gk + d), g1 = *(const f32x4*)(gq + d + 4) * *(const f32x4*)(gk + d + 4);
            a *= g0; b *= g1;
        }
        *(u32x4*)(proj + (size_t)row * NP + col0) = pack8(a, b);
        return s;
    }
};
struct EColScale {
    static constexpr bool PAIRED = false;
    bf16_t* O; const float* ss; int ldc, pad;
    __device__ __forceinline__ float* target(int, int) const { return nullptr; }
    __device__ __forceinline__ float rowscale(int) const { return 1.f; }
    __device__ __forceinline__ float apply(int row, int col0, f32x4 a, f32x4 b, float) const {
        const f32x4 s0 = *(const f32x4*)(ss + col0), s1 = *(const f32x4*)(ss + col0 + 4);
#pragma unroll
        for (int i = 0; i < 4; ++i) { a[i] *= rs_of(s0[i], 1.f / DM); b[i] *= rs_of(s1[i], 1.f / DM); }
        *(u32x4*)(O + (size_t)row * ldc + col0) = pack8(a, b);
        return 0.f;
    }
};
struct EMemK {
    static constexpr bool PAIRED = false;
    bf16_t* O; const float* ssmem; float* kss;
    __device__ __forceinline__ float* target(int row, int col0) const { return kss ? kss + row * 4 + (col0 >> 8) : nullptr; }
    __device__ __forceinline__ float rowscale(int row) const { return rs_of(ssmem[row], 1.f / DM); }
    __device__ __forceinline__ float apply(int row, int col0, f32x4 a, f32x4 b, float rs) const {
        a *= rs; b *= rs;
        *(u32x4*)(O + (size_t)row * 1024 + col0) = pack8(a, b);
        return sum4(a * a) + sum4(b * b);
    }
};
template <bool LDSRK> struct EXs {
    static constexpr bool PAIRED = false;
    bf16_t* proj; const float* qss; const float* kss; float* lsum; const float* Mxp; unsigned rkl; int b, h; float c;
    __device__ __forceinline__ float* target(int row, int) const { return lsum ? lsum + row * 4 + h : nullptr; }
    __device__ __forceinline__ float rowscale(int row) const { return rs_of(qss[row * 4 + h], 1.f / 256) * c; }
    __device__ __forceinline__ float apply(int row, int col0, f32x4 a, f32x4 bb, float rq) const {
        const float Mx = __hip_atomic_load(Mxp, __ATOMIC_RELAXED, __HIP_MEMORY_SCOPE_AGENT);
        f32x4 k0, k1;
        if constexpr (LDSRK) { const LAS float* rk = (const LAS float*)rkl; k0 = *(const LAS f32x4*)(rk + col0); k1 = *(const LAS f32x4*)(rk + col0 + 4); }
        else {
#pragma unroll
            for (int i = 0; i < 4; ++i) { k0[i] = rs_of(kss[(b * 256 + col0 + i) * 4 + h], 1.f / 256); k1[i] = rs_of(kss[(b * 256 + col0 + 4 + i) * 4 + h], 1.f / 256); }
        }
        float s = 0.f;
#pragma unroll
        for (int i = 0; i < 4; ++i) {
            a[i] = __builtin_amdgcn_exp2f(a[i] * rq * k0[i] - Mx);
            bb[i] = __builtin_amdgcn_exp2f(bb[i] * rq * k1[i] - Mx);
            s += a[i] + bb[i];
        }
        *(u32x4*)(proj + (size_t)row * NP + C_P + h * 256 + col0) = pack8(a, bb);
        return s;
    }
};
struct EXo {
    static constexpr bool PAIRED = false;
    bf16_t* proj; const float* lsum; int h, pad;
    __device__ __forceinline__ float* target(int, int) const { return nullptr; }
    __device__ __forceinline__ float rowscale(int row) const { return 1.f / __hip_atomic_load(lsum + row * 4 + h, __ATOMIC_RELAXED, __HIP_MEMORY_SCOPE_AGENT); }
    __device__ __forceinline__ float apply(int row, int col0, f32x4 a, f32x4 b, float inv) const {
        a *= inv; b *= inv;
        *(u32x4*)(proj + (size_t)row * NP + C_OC + h * 256 + col0) = pack8(a, b);
        return 0.f;
    }
};
struct EMerge {
    static constexpr bool PAIRED = false;
    bf16_t* mg; const bf16_t* proj; int gi, pad;
    __device__ __forceinline__ float* target(int, int) const { return nullptr; }
    __device__ __forceinline__ float rowscale(int) const { return 1.f; }
    __device__ __forceinline__ float apply(int row, int col0, f32x4 a, f32x4 b, float) const {
        f32x4 g0, g1; unpack8(*(const u32x4*)(proj + (size_t)row * NP + C_G + gi * 2048 + col0), g0, g1);
        a *= g0; b *= g1;
        bf16_t* p = mg + (size_t)row * DM + col0;
        if (gi > 0) { f32x4 m0, m1; unpack8(*(const u32x4*)p, m0, m1); a += m0; b += m1; }
        *(u32x4*)p = pack8(a, b);
        return 0.f;
    }
};
struct ERes {
    static constexpr bool PAIRED = false;
    const float* xin; float* xout; bf16_t* xb; float* ssn;
    __device__ __forceinline__ float* target(int row, int) const { return ssn ? ssn + row : nullptr; }
    __device__ __forceinline__ float rowscale(int) const { return 1.f; }
    static constexpr bool HASPRE = true;
    __device__ __forceinline__ void pre(int row, int col0, f32x4& p0, f32x4& p1) const { const size_t off = (size_t)row * DM + col0; p0 = *(const f32x4*)(xin + off); p1 = *(const f32x4*)(xin + off + 4); }
    __device__ __forceinline__ float apply(int row, int col0, f32x4 a, f32x4 b, float rs) const { f32x4 p0, p1; pre(row, col0, p0, p1); return apply_pre(row, col0, a, b, rs, p0, p1); }
    __device__ __forceinline__ float apply_pre(int row, int col0, f32x4 a, f32x4 b, float, f32x4 p0, f32x4 p1) const {
        const size_t off = (size_t)row * DM + col0;
        a += p0; b += p1;
        *(f32x4*)(xout + off) = a; *(f32x4*)(xout + off + 4) = b;
        *(u32x4*)(xb + off) = pack8(a, b);
        return sum4(a * a) + sum4(b * b);
    }
};
struct EGU {
    static constexpr bool PAIRED = true;
    bf16_t* H; const float* ss;
    __device__ __forceinline__ float rowscale(int row) const { return rs_of(ss[row], 1.f / DM); }
    __device__ __forceinline__ void apply2(int row, int lcol0, f32x4 a0, f32x4 a1, f32x4 b0, f32x4 b1, float rs) const {
#pragma unroll
        for (int i = 0; i < 4; ++i) {
            const float x = a0[i] * rs, y = a1[i] * rs;
            a0[i] = x * sigmoidf_(x) * (b0[i] * rs); a1[i] = y * sigmoidf_(y) * (b1[i] * rs);
        }
        *(u32x4*)(H + (size_t)row * DFF + lcol0) = pack8(a0, a1);
    }
};

__device__ __forceinline__ float dot8(u32x4 a, u32x4 b) {
    float s = blo(a.x) * blo(b.x); s += bhi(a.x) * bhi(b.x); s += blo(a.y) * blo(b.y); s += bhi(a.y) * bhi(b.y);
    s += blo(a.z) * blo(b.z); s += bhi(a.z) * bhi(b.z); s += blo(a.w) * blo(b.w); s += bhi(a.w) * bhi(b.w); return s;
}
__device__ __forceinline__ int pi32(int i) { return (i & 0x13) | ((i & 4) << 1) | ((i & 8) >> 1); }
template <class E> __global__ void __launch_bounds__(256) naive_gemm(const bf16_t* A, const bf16_t* Bt, E e, int lda, int ldb, int M, int N, int K, int pad) {
    const int lane = threadIdx.x & 63, i32 = lane & 31, hi = lane >> 5;
    const int nct = E::PAIRED ? (N / 256) * 4 : N / 32;
    const long w = (long)blockIdx.x * 4 + (threadIdx.x >> 6); if (w >= (long)(M / 32) * nct) return;
    const int mt = (int)(w / nct), ct = (int)(w % nct), row0 = mt * 32;
    const int pcol = E::PAIRED ? (ct >> 2) * 256 + (ct & 3) * 32 : ct * 32, lcol = E::PAIRED ? (ct >> 2) * 128 + (ct & 3) * 32 : pcol;
    const bf16_t* ap = A + (size_t)(row0 + i32) * lda + 8 * hi;
    const bf16_t* bp = Bt + (size_t)(pcol + pi32(i32)) * ldb + 8 * hi;
    f32x16 acc, acc2;
#pragma unroll
    for (int r = 0; r < 16; ++r) { acc[r] = 0.f; acc2[r] = 0.f; }
    for (int k = 0; k < K; k += 16) {
        const bf16x8 af = *(const bf16x8*)(ap + k), bf = *(const bf16x8*)(bp + k);
        acc = __builtin_amdgcn_mfma_f32_32x32x16_bf16(bf, af, acc, 0, 0, 0);
        if constexpr (E::PAIRED) { const bf16x8 bf2 = *(const bf16x8*)(bp + (size_t)128 * ldb + k); acc2 = __builtin_amdgcn_mfma_f32_32x32x16_bf16(bf2, af, acc2, 0, 0, 0); }
    }
    const int row = row0 + i32;
#pragma unroll
    for (int hf = 0; hf < 2; ++hf) {
        const f32x4 a = {acc[8 * hf], acc[8 * hf + 1], acc[8 * hf + 2], acc[8 * hf + 3]}, b = {acc[8 * hf + 4], acc[8 * hf + 5], acc[8 * hf + 6], acc[8 * hf + 7]};
        if constexpr (E::PAIRED) { const f32x4 c = {acc2[8 * hf], acc2[8 * hf + 1], acc2[8 * hf + 2], acc2[8 * hf + 3]}, d = {acc2[8 * hf + 4], acc2[8 * hf + 5], acc2[8 * hf + 6], acc2[8 * hf + 7]};
            e.apply2(row, lcol + 16 * hf + 8 * hi, a, b, c, d, e.rowscale(row)); }
        else { const float sp = e.apply(row, lcol + 16 * hf + 8 * hi, a, b, e.rowscale(row)); float* tg = e.target(row, lcol + 16 * hf + 8 * hi); if (tg) atomicAdd(tg, sp); }
    }
}

struct AttnConsts { float Mfix, lam, osc; };
__device__ __forceinline__ AttnConsts attn_consts(const float* gq, const float* gk, const float* lv, int layer, int lane) {
    AttnConsts c;
    const float mq = wave_max(fabsf(gq[lane])), mk = wave_max(fabsf(gk[lane]));
    c.Mfix = 8.f * mq * mk * LOG2E;
    const float s1 = wave_sum(lv[lane] * lv[64 + lane]), s2 = wave_sum(lv[128 + lane] * lv[192 + lane]);
    const float lam_init = 0.8f - 0.6f * expf(-0.3f * (float)layer);
    c.lam = expf(s1) - expf(s2) + lam_init; c.osc = 1.f - lam_init;
    return c;
}
__device__ __forceinline__ float xattn_shift(const float* gq, const float* gk, int lane) {
    float m = 0.f;
#pragma unroll
    for (int j = 0; j < 4; ++j) m = fmaxf(m, fabsf(gq[lane + 64 * j] * gk[lane + 64 * j]));
    return 16.f * wave_max(m) * LOG2E;
}

__global__ void __launch_bounds__(256) naive_diff_attn(bf16_t* proj, const bf16_t* VT, const float* gq, const float* gk, const float* lv, const float* gsub, int layer, int pad) {
    __shared__ float sQ[2][32][65], sK[2][32][65], sV[32][129], sP[2][32][33];
    const int t = threadIdx.x, lane = t & 63;
    const AttnConsts ac = attn_consts(gq, gk, lv, layer, lane);
    const int qt = blockIdx.x & 255, bh = blockIdx.x >> 8, b = bh >> 3, h = bh & 7;
    const size_t rowbase = (size_t)b * SEQ; const int q0 = qt * 32;
    for (int i = t; i < 2 * 32 * 64; i += 256) { const int c = i >> 11, r = (i >> 6) & 31, d = i & 63;
        sQ[c][r][d] = blo(proj[(rowbase + q0 + r) * NP + C_DQ + h * 128 + c * 64 + d]); }
    const int c = t >> 7, qr = (t & 127) >> 2, g4 = t & 3;
    float o[32]; float l = 0.f;
#pragma unroll
    for (int i = 0; i < 32; ++i) o[i] = 0.f;
    for (int kt = 0; kt <= qt; ++kt) {
        const int kv0 = kt * 32;
        __syncthreads();
        for (int i = t; i < 2 * 32 * 64; i += 256) { const int cc = i >> 11, r = (i >> 6) & 31, d = i & 63;
            sK[cc][r][d] = blo(proj[(rowbase + kv0 + r) * NP + C_DK + h * 128 + cc * 64 + d]); }
        for (int i = t; i < 32 * 128; i += 256) { const int d = i >> 5, r = i & 31;
            sV[r][d] = blo(VT[(size_t)(h * 128 + d) * TOK + rowbase + kv0 + r]); }
        __syncthreads();
#pragma unroll
        for (int j = 0; j < 8; ++j) { const int kv = g4 * 8 + j; float s = 0.f;
            for (int d = 0; d < 64; ++d) s += sQ[c][qr][d] * sK[c][kv][d];
            float p = __builtin_amdgcn_exp2f(s - ac.Mfix); if (kv0 + kv > q0 + qr) p = 0.f;
            sP[c][qr][kv] = p; }
        __syncthreads();
        for (int kv = 0; kv < 32; ++kv) { const float p = sP[c][qr][kv]; l += p;
#pragma unroll
            for (int i = 0; i < 32; ++i) o[i] += p * sV[kv][g4 * 32 + i]; }
    }
    __syncthreads();
    const float inv = 1.f / l;
    if (c == 1) {
#pragma unroll
        for (int i = 0; i < 32; ++i) sV[qr][g4 * 32 + i] = o[i] * inv; }
    __syncthreads();
    if (c == 0) {
        float ss = 0.f;
#pragma unroll
        for (int i = 0; i < 32; ++i) { o[i] = o[i] * inv - ac.lam * sV[qr][g4 * 32 + i]; ss += o[i] * o[i]; }
        ss += __shfl_xor(ss, 1); ss += __shfl_xor(ss, 2);
        const float rs = rs_of(ss, 1.f / 128) * ac.osc;
#pragma unroll
        for (int i = 0; i < 32; i += 2) {
            const int d = g4 * 32 + i;
            *(unsigned*)(proj + (rowbase + q0 + qr) * NP + C_OB + h * 128 + d) = pk2(o[i] * rs * gsub[d], o[i + 1] * rs * gsub[d + 1]);
        }
    }
}

namespace pg8 {
constexpr int BM = 256, BK = 64, HALF = 128, HTB = HALF * BK * 2, STAGE_BYTES = 8 * HTB, NXCD = 8, WGM = 8;
__host__ __device__ __forceinline__ int lds_byte(int r, int c) { const int st = (r >> 4) * 2 + (c >> 5), rr = r & 15, cc = c & 31, ob = rr * 64 + cc * 2; return st * 1024 + (ob ^ (((ob >> 9) & 1) << 5)); }
__host__ __device__ __forceinline__ void stage_rc(int b, int& R, int& C) { const int st = b / 1024, sb = b % 1024, swz = sb ^ (((sb >> 9) & 1) << 5); R = (st >> 1) * 16 + swz / 64; C = (st & 1) * 32 + (swz % 64) / 2; }
__host__ __device__ __forceinline__ int perm32(int rho) { const int n = rho >> 4, i = rho & 15; return 8 * (i >> 2) + 4 * n + (i & 3); }
struct Unit { int pm, pn, aoff, gi; };
struct Gemm { const bf16_t* A; const bf16_t* Bt; int M, N, K, lda, ldb; };
struct StaticOrder {
    int nM, nN, nwg, G, c;
    __device__ void init(int M, int N, int G_, int c_) { nM = M / BM; nN = N / BM; nwg = nM * nN; G = G_; c = c_; }
    __device__ bool next(int i, Unit& u) const {
        const long L = (long)i * G + c; if (L >= nwg || c >= G) return false;
        int wgid = (int)L; { const int q = nwg / NXCD, r = nwg % NXCD, xcd = wgid % NXCD, off = wgid / NXCD; wgid = (xcd < r ? xcd * (q + 1) : r * (q + 1) + (xcd - r) * q) + off; }
        const int nig = WGM * nN, gid = wgid / nig, fm = gid * WGM, gsz = (nM - fm) < WGM ? (nM - fm) : WGM;
        u.pm = fm + ((wgid % nig) % gsz); u.pn = (wgid % nig) / gsz; u.aoff = 0; u.gi = 0; return true;
    }
};
struct OneUnit { Unit u; bool valid; __device__ bool next(int i, Unit& o) const { if (i || !valid) return false; o = u; return true; } };

template <class F, class = void> struct has_pre { static constexpr bool value = false; };
template <class F> struct has_pre<F, decltype((void)F::HASPRE)> { static constexpr bool value = true; };
template <class F> struct EpiWrap {
    F f;
    __device__ __forceinline__ bool zero_after(const Unit&) const { return true; }
    __device__ __forceinline__ void operator()(f32x4 (&acc)[2][2][4][2], const Unit& u, int wr, int wc, int fr, int fq) const {
        f32x4 pr[2][2][2];
        float rsv[2][4];
#pragma unroll
        for (int ai = 0; ai < 2; ++ai)
#pragma unroll
            for (int m = 0; m < 4; ++m) rsv[ai][m] = f.rowscale(u.pm * BM + ai * HALF + wr * 64 + m * 16 + fr);
#pragma unroll
        for (int ai = 0; ai < 2; ++ai)
#pragma unroll
            for (int m = 0; m < 4; ++m) {
                const int row = u.pm * BM + ai * HALF + wr * 64 + m * 16 + fr;
                if constexpr (F::PAIRED) f.apply2(row, u.pn * 128 + wc * 32 + 8 * fq, acc[ai][0][m][0], acc[ai][0][m][1], acc[ai][1][m][0], acc[ai][1][m][1], rsv[ai][m]);
                else if constexpr (has_pre<F>::value) {
                    if ((m & 1) == 0) {
#pragma unroll
                        for (int mm = 0; mm < 2; ++mm)
#pragma unroll
                            for (int bj = 0; bj < 2; ++bj) f.pre(row + 16 * mm, u.pn * BM + bj * HALF + wc * 32 + 8 * fq, pr[mm][bj][0], pr[mm][bj][1]);
                    }
                    float sp = 0.f;
#pragma unroll
                    for (int bj = 0; bj < 2; ++bj) sp += f.apply_pre(row, u.pn * BM + bj * HALF + wc * 32 + 8 * fq, acc[ai][bj][m][0], acc[ai][bj][m][1], rsv[ai][m], pr[m & 1][bj][0], pr[m & 1][bj][1]);
                    float* tg = f.target(row, u.pn * BM + wc * 32 + 8 * fq);
                    if (tg) { sp += swz_xor<16>(sp); sp = xor32_sum(sp); if (fq == 0) atomicAdd(tg, sp); }
                } else {
                    float sp = 0.f;
#pragma unroll
                    for (int bj = 0; bj < 2; ++bj) sp += f.apply(row, u.pn * BM + bj * HALF + wc * 32 + 8 * fq, acc[ai][bj][m][0], acc[ai][bj][m][1], rsv[ai][m]);
                    float* tg = f.target(row, u.pn * BM + wc * 32 + 8 * fq);
                    if (tg) { sp += swz_xor<16>(sp); sp = xor32_sum(sp); if (fq == 0) atomicAdd(tg, sp); }
                }
                if (m == 3) asm volatile("" ::: "memory");
            }
    }
};

struct ChainOrder {
    StaticOrder base;
    __device__ bool next(int j, Unit& u) const {
        const int i = j / 3, gi = j - 3 * i; Unit t;
        if (!base.next(i, t)) return false;
        u.pm = t.pm; u.pn = gi * 8 + t.pn; u.aoff = (gi == 0) ? C_CA : (gi == 1) ? C_OB : C_OC; u.gi = gi; return true;
    }
};
struct EpiChain {
    bf16_t* mg; const bf16_t* proj;
    __device__ __forceinline__ bool zero_after(const Unit& u) const { return u.gi == 2; }
    __device__ __forceinline__ void operator()(f32x4 (&acc)[2][2][4][2], const Unit& u, int wr, int wc, int fr, int fq) const {
        const int pn = u.pn & 7, gi = u.gi;
#pragma unroll
        for (int ai = 0; ai < 2; ++ai)
#pragma unroll
            for (int m = 0; m < 4; ++m) {
                const int row = u.pm * BM + ai * HALF + wr * 64 + m * 16 + fr;
#pragma unroll
                for (int bj = 0; bj < 2; ++bj) {
                    const int col0 = pn * BM + bj * HALF + wc * 32 + 8 * fq;
                    const bf16_t* gp = proj + (size_t)row * NP + C_G + gi * 2048 + col0;
                    f32x4 g0, g1; unpack8(*(const u32x4*)gp, g0, g1);
                    if (gi < 2) {
                        f32x4 n0, n1; unpack8(*(const u32x4*)(gp + 2048), n0, n1);
#pragma unroll
                        for (int i = 0; i < 4; ++i) { g0[i] *= __builtin_amdgcn_rcpf(fmaxf(n0[i], 1e-30f)); g1[i] *= __builtin_amdgcn_rcpf(fmaxf(n1[i], 1e-30f)); }
                        acc[ai][bj][m][0] *= g0; acc[ai][bj][m][1] *= g1;
                    } else {
                        *(u32x4*)(mg + (size_t)row * DM + col0) = pack8(acc[ai][bj][m][0] * g0, acc[ai][bj][m][1] * g1);
                    }
                }
                if (m == 3) asm volatile("" ::: "memory");
            }
    }
};

template <class Epi, class Sched>
__device__ __forceinline__ void gemm_phase(LAS unsigned char* lds, const Gemm g, const Sched& S, const Epi& E, const int tid) {
    const int wid = __builtin_amdgcn_readfirstlane(tid >> 6), lane = tid & 63, wr = wid >> 2, wc = wid & 3, fr = lane & 15, fq = lane >> 4;
    const int K = g.K, nt = K / BK;
    unsigned voffA[2], voffB[2];
#pragma unroll
    for (int i = 0; i < 2; ++i) { int R, C; stage_rc(tid * 16 + i * 8192, R, C); const int Rb = (R & ~31) + perm32(R & 31);
        voffA[i] = (unsigned)(R * g.lda + C) * 2u; voffB[i] = (unsigned)(Rb * g.ldb + C) * 2u; }
    const size_t kstep = (size_t)(BK * 2);
    const size_t hstepA = (size_t)HALF * g.lda * 2, hstepB = (size_t)HALF * g.ldb * 2, tstepA = 2 * hstepA, tstepB = 2 * hstepB;
    const unsigned ldsw = (unsigned)wid * 1024u;
    const int aoff = lds_byte(wr * 64 + fr, fq * 8), boff = lds_byte(wc * 32 + fr, fq * 8);
#define PG8_SA(b, h) (((b) * 2 + (h)) * HTB)
#define PG8_SB(b, h) ((4 + (b) * 2 + (h)) * HTB)
#define PG8_STAGE(bufoff, gbase, voff) do { _Pragma("unroll") for (int _i = 0; _i < 2; ++_i) \
        __builtin_amdgcn_global_load_lds((const unsigned*)((const char*)(gbase) + (voff)[_i]), (LAS unsigned*)(lds + (bufoff) + ldsw + _i * 8192), 16, 0, 0); } while (0)
#define PG8_LDA(dst, b, h) do { _Pragma("unroll") for (int m = 0; m < 4; ++m) _Pragma("unroll") for (int k = 0; k < 2; ++k) dst[m][k] = *(const LAS bf16x8*)(lds + PG8_SA(b, h) + aoff + m * 2048 + k * 1024); } while (0)
#define PG8_LDB(dst, b, h) do { _Pragma("unroll") for (int n = 0; n < 2; ++n) _Pragma("unroll") for (int k = 0; k < 2; ++k) dst[n][k] = *(const LAS bf16x8*)(lds + PG8_SB(b, h) + boff + n * 2048 + k * 1024); } while (0)
#define PG8_MMA(ai, bj, At, Bt) do { __builtin_amdgcn_s_setprio(1); _Pragma("unroll") for (int m = 0; m < 4; ++m) _Pragma("unroll") for (int n = 0; n < 2; ++n) _Pragma("unroll") for (int k = 0; k < 2; ++k) \
        acc[ai][bj][m][n] = __builtin_amdgcn_mfma_f32_16x16x32_bf16(Bt[n][k], At[m][k], acc[ai][bj][m][n], 0, 0, 0); __builtin_amdgcn_s_setprio(0); } while (0)
#define PG8_WAIT_V(n) asm volatile("s_waitcnt vmcnt(" #n ")" ::: "memory")
#define PG8_WAIT_L(n) asm volatile("s_waitcnt lgkmcnt(" #n ")" ::: "memory")
#define PG8_BAR __builtin_amdgcn_s_barrier()
#define PG8_SCHED __builtin_amdgcn_sched_barrier(0)
    Unit cur, nxt; int ui = 0;
    if (!S.next(0, cur)) return;
    f32x4 acc[2][2][4][2];
#pragma unroll
    for (int a = 0; a < 2; ++a)
#pragma unroll
        for (int b = 0; b < 2; ++b)
#pragma unroll
            for (int m = 0; m < 4; ++m)
#pragma unroll
                for (int n = 0; n < 2; ++n) acc[a][b][m][n] = (f32x4){0.f, 0.f, 0.f, 0.f};
    bf16x8 At[4][2], B0[2][2], B1[2][2];
    const char* cA = (const char*)g.A + (size_t)cur.pm * tstepA + (size_t)cur.aoff * 2; const char* cB = (const char*)g.Bt + (size_t)cur.pn * tstepB;
    PG8_STAGE(PG8_SB(0, 0), cB, voffB); PG8_STAGE(PG8_SB(0, 1), cB + hstepB, voffB); PG8_STAGE(PG8_SA(0, 0), cA, voffA); PG8_STAGE(PG8_SA(0, 1), cA + hstepA, voffA);
    if (wr == 1) PG8_BAR;
    PG8_WAIT_V(2); PG8_BAR;
    PG8_STAGE(PG8_SB(1, 0), cB + kstep, voffB); PG8_STAGE(PG8_SA(1, 0), cA + kstep, voffA); PG8_STAGE(PG8_SB(1, 1), cB + hstepB + kstep, voffB);
    PG8_WAIT_V(6); PG8_BAR;
    for (;;) {
        const bool has_next = S.next(ui + 1, nxt);
        const char* nA = has_next ? (const char*)g.A + (size_t)nxt.pm * tstepA + (size_t)nxt.aoff * 2 : cA; const char* nB = has_next ? (const char*)g.Bt + (size_t)nxt.pn * tstepB : cB;
        for (int t = 0; t < nt; t += 2) {
            const bool last = (t == nt - 2);
            const char* a1 = cA + (size_t)(t + 1) * kstep;
            const char* a2 = last ? nA : cA + (size_t)(t + 2) * kstep; const char* b2 = last ? nB : cB + (size_t)(t + 2) * kstep;
            const char* a3 = a2 + kstep; const char* b3 = b2 + kstep;
            PG8_LDB(B0, 0, 0); PG8_LDB(B1, 0, 1); PG8_SCHED; PG8_LDA(At, 0, 0); PG8_STAGE(PG8_SA(1, 1), a1 + hstepA, voffA);
            PG8_WAIT_V(8); PG8_WAIT_L(0); PG8_BAR; PG8_MMA(0, 0, At, B0); PG8_MMA(0, 1, At, B1); PG8_BAR; PG8_SCHED;
            PG8_LDA(At, 0, 1); PG8_STAGE(PG8_SB(0, 0), b2, voffB); PG8_STAGE(PG8_SB(0, 1), b2 + hstepB, voffB); PG8_STAGE(PG8_SA(0, 0), a2, voffA);
            PG8_WAIT_V(8); PG8_WAIT_L(0); PG8_BAR; PG8_MMA(1, 0, At, B0); PG8_MMA(1, 1, At, B1); PG8_BAR; PG8_SCHED;
            PG8_LDB(B0, 1, 0); PG8_LDB(B1, 1, 1); PG8_SCHED; PG8_LDA(At, 1, 0); PG8_STAGE(PG8_SA(0, 1), a2 + hstepA, voffA);
            PG8_WAIT_V(8); PG8_WAIT_L(0); PG8_BAR; PG8_MMA(0, 0, At, B0); PG8_MMA(0, 1, At, B1); PG8_BAR; PG8_SCHED;
            PG8_LDA(At, 1, 1); PG8_STAGE(PG8_SB(1, 0), b3, voffB); PG8_STAGE(PG8_SB(1, 1), b3 + hstepB, voffB); PG8_STAGE(PG8_SA(1, 0), a3, voffA);
            PG8_WAIT_V(8); PG8_WAIT_L(0); PG8_BAR; PG8_MMA(1, 0, At, B0); PG8_MMA(1, 1, At, B1); PG8_BAR; PG8_SCHED;
        }
        if (wr == 0) PG8_BAR;
        E(acc, cur, wr, wc, fr, fq);
        if (!has_next) break;
        if (E.zero_after(cur))
#pragma unroll
        for (int a = 0; a < 2; ++a)
#pragma unroll
            for (int b = 0; b < 2; ++b)
#pragma unroll
                for (int m = 0; m < 4; ++m)
#pragma unroll
                    for (int n = 0; n < 2; ++n) acc[a][b][m][n] = (f32x4){0.f, 0.f, 0.f, 0.f};
        cur = nxt; cA = nA; cB = nB; ++ui;
        if (wr == 1) PG8_BAR;
    }
    PG8_WAIT_V(0);
    PG8_BAR;
#undef PG8_SA
#undef PG8_SB
#undef PG8_STAGE
#undef PG8_LDA
#undef PG8_LDB
#undef PG8_MMA
#undef PG8_WAIT_V
#undef PG8_WAIT_L
#undef PG8_BAR
#undef PG8_SCHED
}
}

__device__ __forceinline__ void glds16(const void* gsrc, unsigned lds_dst) { unsigned keep;
    asm volatile("s_mov_b32 %0, m0\n\ts_mov_b32 m0, %2\n\ts_nop 0\n\tglobal_load_lds_dwordx4 %1, off\n\ts_mov_b32 m0, %0" : "=&s"(keep) : "v"(gsrc), "s"(lds_dst) : "memory"); }
constexpr int ATT_LDS = 65536;
template <bool NOSHIFT> __device__ __forceinline__ void diff_attn_unit(LAS unsigned char* lds, bf16_t* proj, const bf16_t* VT, int b, int h, int qb, const AttnConsts ac, const float* gsub, const int tid, bf16_t* obuf, int opitch, int ocol) {
    const int lane = tid & 63, wid = __builtin_amdgcn_readfirstlane(tid >> 6), wq = wid & 3, c = wid >> 2, i32 = lane & 31, hi = lane >> 5;
    const size_t rowbase = (size_t)b * SEQ; const int q0 = qb * 128, qrow = q0 + 32 * wq + i32;
    bf16x8 qf[4];
    { const bf16_t* qp = proj + (rowbase + qrow) * NP + C_DQ + h * 128 + c * 64 + hi * 8;
#pragma unroll
      for (int ks = 0; ks < 4; ++ks) qf[ks] = *(const bf16x8*)(qp + 16 * ks); }
    const unsigned lds0 = (unsigned)(uintptr_t)lds;
    const int krow_s = 4 * wid + (lane >> 4), vd_s = 8 * wid + (lane >> 3);
    const bf16_t* kg = proj + (rowbase + krow_s) * NP + C_DK + h * 128 + (((lane & 15) ^ (krow_s & 15)) * 8);
    const bf16_t* vg = VT + (size_t)(h * 128 + vd_s) * TOK + rowbase + (((lane & 7) ^ ((vd_s >> 1) & 7)) * 8);
    const unsigned kdst = lds0 + wid * 1024, vdst = lds0 + 65536 + wid * 1024;
#define ATT_ISSUE(tt) do { const unsigned so_ = ((tt) & 3) * 16384; const bf16_t* kp_ = kg + (size_t)(tt) * 64 * NP; const bf16_t* vp_ = vg + (size_t)(tt) * 64; \
        glds16(kp_, (unsigned)__builtin_amdgcn_readfirstlane(kdst + so_)); glds16(kp_ + (size_t)32 * NP, (unsigned)__builtin_amdgcn_readfirstlane(kdst + so_ + 8192)); \
        glds16(vp_, (unsigned)__builtin_amdgcn_readfirstlane(vdst + so_)); glds16(vp_ + (size_t)64 * TOK, (unsigned)__builtin_amdgcn_readfirstlane(vdst + so_ + 8192)); } while (0)
#define ATT_WAITBAR(N) asm volatile("s_waitcnt vmcnt(" #N ") lgkmcnt(0)\n\ts_barrier" ::: "memory")
    const int krow = pi32(i32);
    int koff[2][4];
#pragma unroll
    for (int mt = 0; mt < 2; ++mt)
#pragma unroll
        for (int ks = 0; ks < 4; ++ks) { const int r = 32 * mt + krow; koff[mt][ks] = r * 256 + (((8 * c + 2 * ks + hi) ^ (r & 15)) * 16); }
    const int NT = 2 * qb + 2;
    f32x16 o[4];
#pragma unroll
    for (int dt = 0; dt < 4; ++dt)
#pragma unroll
        for (int r = 0; r < 16; ++r) o[dt][r] = 0.f;
    float l = 0.f;
    bf16x8 pf[4];
#pragma unroll
    for (int kk = 0; kk < 4; ++kk) pf[kk] = (bf16x8){0, 0, 0, 0, 0, 0, 0, 0};
    const int qmax = q0 + 32 * wq + 31;
#define ATT_LDV(dst, slot, kk) do { _Pragma("unroll") for (int dt = 0; dt < 4; ++dt) { const int d = 32 * dt + i32; \
        dst[dt] = *(const LAS bf16x8*)(lds + 65536 + (slot) + d * 128 + (((2 * (kk) + hi) ^ ((d >> 1) & 7)) * 16)); } } while (0)
#define ATT_MMV(src, kk) do { __builtin_amdgcn_s_setprio(1); _Pragma("unroll") for (int dt = 0; dt < 4; ++dt) o[dt] = __builtin_amdgcn_mfma_f32_32x32x16_bf16(src[dt], pf[kk], o[dt], 0, 0, 0); __builtin_amdgcn_s_setprio(0); } while (0)
#define ATT_SB __builtin_amdgcn_sched_barrier(0)
#define ATT_PV(slot) do { bf16x8 va[4], vb[4]; ATT_LDV(va, slot, 0); ATT_SB; ATT_LDV(vb, slot, 1); ATT_SB; ATT_MMV(va, 0); ATT_SB; ATT_LDV(va, slot, 2); ATT_SB; ATT_MMV(vb, 1); ATT_SB; \
        ATT_LDV(vb, slot, 3); ATT_SB; ATT_MMV(va, 2); ATT_SB; ATT_MMV(vb, 3); ATT_SB; } while (0)
    ATT_ISSUE(0); ATT_ISSUE(1);
    ATT_WAITBAR(4);
    for (int t = 0; t < NT; ++t) {
        const int bo = (t & 3) * 16384, sl_cur = bo, sl_prev = ((t - 1) & 3) * 16384;
        if (t + 2 < NT) ATT_ISSUE(t + 2);
        const int kv0 = 64 * t;
        if (c == 1 && t >= 1 && kv0 - 64 <= qmax) ATT_PV(sl_prev);
        if (kv0 <= qmax) {
            f32x16 p[2];
            bf16x8 kf[2][4];
#pragma unroll
            for (int mt = 0; mt < 2; ++mt)
#pragma unroll
                for (int ks = 0; ks < 4; ++ks) kf[mt][ks] = *(const LAS bf16x8*)(lds + bo + koff[mt][ks]);
            if constexpr (!NOSHIFT) {
#pragma unroll
                for (int mt = 0; mt < 2; ++mt)
#pragma unroll
                    for (int r = 0; r < 16; ++r) p[mt][r] = -ac.Mfix;
            }
            ATT_SB;
            __builtin_amdgcn_s_setprio(1);
#pragma unroll
            for (int ks = 0; ks < 4; ++ks)
#pragma unroll
                for (int mt = 0; mt < 2; ++mt) {
                    if (NOSHIFT && ks == 0) { const f32x16 z = {0.f, 0.f, 0.f, 0.f, 0.f, 0.f, 0.f, 0.f, 0.f, 0.f, 0.f, 0.f, 0.f, 0.f, 0.f, 0.f}; p[mt] = __builtin_amdgcn_mfma_f32_32x32x16_bf16(kf[mt][ks], qf[ks], z, 0, 0, 0); }
                    else p[mt] = __builtin_amdgcn_mfma_f32_32x32x16_bf16(kf[mt][ks], qf[ks], p[mt], 0, 0, 0);
                }
            __builtin_amdgcn_s_setprio(0);
            ATT_SB;
            const bool diag = (t >= 2 * qb);
            if (diag) {
                const int qrel = qrow - kv0 - 8 * hi;
#pragma unroll
                for (int mt = 0; mt < 2; ++mt)
#pragma unroll
                    for (int r = 0; r < 16; ++r) { float v = __builtin_amdgcn_exp2f(p[mt][r]); if (32 * mt + 16 * (r >> 3) + (r & 7) > qrel) v = 0.f; p[mt][r] = v; l += v; }
            } else {
#pragma unroll
                for (int mt = 0; mt < 2; ++mt)
#pragma unroll
                    for (int r = 0; r < 16; ++r) { const float v = __builtin_amdgcn_exp2f(p[mt][r]); p[mt][r] = v; l += v; }
            }
            asm volatile("" ::: "memory");
#pragma unroll
            for (int kk = 0; kk < 4; ++kk) { const int mt = kk >> 1, r0 = 8 * (kk & 1); u32x4 w;
                w.x = pk2(p[mt][r0], p[mt][r0 + 1]); w.y = pk2(p[mt][r0 + 2], p[mt][r0 + 3]); w.z = pk2(p[mt][r0 + 4], p[mt][r0 + 5]); w.w = pk2(p[mt][r0 + 6], p[mt][r0 + 7]);
                pf[kk] = __builtin_bit_cast(bf16x8, w); }
            if (c == 0) ATT_PV(sl_cur);
        }
        if (t + 2 < NT) ATT_WAITBAR(4); else ATT_WAITBAR(0);
    }
    if (c == 1 && 64 * (NT - 1) <= qmax) ATT_PV(((NT - 1) & 3) * 16384);
#undef ATT_ISSUE
#undef ATT_WAITBAR
#undef ATT_PV
#undef ATT_LDV
#undef ATT_MMV
#undef ATT_SB
    l = xor32_sum(l);
    const float inv = 1.f / l;
    LAS float* xch = (LAS float*)lds + (size_t)wq * 4096 + lane;
    if (c == 1) {
#pragma unroll
        for (int dt = 0; dt < 4; ++dt)
#pragma unroll
            for (int r = 0; r < 16; ++r) xch[(dt * 16 + r) * 64] = o[dt][r] * inv;
    }
    __syncthreads();
    if (c == 0) {
        float ss = 0.f;
#pragma unroll
        for (int dt = 0; dt < 4; ++dt)
#pragma unroll
            for (int r = 0; r < 16; ++r) { const float v = o[dt][r] * inv - ac.lam * xch[(dt * 16 + r) * 64]; o[dt][r] = v; ss += v * v; }
        ss = xor32_sum(ss);
        const float rs = rs_of(ss, 1.f / 128) * ac.osc;
        bf16_t* op = obuf + (rowbase + qrow) * opitch + ocol + h * 128;
#pragma unroll
        for (int dt = 0; dt < 4; ++dt)
#pragma unroll
            for (int rg = 0; rg < 4; ++rg) { const int d = 32 * dt + 8 * rg + 4 * hi; const f32x4 g = *(const f32x4*)(gsub + d);
                u32x2 w; w.x = pk2(o[dt][4 * rg] * rs * g.x, o[dt][4 * rg + 1] * rs * g.y); w.y = pk2(o[dt][4 * rg + 2] * rs * g.z, o[dt][4 * rg + 3] * rs * g.w);
                *(u32x2*)(op + d) = w; }
    }
    __syncthreads();
}

__device__ __forceinline__ int maprow(int mode, int n) {
    if (mode == 1) { if (n < 5120) return n; if (n < 6144) return 12288 + (n - 5120); if (n < 7168) return 5120 + (n - 6144); return 6144 + (n - 7168); }
    if (mode == 2) { if (n < DFF) return (n >> 7) * 256 + (n & 127); const int m = n - DFF; return (m >> 7) * 256 + 128 + (m & 127); }
    return n;
}
__device__ __forceinline__ void conv_item(const float* W, int K, int N, bf16_t* Wt, const float* g, int mode, int item, int lane) {
    const int nkc = K >> 7, nb = item / nkc, kc = item - nb * nkc, n0 = nb * 64, k0 = kc * 128, kgp = lane >> 4, nq = lane & 15;
    const int drow = maprow(mode, n0) + 4 * nq;
#pragma unroll 2
    for (int it = 0; it < 4; ++it) {
        const int kb = k0 + it * 32 + kgp * 8;
        f32x4 v[8];
#pragma unroll
        for (int j = 0; j < 8; ++j) v[j] = *(const f32x4*)(W + (size_t)(kb + j) * N + n0 + 4 * nq);
        if (g) {
            const f32x4 g0 = *(const f32x4*)(g + kb), g1 = *(const f32x4*)(g + kb + 4);
#pragma unroll
            for (int j = 0; j < 4; ++j) { v[j] *= g0[j]; v[4 + j] *= g1[j]; }
        }
#pragma unroll
        for (int i = 0; i < 4; ++i) {
            u32x4 o; o.x = pk2(v[0][i], v[1][i]); o.y = pk2(v[2][i], v[3][i]); o.z = pk2(v[4][i], v[5][i]); o.w = pk2(v[6][i], v[7][i]);
            *(u32x4*)(Wt + (size_t)(drow + i) * K + kb) = o;
        }
    }
}
__device__ __forceinline__ void row_to_bf16(const float* xr, bf16_t* orow, float* ssout, int lane) {
    float s = 0.f;
#pragma unroll
    for (int j = 0; j < 8; ++j) { const f32x4 v = *(const f32x4*)(xr + 4 * lane + 256 * j); s += sum4(v * v);
        u32x2 w; w.x = pk2(v.x, v.y); w.y = pk2(v.z, v.w); *(u32x2*)(orow + 4 * lane + 256 * j) = w; }
    s = wave_sum(s);
    if (lane == 0) *ssout = s;
}

#define XB_TMO      128
#define XB_XCNT(j)  (256  + 64 * (j))
#define XB_XSUB(j)  (1280 + 64 * (j))
#define XB_XGEN(j)  (2304 + 64 * (j))
#define XB_TOP      3328
#define XB_TOPGEN   3392
#define XCD_BAR_WORDS 3456
#define XB_SPIN_CAP (1u << 18)
__device__ __forceinline__ unsigned xb_ld(unsigned* p)              { return __hip_atomic_load(p, __ATOMIC_RELAXED, __HIP_MEMORY_SCOPE_AGENT); }
__device__ __forceinline__ unsigned xb_add(unsigned* p, unsigned v) { return __hip_atomic_fetch_add(p, v, __ATOMIC_RELAXED, __HIP_MEMORY_SCOPE_AGENT); }
__device__ __forceinline__ unsigned xb_xcc_id() { return (unsigned)__builtin_amdgcn_s_getreg((3 << 11) | 20) & 0xFu; }
#define XB_SPIN(cond, bar) do { unsigned _sp = 0; while (cond) { __builtin_amdgcn_s_sleep(1); \
    if ((++_sp & 255u) == 0u) { if (xb_ld(&(bar)[XB_TMO])) break; if (_sp > XB_SPIN_CAP) { atomicAdd(&(bar)[XB_TMO], 1u); break; } } } } while (0)
struct XcdBarrier { unsigned* bar; unsigned x; volatile LAS unsigned* st; };
__device__ __forceinline__ XcdBarrier xcd_barrier_post(unsigned* bar, volatile LAS unsigned* st) {
    XcdBarrier b; b.bar = bar; b.x = xb_xcc_id(); b.st = st;
    if (threadIdx.x == 0) (void)xb_add(&bar[XB_XCNT(b.x)], 1u);
    return b;
}
__device__ __forceinline__ void xcd_barrier_complete(unsigned* bar, unsigned x, unsigned& nloc, unsigned& nx) {
    const unsigned G = gridDim.x * gridDim.y * gridDim.z;
    unsigned sum, cnt, mine, sp = 0u;
    for (;;) {
        sum = 0u; cnt = 0u; mine = 0u;
#pragma unroll
        for (unsigned j = 0; j < 16; ++j) { const unsigned c = xb_ld(&bar[XB_XCNT(j)]); sum += c; cnt += (c > 0u) ? 1u : 0u; mine = (j == x) ? c : mine; }
        if (sum == G) break;
        __builtin_amdgcn_s_sleep(1);
        if ((++sp & 255u) == 0u) { if (xb_ld(&bar[XB_TMO])) break; if (sp > XB_SPIN_CAP) { atomicAdd(&bar[XB_TMO], 1u); break; } }
    }
    nloc = mine > 0u ? mine : 1u; nx = cnt > 0u ? cnt : 1u;
}
__device__ __forceinline__ void xcd_barrier(const XcdBarrier& b) {
    asm volatile("s_waitcnt vmcnt(0)" ::: "memory");
    __syncthreads();
    if (threadIdx.x == 0) {
        unsigned* bar = b.bar;
        __builtin_amdgcn_s_waitcnt(0);
        unsigned nloc = b.st[0], nx = b.st[1];
        if (nloc == 0u) { xcd_barrier_complete(bar, b.x, nloc, nx); b.st[0] = nloc; b.st[1] = nx; }
        const unsigned old = xb_add(&bar[XB_XSUB(b.x)], 1u);
        const unsigned gen = old / nloc;
        if (old + 1u == (gen + 1u) * nloc) {
            __builtin_amdgcn_fence(__ATOMIC_RELEASE, "agent");
            asm volatile("s_waitcnt vmcnt(0)" ::: "memory");
            const unsigned og = xb_add(&bar[XB_TOP], 1u);
            const unsigned tg = og / nx;
            if (og + 1u == (tg + 1u) * nx) xb_add(&bar[XB_TOPGEN], 1u);
            else XB_SPIN(xb_ld(&bar[XB_TOPGEN]) == tg, bar);
            __builtin_amdgcn_fence(__ATOMIC_ACQUIRE, "agent");
            xb_add(&bar[XB_XGEN(b.x)], 1u);
            asm volatile("s_waitcnt vmcnt(0)" ::: "memory");
        } else {
            XB_SPIN(xb_ld(&bar[XB_XGEN(b.x)]) == gen, bar);
            __builtin_amdgcn_fence(__ATOMIC_ACQUIRE, "agent");
            asm volatile("s_waitcnt vmcnt(0)" ::: "memory");
        }
    }
    __syncthreads();
}

struct Args { const void* in[21]; float* out; unsigned char* ws; int lo, hi, flags, pad; };
constexpr int NPHASE = 16;
constexpr int FL_SKIP_MEMKV = 1, FL_SKIP_ATTN = 2, FL_SKIP_CROSS = 4, FL_SKIP_MAIN = 8, FL_XCDBAR = 16;
constexpr int LDS_BYTES = pg8::STAGE_BYTES + 2048;
constexpr size_t WS_BAR = 1400 * KiB, WS_BAR_BYTES = 16 * KiB;

__global__ void __launch_bounds__(512, 2) mega(Args args) {
    extern __shared__ __attribute__((aligned(16))) unsigned char lds_raw[];
    LAS unsigned char* lds = (LAS unsigned char*)lds_raw;
    cg::grid_group grid = cg::this_grid();
    constexpr int G = 256;
    const int wave0 = __builtin_amdgcn_readfirstlane(threadIdx.x >> 6);
    volatile LAS unsigned* bst = (volatile LAS unsigned*)(lds + pg8::STAGE_BYTES + 1024);
    if (threadIdx.x < 2) bst[threadIdx.x] = 0u;
    __syncthreads();
    XcdBarrier xbar; xbar.bar = (unsigned*)(args.ws + WS_BAR); xbar.x = 0; xbar.st = bst;
    if (args.flags & FL_XCDBAR) xbar = xcd_barrier_post((unsigned*)(args.ws + WS_BAR), bst);
    for (int ph = args.lo; ph < args.hi; ++ph) {
        int bx_ = blockIdx.x; asm volatile("" : "+s"(bx_)); const int bx = bx_, vcu = (bx % 8) * (G / 8) + bx / 8;
        unsigned char* ws = args.ws; asm volatile("" : "+s"(ws));
        constexpr int NGW = G * 8;
        const float* x_in = (const float*)args.in[0]; const float* mem = (const float*)args.in[1]; const int* positions = (const int*)args.in[2];
        float* xcur = args.out;
        float* ssb = (float*)(ws + WS_SS); float* qssb = (float*)(ws + WS_QSS); float* lsumb = (float*)(ws + WS_LSUM); float* kssb = (float*)(ws + WS_KSS); float* ssmem = (float*)(ws + WS_SSMEM);
        float* cs = (float*)(ws + WS_CS); float* xsh = (float*)(ws + WS_XSH);
        bf16_t* memb = (bf16_t*)(ws + WS_MEMB); bf16_t* mkraw = (bf16_t*)(ws + WS_MKRAW); bf16_t* mvT = (bf16_t*)(ws + WS_MVT);
        bf16_t* Win_t = (bf16_t*)(ws + WS_WIN); bf16_t* Wc_t = (bf16_t*)(ws + WS_WC); bf16_t* Wd_t = (bf16_t*)(ws + WS_WD); bf16_t* Wx_t = (bf16_t*)(ws + WS_WX);
        bf16_t* Wmkv_t = (bf16_t*)(ws + WS_WMKV); bf16_t* Wo_t = (bf16_t*)(ws + WS_WO); bf16_t* Wgu_t = (bf16_t*)(ws + WS_WGU); bf16_t* Wdn_t = (bf16_t*)(ws + WS_WDN);
        bf16_t* proj = (bf16_t*)(ws + WS_PROJ); bf16_t* VT = (bf16_t*)(ws + WS_VT); bf16_t* xb = (bf16_t*)(ws + WS_XB); bf16_t* mg = (bf16_t*)(ws + WS_MG); bf16_t* hb = (bf16_t*)(ws + WS_H);

        const int l = ph >> 3, p = ph & 7;
        const int wave = wave0, gw = vcu * 8 + wave;
#define PHASE_TID() const int tid = phase_tid(wave0), lane = tid & 63
        const float* gq_x = (const float*)args.in[14] + l * 256; const float* gk_x = (const float*)args.in[15] + l * 256;
        float* qss = qssb + (size_t)l * TOK * 4; float* lsum = lsumb + (size_t)l * TOK * 4; float* kss = kssb + l * 2048;
        if (p == 0) {
            PHASE_TID();
            const float* g_mix = (const float*)args.in[3] + l * DM; const float* g_mem = (const float*)args.in[12] + l * DM; const float* g_ffn = (const float*)args.in[18] + l * DM;
            const float* w_in = (const float*)args.in[4] + (size_t)l * DM * NIN; const float* w_co = (const float*)args.in[6] + (size_t)l * 1024 * DM;
            const float* w_do = (const float*)args.in[11] + (size_t)l * 1024 * DM; const float* w_mkv = (const float*)args.in[13] + (size_t)l * DM * 2048;
            const float* w_xo = (const float*)args.in[16] + (size_t)l * 1024 * DM; const float* w_o = (const float*)args.in[17] + (size_t)l * DM * DM;
            const float* w_gu = (const float*)args.in[19] + (size_t)l * DM * 2 * DFF; const float* w_dn = (const float*)args.in[20] + (size_t)l * DFF * DM;
            constexpr int I_IN = (NIN / 64) * (DM / 128), I_B = (DM / 64) * (1024 / 128), I_SQ = (DM / 64) * (DM / 128), I_GU = (2 * DFF / 64) * (DM / 128), I_DN = (DM / 64) * (DFF / 128);
            constexpr int NIT = I_IN + 3 * I_B + 2 * I_SQ + I_GU + I_DN;
#pragma unroll 1
            for (int rep = 0; rep < REP_P0; ++rep)
            for (int it = gw; it < NIT; it += NGW) {
                int r = it;
                if (r < I_IN) { conv_item(w_in, DM, NIN, Win_t, g_mix, 1, r, lane); continue; } r -= I_IN;
                if (r < I_GU) { conv_item(w_gu, DM, 2 * DFF, Wgu_t, g_ffn, 2, r, lane); continue; } r -= I_GU;
                if (r < I_DN) { conv_item(w_dn, DFF, DM, Wdn_t, nullptr, 0, r, lane); continue; } r -= I_DN;
                if (r < I_SQ) { conv_item(w_mkv, DM, 2048, Wmkv_t, g_mem, 0, r, lane); continue; } r -= I_SQ;
                if (r < I_SQ) { conv_item(w_o, DM, DM, Wo_t, nullptr, 0, r, lane); continue; } r -= I_SQ;
                if (r < I_B) { conv_item(w_co, 1024, DM, Wc_t, nullptr, 0, r, lane); continue; } r -= I_B;
                if (r < I_B) { conv_item(w_do, 1024, DM, Wd_t, nullptr, 0, r, lane); continue; } r -= I_B;
                conv_item(w_xo, 1024, DM, Wx_t, nullptr, 0, r, lane);
            }
            if (l == 0) {
                for (int m = gw; m < TOK; m += NGW) row_to_bf16(x_in + (size_t)m * DM, xb + (size_t)m * DM, ssb + m, lane);
                for (int m = gw; m < BATCH * MEMLEN; m += NGW) row_to_bf16(mem + (size_t)m * DM, memb + (size_t)m * DM, ssmem + m, lane);
                { unsigned* z = (unsigned*)(ws + WS_ZERO_LO); const int nz = (int)((WS_ZERO_HI - WS_ZERO_LO) / 4);
                  for (int i = bx * 512 + tid; i < nz; i += G * 512) z[i] = 0u; }
                for (int i = bx * 512 + tid; i < TOK * 8; i += G * 512) {
                    const int row = i >> 3, k = i & 7;
                    const float ang = (float)positions[row] * INVF[k];
                    const float kk = rintf(ang * 0.15915494309189535f);
                    float rr = fmaf(-kk, 6.2831854820251465f, ang); rr = fmaf(-kk, -1.7484556000744883e-07f, rr);
                    const float fr = rr * 0.15915494309189535f;
                    cs[row * 16 + k] = __builtin_amdgcn_cosf(fr); cs[row * 16 + 8 + k] = __builtin_amdgcn_sinf(fr);
                }
            }
        } else if (p == 1) {
            PHASE_TID();
            if (PH_EN(1) && !(args.flags & FL_SKIP_MAIN)) {
#pragma unroll 1
                for (int rep = 0; rep < REP_P1; ++rep)
                { pg8::Gemm g{xb, Win_t, TOK, NP, DM, DM, DM}; pg8::StaticOrder S; S.init(TOK, NP, G, bx);
                  pg8::EpiWrap<EIn> E{EIn{proj, ssb + (size_t)(2 * l) * TOK, gq_x, gk_x, rep == REP_P1 - 1 ? qss : nullptr}}; pg8::gemm_phase(lds, g, S, E, phase_tid(wave0)); }
                { pg8::Gemm g{Win_t + (size_t)NP * DM, xb, 1024, TOK, DM, DM, DM}; pg8::StaticOrder S; S.init(1024, TOK, G, bx);
                  pg8::EpiWrap<EColScale> E{EColScale{VT, ssb + (size_t)(2 * l) * TOK, TOK, 0}}; pg8::gemm_phase(lds, g, S, E, phase_tid(wave0)); }
            }
        } else if (p == 2) {
            PHASE_TID();
            const bool do_mkv = !(args.flags & FL_SKIP_MEMKV) && G >= 32;
            if (bx == G - 1 && wave == 0) { const float mx = xattn_shift(gq_x, gk_x, lane); if (lane == 0) xsh[l] = mx; }
#pragma unroll 1
            for (int rep2 = 0; rep2 < REP_P2; ++rep2) { const bool real2 = rep2 == REP_P2 - 1;
            if (PH_EN(2) && do_mkv && bx < 16) {
                if (bx < 8) { pg8::Gemm g{memb, Wmkv_t, 512, 1024, DM, DM, DM}; pg8::StaticOrder S; S.init(512, 1024, 8, bx);
                    pg8::EpiWrap<EMemK> E{EMemK{mkraw, ssmem, real2 ? kss : nullptr}}; pg8::gemm_phase(lds, g, S, E, phase_tid(wave0)); }
                else { pg8::Gemm g{Wmkv_t + (size_t)1024 * DM, memb, 1024, 512, DM, DM, DM}; pg8::StaticOrder S; S.init(1024, 512, 8, bx - 8);
                    pg8::EpiWrap<EColScale> E{EColScale{mvT, ssmem, 512, 0}}; pg8::gemm_phase(lds, g, S, E, phase_tid(wave0)); }
            } else {
                const int nb0 = do_mkv ? 16 : 0, NW2 = (G - nb0) * 8, gw2 = (bx - nb0) * 8 + wave;
                const float* gqd = (const float*)args.in[7] + l * 64; const float* gkd = (const float*)args.in[8] + l * 64; const float* cw = (const float*)args.in[5] + l * 3 * 1024;
#pragma unroll 1
                for (int base = gw2; base < 2 * TOK; base += 4 * NW2) {
                    u32x4 wv[4][2];
#pragma unroll
                    for (int j4 = 0; j4 < 4; ++j4) { const int tk = min(base + j4 * NW2, 2 * TOK - 1);
                        const bf16_t* pp = proj + (size_t)(tk >> 1) * NP + ((tk & 1) ? C_DK : C_DQ) + lane * 16; wv[j4][0] = *(const u32x4*)pp; wv[j4][1] = *(const u32x4*)(pp + 8); }
#pragma unroll
                    for (int j4 = 0; j4 < 4; ++j4) { const int tk = base + j4 * NW2;
                        if (tk < 2 * TOK) {
                            const int row = tk >> 1, which = tk & 1, j = lane & 3;
                            bf16_t* pp = proj + (size_t)row * NP + (which ? C_DK : C_DQ) + lane * 16;
                            f32x4 f0, f1, f2, f3; unpack8(wv[j4][0], f0, f1); unpack8(wv[j4][1], f2, f3);
                            float ss = sum4(f0 * f0) + sum4(f1 * f1) + sum4(f2 * f2) + sum4(f3 * f3);
                            ss += swz_xor<1>(ss); ss += swz_xor<2>(ss);
                            const float rs = rs_of(ss, 1.f / 64);
                            const float* gg = (which ? gkd : gqd) + 16 * j;
                            f0 *= *(const f32x4*)gg * rs; f1 *= *(const f32x4*)(gg + 4) * rs; f2 *= *(const f32x4*)(gg + 8) * rs; f3 *= *(const f32x4*)(gg + 12) * rs;
                            if (j == 0) {
                                const float* cr = cs + (size_t)row * 16;
                                const f32x4 c0 = *(const f32x4*)cr, c1 = *(const f32x4*)(cr + 4), s0 = *(const f32x4*)(cr + 8), s1 = *(const f32x4*)(cr + 12);
                                const f32x4 a0 = f0 * c0 - f2 * s0, a1 = f1 * c1 - f3 * s1, b0 = f2 * c0 + f0 * s0, b1 = f3 * c1 + f1 * s1;
                                f0 = a0; f1 = a1; f2 = b0; f3 = b1;
                            }
                            if (!which) { const float sc = 0.125f * LOG2E; f0 *= sc; f1 *= sc; f2 *= sc; f3 *= sc; }
                            bf16_t* po = real2 ? pp : mg + (size_t)row * DM + lane * 16; *(u32x4*)po = pack8(f0, f1); *(u32x4*)(po + 8) = pack8(f2, f3);
                        } }
                }
#pragma unroll 1
                for (int base = gw2; base < 2 * TOK; base += 2 * NW2) {
                    u32x4 vc[2][3], vx[2][3], vb[2];
#pragma unroll
                    for (int j2 = 0; j2 < 2; ++j2) { const int tk = min(base + j2 * NW2, 2 * TOK - 1);
                        const int id = tk * 64 + lane, row = id >> 7, ch = (id & 127) * 8, sq = row & (SEQ - 1); const bf16_t* pr = proj + (size_t)row * NP;
#pragma unroll
                        for (int jj = 0; jj < 3; ++jj) { const bf16_t* q = pr - (size_t)((sq - 2 + jj >= 0) ? (2 - jj) : 0) * NP; vc[j2][jj] = *(const u32x4*)(q + C_CC + ch); vx[j2][jj] = *(const u32x4*)(q + C_CX + ch); }
                        vb[j2] = *(const u32x4*)(pr + C_CB + ch); }
#pragma unroll
                    for (int j2 = 0; j2 < 2; ++j2) { const int tk = base + j2 * NW2;
                        if (tk < 2 * TOK) { const int id = tk * 64 + lane, row = id >> 7, ch = (id & 127) * 8, sq = row & (SEQ - 1);
                            f32x4 u0 = {0.f, 0.f, 0.f, 0.f}, u1 = u0;
#pragma unroll
                            for (int jj = 0; jj < 3; ++jj) {
                                if (sq - 2 + jj >= 0) { f32x4 a0, a1, b0, b1; unpack8(vc[j2][jj], a0, a1); unpack8(vx[j2][jj], b0, b1);
                                    u0 += *(const f32x4*)(cw + jj * 1024 + ch) * (a0 * b0); u1 += *(const f32x4*)(cw + jj * 1024 + ch + 4) * (a1 * b1); } }
                            f32x4 g0, g1; unpack8(vb[j2], g0, g1);
                            *(u32x4*)(real2 ? proj + (size_t)row * NP + C_CA + ch : mg + (size_t)row * DM + 1024 + ch) = pack8(g0 * u0, g1 * u1);
                        } }
                }
            }
            }
        } else if (p == 3) {
            PHASE_TID();
            if (PH_EN(3) && !(args.flags & FL_SKIP_ATTN)) {
                const AttnConsts ac = attn_consts((const float*)args.in[7] + l * 64, (const float*)args.in[8] + l * 64, (const float*)args.in[9] + l * 256, l, lane);
                const float* gsub = (const float*)args.in[10] + l * 128;
#pragma unroll 1
                for (int rep = 0; rep < REP_ATTN; ++rep) {
                    const bool real = (rep == REP_ATTN - 1);
                    const int v = vcu, bh = v >> 4, s = v & 15;
#pragma unroll 1
                    for (int i = 0; i < 4; ++i) { const int qb = (i == 0) ? 63 - s : (i == 1) ? 32 + s : (i == 2) ? 31 - s : s;
                        if (ac.Mfix <= 40.f) diff_attn_unit<true>(lds, proj, VT, bh >> 3, bh & 7, qb, ac, gsub, phase_tid(wave0), real ? proj : mg, real ? NP : DM, real ? C_OB : 0);
                        else diff_attn_unit<false>(lds, proj, VT, bh >> 3, bh & 7, qb, ac, gsub, phase_tid(wave0), real ? proj : mg, real ? NP : DM, real ? C_OB : 0); }
                }
            }
            if (PH_EN(8) && !(args.flags & FL_SKIP_CROSS)) {
#pragma unroll 1
                for (int repx = 0; repx < REP_X; ++repx) {
                    const int u = bx; const bool realx = repx == REP_X - 1;
                    const int b = u >> 7, h = (u >> 5) & 3, qb = u & 31;
                    { pg8::Gemm g{proj + C_XQ + h * 256, mkraw + (size_t)(b * 256) * 1024 + h * 256, TOK, 256, 256, NP, 1024};
                      LAS float* rkl = (LAS float*)(lds + pg8::STAGE_BYTES);
                      if (tid < 256) rkl[tid] = rs_of(kss[(b * 256 + tid) * 4 + h], 1.f / 256);
                      __syncthreads();
                      pg8::OneUnit S{{b * 32 + qb, 0, 0, 0}, true}; pg8::EpiWrap<EXs<true>> E{EXs<true>{proj, qss, kss, realx ? lsum : nullptr, xsh + l, (unsigned)(uintptr_t)rkl, b, h, LOG2E / 16.f}}; pg8::gemm_phase(lds, g, S, E, phase_tid(wave0)); }
                    __threadfence(); __syncthreads();
                    { pg8::Gemm g{proj + C_P + h * 256, mvT + (size_t)(h * 256) * 512 + b * 256, TOK, 256, 256, NP, 512};
                      pg8::OneUnit S{{b * 32 + qb, 0, 0, 0}, true}; pg8::EpiWrap<EXo> E{EXo{proj, lsum, h, 0}}; pg8::gemm_phase(lds, g, S, E, phase_tid(wave0)); }
                }
            }
        } else if (p == 4) {
            PHASE_TID();
            if (PH_EN(4) && !(args.flags & FL_SKIP_MAIN)) {
#pragma unroll 1
                for (int rep = 0; rep < REP_P4; ++rep) {
                    pg8::Gemm g{proj, Wc_t, TOK, DM, 1024, NP, 1024}; pg8::ChainOrder S; S.base.init(TOK, DM, G, bx);
                    pg8::EpiChain E{mg, proj}; pg8::gemm_phase(lds, g, S, E, phase_tid(wave0));
                }
            }
        } else if (p == 5) {
            PHASE_TID();
            if (PH_EN(5) && !(args.flags & FL_SKIP_MAIN)) {
#pragma unroll 1
                for (int rep = 0; rep < REP_P5; ++rep) { const bool real = rep == REP_P5 - 1;
                pg8::Gemm g{mg, Wo_t, TOK, DM, DM, DM, DM}; pg8::StaticOrder S; S.init(TOK, DM, G, bx);
                pg8::EpiWrap<ERes> E{ERes{l == 0 ? x_in : xcur, real ? xcur : (float*)(ws + WS_PROJ + 192 * MiB), real ? xb : (bf16_t*)(ws + WS_PROJ + 320 * MiB), real ? ssb + (size_t)(2 * l + 1) * TOK : nullptr}}; pg8::gemm_phase(lds, g, S, E, phase_tid(wave0)); }
            }
        } else if (p == 6) {
            PHASE_TID();
            if (PH_EN(6) && !(args.flags & FL_SKIP_MAIN)) {
#pragma unroll 1
                for (int rep = 0; rep < REP_GU; ++rep) {
                pg8::Gemm g{xb, Wgu_t, TOK, 2 * DFF, DM, DM, DM}; pg8::StaticOrder S; S.init(TOK, 2 * DFF, G, bx);
                pg8::EpiWrap<EGU> E{EGU{hb, ssb + (size_t)(2 * l + 1) * TOK}}; pg8::gemm_phase(lds, g, S, E, phase_tid(wave0)); }
            }
        } else {
            PHASE_TID();
            if (PH_EN(7) && !(args.flags & FL_SKIP_MAIN)) {
#pragma unroll 1
                for (int rep = 0; rep < REP_P7; ++rep) { const bool real = rep == REP_P7 - 1;
                pg8::Gemm g{hb, Wdn_t, TOK, DM, DFF, DFF, DFF}; pg8::StaticOrder S; S.init(TOK, DM, G, bx);
                pg8::EpiWrap<ERes> E{ERes{xcur, real ? xcur : (float*)(ws + WS_PROJ + 192 * MiB), real ? xb : (bf16_t*)(ws + WS_PROJ + 320 * MiB), (real && l == 0) ? ssb + (size_t)2 * TOK : nullptr}}; pg8::gemm_phase(lds, g, S, E, phase_tid(wave0)); }
            }
        }
        if (ph + 1 < args.hi) { if (!(args.flags & FL_XCDBAR) || ph == args.lo) grid.sync(); else xcd_barrier(xbar); }
    }
}

template <class E> static void launch_naive(const bf16_t* A, int lda, const bf16_t* Bt, int ldb, int M, int N, int K, E e, hipStream_t st) {
    const size_t n = (size_t)(M / 32) * (E::PAIRED ? (N / 256) * 4 : N / 32);
    hipLaunchKernelGGL(naive_gemm<E>, dim3((unsigned)((n + 3) / 4)), dim3(256), 0, st, A, Bt, e, lda, ldb, M, N, K, 0);
}

extern "C" void kernel_launch(void* const* d_in, const int* in_sizes, int n_in, void* d_out, int out_size, void* d_ws, size_t ws_size, hipStream_t stream) {
    static int grid = 0;
    if (grid == 0) {
        if (n_in != 21 || out_size != TOK * DM || ws_size < WS_END) { fprintf(stderr, "kernel_launch: unexpected shapes / workspace (%d inputs, out %d, ws %zu < %zu)\n", n_in, out_size, ws_size, (size_t)WS_END); grid = -1; return; }
        int dev = 0, cus = 0, per_cu = 0;
        hipGetDevice(&dev); hipDeviceGetAttribute(&cus, hipDeviceAttributeMultiprocessorCount, dev);
        hipFuncSetAttribute((const void*)mega, hipFuncAttributeMaxDynamicSharedMemorySize, LDS_BYTES);
        hipOccupancyMaxActiveBlocksPerMultiprocessor(&per_cu, (const void*)mega, 512, LDS_BYTES);
        if (per_cu < 1) per_cu = 1;
        grid = cus * per_cu; if (grid > 256) grid = 256;
        if (grid != 256) { fprintf(stderr, "kernel_launch: needs 256 co-resident workgroups, got %d\n", grid); grid = -1; return; }
        (void)hipGetLastError();
    }
    if (grid < 0) return;
    unsigned char* ws = (unsigned char*)d_ws;
    Args a{};
    for (int i = 0; i < 21; ++i) a.in[i] = d_in[i];
    a.out = (float*)d_out; a.ws = ws;
    float* ssb = (float*)(ws + WS_SS); float* qssb = (float*)(ws + WS_QSS); float* lsumb = (float*)(ws + WS_LSUM); float* kssb = (float*)(ws + WS_KSS); float* ssmem = (float*)(ws + WS_SSMEM);
    bf16_t* memb = (bf16_t*)(ws + WS_MEMB); bf16_t* mkraw = (bf16_t*)(ws + WS_MKRAW); bf16_t* mvT = (bf16_t*)(ws + WS_MVT);
    bf16_t* Win_t = (bf16_t*)(ws + WS_WIN); bf16_t* Wc_t = (bf16_t*)(ws + WS_WC); bf16_t* Wd_t = (bf16_t*)(ws + WS_WD); bf16_t* Wx_t = (bf16_t*)(ws + WS_WX);
    bf16_t* Wmkv_t = (bf16_t*)(ws + WS_WMKV); bf16_t* Wo_t = (bf16_t*)(ws + WS_WO); bf16_t* Wgu_t = (bf16_t*)(ws + WS_WGU); bf16_t* Wdn_t = (bf16_t*)(ws + WS_WDN);
    bf16_t* proj = (bf16_t*)(ws + WS_PROJ); bf16_t* VT = (bf16_t*)(ws + WS_VT); bf16_t* xb = (bf16_t*)(ws + WS_XB); bf16_t* mg = (bf16_t*)(ws + WS_MG); bf16_t* hb = (bf16_t*)(ws + WS_H);
    const float* x_in = (const float*)d_in[0]; float* xcur = (float*)d_out;

    static Args store[NPHASE + 1]; int nco = 0;
    auto coop = [&](int lo, int hi, int flags) {
        a.lo = lo; a.hi = hi; a.flags = flags; store[nco] = a;
        void* kargs[] = {&store[nco]}; ++nco;
        hipError_t e = hipSuccess;
        if (hi - lo == 1) hipLaunchKernelGGL(mega, dim3(grid), dim3(512), LDS_BYTES, stream, store[nco - 1]);
        else e = hipLaunchCooperativeKernel((const void*)mega, dim3(grid), dim3(512), kargs, LDS_BYTES, stream);
        if (e != hipSuccess) fprintf(stderr, "cooperative launch failed: %s (grid %d)\n", hipGetErrorString(e), grid);
    };
    auto is_naive = [](int p) { return p != 0 && ((NAIVE_MASK >> p) & 1); };
    int ph = 0;
#ifndef STOP_PH
#define STOP_PH NPHASE
#endif
    while (ph < STOP_PH) {
        const int l = ph >> 3, p = ph & 7;
#ifndef SKIP_PH
#define SKIP_PH 0x0
#endif
        if ((SKIP_PH >> p) & 1) { ++ph; continue; }
        const bool cross_naive = (NAIVE_MASK >> 8) & 1;
        const bool pure_fast = !is_naive(p) && !(p == 3 && cross_naive);
        if (pure_fast) {
            int e = ph + 1;
            while (e < STOP_PH) { const int q = e & 7; if (is_naive(q) || (q == 3 && cross_naive)) break; ++e; }
            const bool whole = (ph == 0 && e == NPHASE);
            if (whole) (void)hipMemsetAsync(ws + WS_BAR, 0, WS_BAR_BYTES, stream);
            coop(ph, e, whole ? FL_XCDBAR : 0); ph = e; continue;
        }
        const float* gq_x = (const float*)d_in[14] + l * 256; const float* gk_x = (const float*)d_in[15] + l * 256;
        float* qss = qssb + (size_t)l * TOK * 4; float* lsum = lsumb + (size_t)l * TOK * 4; float* kss = kssb + l * 2048;
        const float* ss0 = ssb + (size_t)(2 * l) * TOK; float* ss1 = ssb + (size_t)(2 * l + 1) * TOK;
        if (p == 1) {
            launch_naive(xb, DM, Win_t, DM, TOK, NP, DM, EIn{proj, ss0, gq_x, gk_x, qss}, stream);
            launch_naive(Win_t + (size_t)NP * DM, DM, xb, DM, 1024, TOK, DM, EColScale{VT, ss0, TOK, 0}, stream);
        } else if (p == 2) {
            coop(ph, ph + 1, FL_SKIP_MEMKV);
            launch_naive(memb, DM, Wmkv_t, DM, 512, 1024, DM, EMemK{mkraw, ssmem, kss}, stream);
            launch_naive(Wmkv_t + (size_t)1024 * DM, DM, memb, DM, 1024, 512, DM, EColScale{mvT, ssmem, 512, 0}, stream);
        } else if (p == 3) {
            const bool attn_naive = is_naive(3);
            if (!attn_naive || !cross_naive) coop(ph, ph + 1, (attn_naive ? FL_SKIP_ATTN : 0) | (cross_naive ? FL_SKIP_CROSS : 0));
            if (attn_naive && !(DBG_SKIP & 1))
                hipLaunchKernelGGL(naive_diff_attn, dim3(16 * 256), dim3(256), 0, stream, proj, VT, (const float*)d_in[7] + l * 64, (const float*)d_in[8] + l * 64,
                                   (const float*)d_in[9] + l * 256, (const float*)d_in[10] + l * 128, l, 0);
            if (cross_naive && !(DBG_SKIP & 2)) {
                for (int b = 0; b < BATCH; ++b) for (int h = 0; h < 4; ++h) {
                    launch_naive(proj + (size_t)b * SEQ * NP + C_XQ + h * 256, NP, mkraw + (size_t)(b * 256) * 1024 + h * 256, 1024, SEQ, 256, 256,
                                 EXs<false>{proj + (size_t)b * SEQ * NP, qss + (size_t)b * SEQ * 4, kss, lsum + (size_t)b * SEQ * 4, (const float*)(ws + WS_XSH) + l, 0u, b, h, LOG2E / 16.f}, stream);
                }
                for (int b = 0; b < BATCH; ++b) for (int h = 0; h < 4; ++h) {
                    launch_naive(proj + (size_t)b * SEQ * NP + C_P + h * 256, NP, mvT + (size_t)(h * 256) * 512 + b * 256, 512, SEQ, 256, 256,
                                 EXo{proj + (size_t)b * SEQ * NP, lsum + (size_t)b * SEQ * 4, h, 0}, stream);
                }
            }
        } else if (p == 4) {
            launch_naive(proj + C_CA, NP, Wc_t, 1024, TOK, DM, 1024, EMerge{mg, proj, 0, 0}, stream);
            launch_naive(proj + C_OB, NP, Wd_t, 1024, TOK, DM, 1024, EMerge{mg, proj, 1, 0}, stream);
            launch_naive(proj + C_OC, NP, Wx_t, 1024, TOK, DM, 1024, EMerge{mg, proj, 2, 0}, stream);
        } else if (p == 5) {
            launch_naive(mg, DM, Wo_t, DM, TOK, DM, DM, ERes{l == 0 ? x_in : xcur, xcur, xb, ss1}, stream);
        } else if (p == 6) {
            launch_naive(xb, DM, Wgu_t, DM, TOK, 2 * DFF, DM, EGU{hb, ss1}, stream);
        } else if (p == 7) {
            launch_naive(hb, DFF, Wdn_t, DFF, TOK, DM, DFF, ERes{xcur, xcur, xb, l == 0 ? ssb + (size_t)2 * TOK : nullptr}, stream);
        }
        ++ph;
    }
}
```

```cpp
#include <hip/hip_runtime.h>
#include <hip/hip_cooperative_groups.h>
#include <cstdio>
#include <cstdint>
namespace cg = cooperative_groups;

#ifndef NAIVE_MASK
#define NAIVE_MASK 0x0
#endif

#ifndef REP_ATTN
#define REP_ATTN 1
#endif
#ifndef REP_P0
#define REP_P0 1
#endif
#ifndef REP_P1
#define REP_P1 1
#endif
#ifndef REP_P4
#define REP_P4 1
#endif
#ifndef REP_P5
#define REP_P5 1
#endif
#ifndef REP_P7
#define REP_P7 1
#endif
#ifndef REP_P2
#define REP_P2 1
#endif
#ifndef REP_X
#define REP_X 1
#endif
#ifndef REP_GU
#define REP_GU 1
#endif
#ifndef DBG_SKIP
#define DBG_SKIP 0
#endif
#ifndef EN_MASK
#define EN_MASK 0xFFFF
#endif
#define PH_EN(n) (((EN_MASK) >> (n)) & 1)
constexpr int BATCH = 2, SEQ = 8192, DM = 2048, TOK = BATCH * SEQ, NIN = 13312, NP = 12288, DFF = 5632, MEMLEN = 256, DEPTH = 2;
constexpr float EPS = 1e-6f, LOG2E = 1.4426950408889634f;
constexpr int C_CB = 0, C_CC = 1024, C_CX = 2048, C_DQ = 3072, C_DK = 4096, C_XQ = 5120, C_G = 6144;
constexpr int C_CA = 0, C_P = 1024, C_OC = 2048, C_OB = 3072;

typedef unsigned short bf16_t;
typedef float f32x4 __attribute__((ext_vector_type(4)));
typedef float f32x2 __attribute__((ext_vector_type(2)));
typedef float f32x16 __attribute__((ext_vector_type(16)));
typedef unsigned u32x4 __attribute__((ext_vector_type(4)));
typedef unsigned u32x2 __attribute__((ext_vector_type(2)));
typedef short bf16x8 __attribute__((ext_vector_type(8)));
typedef __bf16 bf16x2_t __attribute__((ext_vector_type(2)));
#define LAS __attribute__((address_space(3)))

constexpr size_t MiB = 1u << 20, KiB = 1024;
constexpr size_t WS_SS = 0, WS_QSS = 256 * KiB, WS_LSUM = 768 * KiB, WS_KSS = 1280 * KiB, WS_SSMEM = 1296 * KiB, WS_ZERO_LO = 64 * KiB, WS_ZERO_HI = 1296 * KiB;
constexpr size_t WS_XSH = 1300 * KiB;
constexpr size_t WS_CS = 2 * MiB, WS_MEMB = 4 * MiB, WS_MKRAW = 6 * MiB, WS_MVT = 7 * MiB;
constexpr size_t WS_WIN = 8 * MiB, WS_WC = 60 * MiB, WS_WD = 64 * MiB, WS_WX = 68 * MiB, WS_WMKV = 72 * MiB, WS_WO = 80 * MiB, WS_WGU = 88 * MiB, WS_WDN = 132 * MiB;
constexpr size_t WS_PROJ = 154 * MiB, WS_VT = 538 * MiB, WS_XB = 570 * MiB, WS_MG = 634 * MiB, WS_END = 698 * MiB;
constexpr size_t WS_H = WS_PROJ;

__device__ __forceinline__ unsigned pk2(float lo, float hi) { f32x2 v = {lo, hi}; bf16x2_t b = __builtin_convertvector(v, bf16x2_t); return __builtin_bit_cast(unsigned, b); }
__device__ __forceinline__ u32x4 pack8(f32x4 a, f32x4 b) { u32x4 w; w.x = pk2(a.x, a.y); w.y = pk2(a.z, a.w); w.z = pk2(b.x, b.y); w.w = pk2(b.z, b.w); return w; }
__device__ __forceinline__ float blo(unsigned w) { return __uint_as_float(w << 16); }
__device__ __forceinline__ float bhi(unsigned w) { return __uint_as_float(w & 0xffff0000u); }
__device__ __forceinline__ void unpack8(u32x4 w, f32x4& a, f32x4& b) { a = (f32x4){blo(w.x), bhi(w.x), blo(w.y), bhi(w.y)}; b = (f32x4){blo(w.z), bhi(w.z), blo(w.w), bhi(w.w)}; }
__device__ __forceinline__ int opaque(int v) { asm volatile("" : "+v"(v)); return v; }
__device__ __forceinline__ int phase_tid(int wave0) { int t; asm volatile("v_mbcnt_lo_u32_b32 %0, -1, 0\n\tv_mbcnt_hi_u32_b32 %0, -1, %0" : "=v"(t)); return t | (wave0 << 6); }
__device__ __forceinline__ float sum4(f32x4 v) { return (v.x + v.y) + (v.z + v.w); }
__device__ __forceinline__ float rs_of(float ss, float invn) { return rsqrtf(ss * invn + EPS); }
__constant__ float INVF[8] = {1.0f, 0.1939227432012558f, 0.03760603070259094f, 0.007292664609849453f, 0.0014142135623842478f, 0.00027424818836152554f, 5.3182957344688475e-05f, 1.0313385246263351e-05f};
__device__ __forceinline__ float xor32_sum(float v) { auto rr = __builtin_amdgcn_permlane32_swap(__float_as_uint(v), __float_as_uint(v), false, false); return __uint_as_float(rr[0]) + __uint_as_float(rr[1]); }
__device__ __forceinline__ float xor32_max(float v) { auto rr = __builtin_amdgcn_permlane32_swap(__float_as_uint(v), __float_as_uint(v), false, false); return fmaxf(__uint_as_float(rr[0]), __uint_as_float(rr[1])); }
template <int X> __device__ __forceinline__ float swz_xor(float v) { return __int_as_float(__builtin_amdgcn_ds_swizzle(__float_as_int(v), 0x1f | (X << 10))); }
__device__ __forceinline__ float wave_sum(float v) {
    v += swz_xor<1>(v); v += swz_xor<2>(v); v += swz_xor<4>(v); v += swz_xor<8>(v); v += swz_xor<16>(v); v = xor32_sum(v);
    return v;
}
__device__ __forceinline__ float wave_max(float v) {
    v = fmaxf(v, swz_xor<1>(v)); v = fmaxf(v, swz_xor<2>(v)); v = fmaxf(v, swz_xor<4>(v)); v = fmaxf(v, swz_xor<8>(v)); v = fmaxf(v, swz_xor<16>(v)); v = xor32_max(v);
    return v;
}
__device__ __forceinline__ float sigmoidf_(float v) { return __builtin_amdgcn_rcpf(1.f + __expf(-v)); }

struct EIn {
    static constexpr bool PAIRED = false;
    bf16_t* proj; const float* ss; const float* gq; const float* gk; float* qss;
    __device__ __forceinline__ float* target(int row, int col0) const { return (qss && col0 >= C_XQ && col0 < C_G) ? qss + row * 4 + ((col0 - C_XQ) >> 8) : nullptr; }
    __device__ __forceinline__ float rowscale(int row) const { return rs_of(ss[row], 1.f / DM); }
    __device__ __forceinline__ float apply(int row, int col0, f32x4 a, f32x4 b, float rs) const {
        a *= rs; b *= rs; float s = 0.f;
        if (col0 >= C_G) {
#pragma unroll
            for (int i = 0; i < 4; ++i) { a[i] = sigmoidf_(a[i]); b[i] = sigmoidf_(b[i]); }
        } else if (col0 >= C_XQ) {
            const int d = (col0 - C_XQ) & 255;
            s = sum4(a * a) + sum4(b * b);
            const f32x4 g0 = *(const f32x4*)(gq + d) * *(const f32x4*)(gk + d), g1 = *(const f32x4*)(gq + d + 4) * *(const f32x4*)(gk + d + 4);
            a *= g0; b *= g1;
        }
        *(u32x4*)(proj + (size_t)row * NP + col0) = pack8(a, b);
        return s;
    }
};
struct EColScale {
    static constexpr bool PAIRED = false;
    bf16_t* O; const float* ss; int ldc, pad;
    __device__ __forceinline__ float* target(int, int) const { return nullptr; }
    __device__ __forceinline__ float rowscale(int) const { return 1.f; }
    __device__ __forceinline__ float apply(int row, int col0, f32x4 a, f32x4 b, float) const {
        const f32x4 s0 = *(const f32x4*)(ss + col0), s1 = *(const f32x4*)(ss + col0 + 4);
#pragma unroll
        for (int i = 0; i < 4; ++i) { a[i] *= rs_of(s0[i], 1.f / DM); b[i] *= rs_of(s1[i], 1.f / DM); }
        *(u32x4*)(O + (size_t)row * ldc + col0) = pack8(a, b);
        return 0.f;
    }
};
struct EMemK {
    static constexpr bool PAIRED = false;
    bf16_t* O; const float* ssmem; float* kss;
    __device__ __forceinline__ float* target(int row, int col0) const { return kss ? kss + row * 4 + (col0 >> 8) : nullptr; }
    __device__ __forceinline__ float rowscale(int row) const { return rs_of(ssmem[row], 1.f / DM); }
    __device__ __forceinline__ float apply(int row, int col0, f32x4 a, f32x4 b, float rs) const {
        a *= rs; b *= rs;
        *(u32x4*)(O + (size_t)row * 1024 + col0) = pack8(a, b);
        return sum4(a * a) + sum4(b * b);
    }
};
template <bool LDSRK> struct EXs {
    static constexpr bool PAIRED = false;
    bf16_t* proj; const float* qss; const float* kss; float* lsum; const float* Mxp; unsigned rkl; int b, h; float c;
    __device__ __forceinline__ float* target(int row, int) const { return lsum ? lsum + row * 4 + h : nullptr; }
    __device__ __forceinline__ float rowscale(int row) const { return rs_of(qss[row * 4 + h], 1.f / 256) * c; }
    __device__ __forceinline__ float apply(int row, int col0, f32x4 a, f32x4 bb, float rq) const {
        const float Mx = __hip_atomic_load(Mxp, __ATOMIC_RELAXED, __HIP_MEMORY_SCOPE_AGENT);
        f32x4 k0, k1;
        if constexpr (LDSRK) { const LAS float* rk = (const LAS float*)rkl; k0 = *(const LAS f32x4*)(rk + col0); k1 = *(const LAS f32x4*)(rk + col0 + 4); }
        else {
#pragma unroll
            for (int i = 0; i < 4; ++i) { k0[i] = rs_of(kss[(b * 256 + col0 + i) * 4 + h], 1.f / 256); k1[i] = rs_of(kss[(b * 256 + col0 + 4 + i) * 4 + h], 1.f / 256); }
        }
        float s = 0.f;
#pragma unroll
        for (int i = 0; i < 4; ++i) {
            a[i] = __builtin_amdgcn_exp2f(a[i] * rq * k0[i] - Mx);
            bb[i] = __builtin_amdgcn_exp2f(bb[i] * rq * k1[i] - Mx);
            s += a[i] + bb[i];
        }
        *(u32x4*)(proj + (size_t)row * NP + C_P + h * 256 + col0) = pack8(a, bb);
        return s;
    }
};
struct EXo {
    static constexpr bool PAIRED = false;
    bf16_t* proj; const float* lsum; int h, pad;
    __device__ __forceinline__ float* target(int, int) const { return nullptr; }
    __device__ __forceinline__ float rowscale(int row) const { return 1.f / __hip_atomic_load(lsum + row * 4 + h, __ATOMIC_RELAXED, __HIP_MEMORY_SCOPE_AGENT); }
    __device__ __forceinline__ float apply(int row, int col0, f32x4 a, f32x4 b, float inv) const {
        a *= inv; b *= inv;
        *(u32x4*)(proj + (size_t)row * NP + C_OC + h * 256 + col0) = pack8(a, b);
        return 0.f;
    }
};
struct EMerge {
    static constexpr bool PAIRED = false;
    bf16_t* mg; const bf16_t* proj; int gi, pad;
    __device__ __forceinline__ float* target(int, int) const { return nullptr; }
    __device__ __forceinline__ float rowscale(int) const { return 1.f; }
    __device__ __forceinline__ float apply(int row, int col0, f32x4 a, f32x4 b, float) const {
        f32x4 g0, g1; unpack8(*(const u32x4*)(proj + (size_t)row * NP + C_G + gi * 2048 + col0), g0, g1);
        a *= g0; b *= g1;
        bf16_t* p = mg + (size_t)row * DM + col0;
        if (gi > 0) { f32x4 m0, m1; unpack8(*(const u32x4*)p, m0, m1); a += m0; b += m1; }
        *(u32x4*)p = pack8(a, b);
        return 0.f;
    }
};
struct ERes {
    static constexpr bool PAIRED = false;
    const float* xin; float* xout; bf16_t* xb; float* ssn;
    __device__ __forceinline__ float* target(int row, int) const { return ssn ? ssn + row : nullptr; }
    __device__ __forceinline__ float rowscale(int) const { return 1.f; }
    static constexpr bool HASPRE = true;
    __device__ __forceinline__ void pre(int row, int col0, f32x4& p0, f32x4& p1) const { const size_t off = (size_t)row * DM + col0; p0 = *(const f32x4*)(xin + off); p1 = *(const f32x4*)(xin + off + 4); }
    __device__ __forceinline__ float apply(int row, int col0, f32x4 a, f32x4 b, float rs) const { f32x4 p0, p1; pre(row, col0, p0, p1); return apply_pre(row, col0, a, b, rs, p0, p1); }
    __device__ __forceinline__ float apply_pre(int row, int col0, f32x4 a, f32x4 b, float, f32x4 p0, f32x4 p1) const {
        const size_t off = (size_t)row * DM + col0;
        a += p0; b += p1;
        *(f32x4*)(xout + off) = a; *(f32x4*)(xout + off + 4) = b;
        *(u32x4*)(xb + off) = pack8(a, b);
        return sum4(a * a) + sum4(b * b);
    }
};
struct EGU {
    static constexpr bool PAIRED = true;
    bf16_t* H; const float* ss;
    __device__ __forceinline__ float rowscale(int row) const { return rs_of(ss[row], 1.f / DM); }
    __device__ __forceinline__ void apply2(int row, int lcol0, f32x4 a0, f32x4 a1, f32x4 b0, f32x4 b1, float rs) const {
#pragma unroll
        for (int i = 0; i < 4; ++i) {
            const float x = a0[i] * rs, y = a1[i] * rs;
            a0[i] = x * sigmoidf_(x) * (b0[i] * rs); a1[i] = y * sigmoidf_(y) * (b1[i] * rs);
        }
        *(u32x4*)(H + (size_t)row * DFF + lcol0) = pack8(a0, a1);
    }
};

__device__ __forceinline__ float dot8(u32x4 a, u32x4 b) {
    float s = blo(a.x) * blo(b.x); s += bhi(a.x) * bhi(b.x); s += blo(a.y) * blo(b.y); s += bhi(a.y) * bhi(b.y);
    s += blo(a.z) * blo(b.z); s += bhi(a.z) * bhi(b.z); s += blo(a.w) * blo(b.w); s += bhi(a.w) * bhi(b.w); return s;
}
__device__ __forceinline__ int pi32(int i) { return (i & 0x13) | ((i & 4) << 1) | ((i & 8) >> 1); }
template <class E> __global__ void __launch_bounds__(256) naive_gemm(const bf16_t* A, const bf16_t* Bt, E e, int lda, int ldb, int M, int N, int K, int pad) {
    const int lane = threadIdx.x & 63, i32 = lane & 31, hi = lane >> 5;
    const int nct = E::PAIRED ? (N / 256) * 4 : N / 32;
    const long w = (long)blockIdx.x * 4 + (threadIdx.x >> 6); if (w >= (long)(M / 32) * nct) return;
    const int mt = (int)(w / nct), ct = (int)(w % nct), row0 = mt * 32;
    const int pcol = E::PAIRED ? (ct >> 2) * 256 + (ct & 3) * 32 : ct * 32, lcol = E::PAIRED ? (ct >> 2) * 128 + (ct & 3) * 32 : pcol;
    const bf16_t* ap = A + (size_t)(row0 + i32) * lda + 8 * hi;
    const bf16_t* bp = Bt + (size_t)(pcol + pi32(i32)) * ldb + 8 * hi;
    f32x16 acc, acc2;
#pragma unroll
    for (int r = 0; r < 16; ++r) { acc[r] = 0.f; acc2[r] = 0.f; }
    for (int k = 0; k < K; k += 16) {
        const bf16x8 af = *(const bf16x8*)(ap + k), bf = *(const bf16x8*)(bp + k);
        acc = __builtin_amdgcn_mfma_f32_32x32x16_bf16(bf, af, acc, 0, 0, 0);
        if constexpr (E::PAIRED) { const bf16x8 bf2 = *(const bf16x8*)(bp + (size_t)128 * ldb + k); acc2 = __builtin_amdgcn_mfma_f32_32x32x16_bf16(bf2, af, acc2, 0, 0, 0); }
    }
    const int row = row0 + i32;
#pragma unroll
    for (int hf = 0; hf < 2; ++hf) {
        const f32x4 a = {acc[8 * hf], acc[8 * hf + 1], acc[8 * hf + 2], acc[8 * hf + 3]}, b = {acc[8 * hf + 4], acc[8 * hf + 5], acc[8 * hf + 6], acc[8 * hf + 7]};
        if constexpr (E::PAIRED) { const f32x4 c = {acc2[8 * hf], acc2[8 * hf + 1], acc2[8 * hf + 2], acc2[8 * hf + 3]}, d = {acc2[8 * hf + 4], acc2[8 * hf + 5], acc2[8 * hf + 6], acc2[8 * hf + 7]};
            e.apply2(row, lcol + 16 * hf + 8 * hi, a, b, c, d, e.rowscale(row)); }
        else { const float sp = e.apply(row, lcol + 16 * hf + 8 * hi, a, b, e.rowscale(row)); float* tg = e.target(row, lcol + 16 * hf + 8 * hi); if (tg) atomicAdd(tg, sp); }
    }
}

struct AttnConsts { float Mfix, lam, osc; };
__device__ __forceinline__ AttnConsts attn_consts(const float* gq, const float* gk, const float* lv, int layer, int lane) {
    AttnConsts c;
    const float mq = wave_max(fabsf(gq[lane])), mk = wave_max(fabsf(gk[lane]));
    c.Mfix = 8.f * mq * mk * LOG2E;
    const float s1 = wave_sum(lv[lane] * lv[64 + lane]), s2 = wave_sum(lv[128 + lane] * lv[192 + lane]);
    const float lam_init = 0.8f - 0.6f * expf(-0.3f * (float)layer);
    c.lam = expf(s1) - expf(s2) + lam_init; c.osc = 1.f - lam_init;
    return c;
}
__device__ __forceinline__ float xattn_shift(const float* gq, const float* gk, int lane) {
    float m = 0.f;
#pragma unroll
    for (int j = 0; j < 4; ++j) m = fmaxf(m, fabsf(gq[lane + 64 * j] * gk[lane + 64 * j]));
    return 16.f * wave_max(m) * LOG2E;
}

__global__ void __launch_bounds__(256) naive_diff_attn(bf16_t* proj, const bf16_t* VT, const float* gq, const float* gk, const float* lv, const float* gsub, int layer, int pad) {
    __shared__ float sQ[2][32][65], sK[2][32][65], sV[32][129], sP[2][32][33];
    const int t = threadIdx.x, lane = t & 63;
    const AttnConsts ac = attn_consts(gq, gk, lv, layer, lane);
    const int qt = blockIdx.x & 255, bh = blockIdx.x >> 8, b = bh >> 3, h = bh & 7;
    const size_t rowbase = (size_t)b * SEQ; const int q0 = qt * 32;
    for (int i = t; i < 2 * 32 * 64; i += 256) { const int c = i >> 11, r = (i >> 6) & 31, d = i & 63;
        sQ[c][r][d] = blo(proj[(rowbase + q0 + r) * NP + C_DQ + h * 128 + c * 64 + d]); }
    const int c = t >> 7, qr = (t & 127) >> 2, g4 = t & 3;
    float o[32]; float l = 0.f;
#pragma unroll
    for (int i = 0; i < 32; ++i) o[i] = 0.f;
    for (int kt = 0; kt <= qt; ++kt) {
        const int kv0 = kt * 32;
        __syncthreads();
        for (int i = t; i < 2 * 32 * 64; i += 256) { const int cc = i >> 11, r = (i >> 6) & 31, d = i & 63;
            sK[cc][r][d] = blo(proj[(rowbase + kv0 + r) * NP + C_DK + h * 128 + cc * 64 + d]); }
        for (int i = t; i < 32 * 128; i += 256) { const int d = i >> 5, r = i & 31;
            sV[r][d] = blo(VT[(size_t)(h * 128 + d) * TOK + rowbase + kv0 + r]); }
        __syncthreads();
#pragma unroll
        for (int j = 0; j < 8; ++j) { const int kv = g4 * 8 + j; float s = 0.f;
            for (int d = 0; d < 64; ++d) s += sQ[c][qr][d] * sK[c][kv][d];
            float p = __builtin_amdgcn_exp2f(s - ac.Mfix); if (kv0 + kv > q0 + qr) p = 0.f;
            sP[c][qr][kv] = p; }
        __syncthreads();
        for (int kv = 0; kv < 32; ++kv) { const float p = sP[c][qr][kv]; l += p;
#pragma unroll
            for (int i = 0; i < 32; ++i) o[i] += p * sV[kv][g4 * 32 + i]; }
    }
    __syncthreads();
    const float inv = 1.f / l;
    if (c == 1) {
#pragma unroll
        for (int i = 0; i < 32; ++i) sV[qr][g4 * 32 + i] = o[i] * inv; }
    __syncthreads();
    if (c == 0) {
        float ss = 0.f;
#pragma unroll
        for (int i = 0; i < 32; ++i) { o[i] = o[i] * inv - ac.lam * sV[qr][g4 * 32 + i]; ss += o[i] * o[i]; }
        ss += __shfl_xor(ss, 1); ss += __shfl_xor(ss, 2);
        const float rs = rs_of(ss, 1.f / 128) * ac.osc;
#pragma unroll
        for (int i = 0; i < 32; i += 2) {
            const int d = g4 * 32 + i;
            *(unsigned*)(proj + (rowbase + q0 + qr) * NP + C_OB + h * 128 + d) = pk2(o[i] * rs * gsub[d], o[i + 1] * rs * gsub[d + 1]);
        }
    }
}

namespace pg8 {
constexpr int BM = 256, BK = 64, HALF = 128, HTB = HALF * BK * 2, STAGE_BYTES = 8 * HTB, NXCD = 8, WGM = 8;
__host__ __device__ __forceinline__ int lds_byte(int r, int c) { const int st = (r >> 4) * 2 + (c >> 5), rr = r & 15, cc = c & 31, ob = rr * 64 + cc * 2; return st * 1024 + (ob ^ (((ob >> 9) & 1) << 5)); }
__host__ __device__ __forceinline__ void stage_rc(int b, int& R, int& C) { const int st = b / 1024, sb = b % 1024, swz = sb ^ (((sb >> 9) & 1) << 5); R = (st >> 1) * 16 + swz / 64; C = (st & 1) * 32 + (swz % 64) / 2; }
__host__ __device__ __forceinline__ int perm32(int rho) { const int n = rho >> 4, i = rho & 15; return 8 * (i >> 2) + 4 * n + (i & 3); }
struct Unit { int pm, pn, aoff, gi; };
struct Gemm { const bf16_t* A; const bf16_t* Bt; int M, N, K, lda, ldb; };
struct StaticOrder {
    int nM, nN, nwg, G, c;
    __device__ void init(int M, int N, int G_, int c_) { nM = M / BM; nN = N / BM; nwg = nM * nN; G = G_; c = c_; }
    __device__ bool next(int i, Unit& u) const {
        const long L = (long)i * G + c; if (L >= nwg || c >= G) return false;
        int wgid = (int)L; { const int q = nwg / NXCD, r = nwg % NXCD, xcd = wgid % NXCD, off = wgid / NXCD; wgid = (xcd < r ? xcd * (q + 1) : r * (q + 1) + (xcd - r) * q) + off; }
        const int nig = WGM * nN, gid = wgid / nig, fm = gid * WGM, gsz = (nM - fm) < WGM ? (nM - fm) : WGM;
        u.pm = fm + ((wgid % nig) % gsz); u.pn = (wgid % nig) / gsz; u.aoff = 0; u.gi = 0; return true;
    }
};
struct OneUnit { Unit u; bool valid; __device__ bool next(int i, Unit& o) const { if (i || !valid) return false; o = u; return true; } };

template <class F, class = void> struct has_pre { static constexpr bool value = false; };
template <class F> struct has_pre<F, decltype((void)F::HASPRE)> { static constexpr bool value = true; };
template <class F> struct EpiWrap {
    F f;
    __device__ __forceinline__ bool zero_after(const Unit&) const { return true; }
    __device__ __forceinline__ void operator()(f32x4 (&acc)[2][2][4][2], const Unit& u, int wr, int wc, int fr, int fq) const {
        f32x4 pr[2][2][2];
        float rsv[2][4];
#pragma unroll
        for (int ai = 0; ai < 2; ++ai)
#pragma unroll
            for (int m = 0; m < 4; ++m) rsv[ai][m] = f.rowscale(u.pm * BM + ai * HALF + wr * 64 + m * 16 + fr);
#pragma unroll
        for (int ai = 0; ai < 2; ++ai)
#pragma unroll
            for (int m = 0; m < 4; ++m) {
                const int row = u.pm * BM + ai * HALF + wr * 64 + m * 16 + fr;
                if constexpr (F::PAIRED) f.apply2(row, u.pn * 128 + wc * 32 + 8 * fq, acc[ai][0][m][0], acc[ai][0][m][1], acc[ai][1][m][0], acc[ai][1][m][1], rsv[ai][m]);
                else if constexpr (has_pre<F>::value) {
                    if ((m & 1) == 0) {
#pragma unroll
                        for (int mm = 0; mm < 2; ++mm)
#pragma unroll
                            for (int bj = 0; bj < 2; ++bj) f.pre(row + 16 * mm, u.pn * BM + bj * HALF + wc * 32 + 8 * fq, pr[mm][bj][0], pr[mm][bj][1]);
                    }
                    float sp = 0.f;
#pragma unroll
                    for (int bj = 0; bj < 2; ++bj) sp += f.apply_pre(row, u.pn * BM + bj * HALF + wc * 32 + 8 * fq, acc[ai][bj][m][0], acc[ai][bj][m][1], rsv[ai][m], pr[m & 1][bj][0], pr[m & 1][bj][1]);
                    float* tg = f.target(row, u.pn * BM + wc * 32 + 8 * fq);
                    if (tg) { sp += swz_xor<16>(sp); sp = xor32_sum(sp); if (fq == 0) atomicAdd(tg, sp); }
                } else {
                    float sp = 0.f;
#pragma unroll
                    for (int bj = 0; bj < 2; ++bj) sp += f.apply(row, u.pn * BM + bj * HALF + wc * 32 + 8 * fq, acc[ai][bj][m][0], acc[ai][bj][m][1], rsv[ai][m]);
                    float* tg = f.target(row, u.pn * BM + wc * 32 + 8 * fq);
                    if (tg) { sp += swz_xor<16>(sp); sp = xor32_sum(sp); if (fq == 0) atomicAdd(tg, sp); }
                }
                if (m == 3) asm volatile("" ::: "memory");
            }
    }
};

struct ChainOrder {
    StaticOrder base;
    __device__ bool next(int j, Unit& u) const {
        const int i = j / 3, gi = j - 3 * i; Unit t;
        if (!base.next(i, t)) return false;
        u.pm = t.pm; u.pn = gi * 8 + t.pn; u.aoff = (gi == 0) ? C_CA : (gi == 1) ? C_OB : C_OC; u.gi = gi; return true;
    }
};
struct EpiChain {
    bf16_t* mg; const bf16_t* proj;
    __device__ __forceinline__ bool zero_after(const Unit& u) const { return u.gi == 2; }
    __device__ __forceinline__ void operator()(f32x4 (&acc)[2][2][4][2], const Unit& u, int wr, int wc, int fr, int fq) const {
        const int pn = u.pn & 7, gi = u.gi;
        u32x4 gc[2][2], gn[2][2];
#pragma unroll
        for (int ai = 0; ai < 2; ++ai)
#pragma unroll
            for (int m = 0; m < 4; ++m) {
                const int row = u.pm * BM + ai * HALF + wr * 64 + m * 16 + fr;
                if ((m & 1) == 0) {
#pragma unroll
                    for (int mm = 0; mm < 2; ++mm)
#pragma unroll
                        for (int bj = 0; bj < 2; ++bj) {
                            const bf16_t* gp = proj + (size_t)(row + 16 * mm) * NP + C_G + gi * 2048 + pn * BM + bj * HALF + wc * 32 + 8 * fq;
                            gc[mm][bj] = *(const u32x4*)gp; if (gi < 2) gn[mm][bj] = *(const u32x4*)(gp + 2048);
                        }
                }
#pragma unroll
                for (int bj = 0; bj < 2; ++bj) {
                    const int col0 = pn * BM + bj * HALF + wc * 32 + 8 * fq;
                    f32x4 g0, g1; unpack8(gc[m & 1][bj], g0, g1);
                    if (gi < 2) {
                        f32x4 n0, n1; unpack8(gn[m & 1][bj], n0, n1);
#pragma unroll
                        for (int i = 0; i < 4; ++i) { g0[i] *= __builtin_amdgcn_rcpf(fmaxf(n0[i], 1e-30f)); g1[i] *= __builtin_amdgcn_rcpf(fmaxf(n1[i], 1e-30f)); }
                        acc[ai][bj][m][0] *= g0; acc[ai][bj][m][1] *= g1;
                    } else {
                        *(u32x4*)(mg + (size_t)row * DM + col0) = pack8(acc[ai][bj][m][0] * g0, acc[ai][bj][m][1] * g1);
                    }
                }
                if (m == 3) asm volatile("" ::: "memory");
            }
    }
};

template <class Epi, class Sched>
__device__ __forceinline__ void gemm_phase(LAS unsigned char* lds, const Gemm g, const Sched& S, const Epi& E, const int tid) {
    const int wid = __builtin_amdgcn_readfirstlane(tid >> 6), lane = tid & 63, wr = wid >> 2, wc = wid & 3, fr = lane & 15, fq = lane >> 4;
    const int K = g.K, nt = K / BK;
    unsigned voffA[2], voffB[2];
#pragma unroll
    for (int i = 0; i < 2; ++i) { int R, C; stage_rc(tid * 16 + i * 8192, R, C); const int Rb = (R & ~31) + perm32(R & 31);
        voffA[i] = (unsigned)(R * g.lda + C) * 2u; voffB[i] = (unsigned)(Rb * g.ldb + C) * 2u; }
    const size_t kstep = (size_t)(BK * 2);
    const size_t hstepA = (size_t)HALF * g.lda * 2, hstepB = (size_t)HALF * g.ldb * 2, tstepA = 2 * hstepA, tstepB = 2 * hstepB;
    const unsigned ldsw = (unsigned)wid * 1024u;
    const int aoff = lds_byte(wr * 64 + fr, fq * 8), boff = lds_byte(wc * 32 + fr, fq * 8);
#define PG8_SA(b, h) (((b) * 2 + (h)) * HTB)
#define PG8_SB(b, h) ((4 + (b) * 2 + (h)) * HTB)
#define PG8_STAGE(bufoff, gbase, voff) do { _Pragma("unroll") for (int _i = 0; _i < 2; ++_i) \
        __builtin_amdgcn_global_load_lds((const unsigned*)((const char*)(gbase) + (voff)[_i]), (LAS unsigned*)(lds + (bufoff) + ldsw + _i * 8192), 16, 0, 0); } while (0)
#define PG8_LDA(dst, b, h) do { _Pragma("unroll") for (int m = 0; m < 4; ++m) _Pragma("unroll") for (int k = 0; k < 2; ++k) dst[m][k] = *(const LAS bf16x8*)(lds + PG8_SA(b, h) + aoff + m * 2048 + k * 1024); } while (0)
#define PG8_LDB(dst, b, h) do { _Pragma("unroll") for (int n = 0; n < 2; ++n) _Pragma("unroll") for (int k = 0; k < 2; ++k) dst[n][k] = *(const LAS bf16x8*)(lds + PG8_SB(b, h) + boff + n * 2048 + k * 1024); } while (0)
#define PG8_MMA(ai, bj, At, Bt) do { __builtin_amdgcn_s_setprio(1); _Pragma("unroll") for (int m = 0; m < 4; ++m) _Pragma("unroll") for (int n = 0; n < 2; ++n) _Pragma("unroll") for (int k = 0; k < 2; ++k) \
        acc[ai][bj][m][n] = __builtin_amdgcn_mfma_f32_16x16x32_bf16(Bt[n][k], At[m][k], acc[ai][bj][m][n], 0, 0, 0); __builtin_amdgcn_s_setprio(0); } while (0)
#define PG8_WAIT_V(n) asm volatile("s_waitcnt vmcnt(" #n ")" ::: "memory")
#define PG8_WAIT_L(n) asm volatile("s_waitcnt lgkmcnt(" #n ")" ::: "memory")
#define PG8_BAR __builtin_amdgcn_s_barrier()
#define PG8_SCHED __builtin_amdgcn_sched_barrier(0)
    Unit cur, nxt; int ui = 0;
    if (!S.next(0, cur)) return;
    f32x4 acc[2][2][4][2];
#pragma unroll
    for (int a = 0; a < 2; ++a)
#pragma unroll
        for (int b = 0; b < 2; ++b)
#pragma unroll
            for (int m = 0; m < 4; ++m)
#pragma unroll
                for (int n = 0; n < 2; ++n) acc[a][b][m][n] = (f32x4){0.f, 0.f, 0.f, 0.f};
    bf16x8 At[4][2], B0[2][2], B1[2][2];
    const char* cA = (const char*)g.A + (size_t)cur.pm * tstepA + (size_t)cur.aoff * 2; const char* cB = (const char*)g.Bt + (size_t)cur.pn * tstepB;
    PG8_STAGE(PG8_SB(0, 0), cB, voffB); PG8_STAGE(PG8_SB(0, 1), cB + hstepB, voffB); PG8_STAGE(PG8_SA(0, 0), cA, voffA); PG8_STAGE(PG8_SA(0, 1), cA + hstepA, voffA);
    if (wr == 1) PG8_BAR;
    PG8_WAIT_V(2); PG8_BAR;
    PG8_STAGE(PG8_SB(1, 0), cB + kstep, voffB); PG8_STAGE(PG8_SA(1, 0), cA + kstep, voffA); PG8_STAGE(PG8_SB(1, 1), cB + hstepB + kstep, voffB);
    PG8_WAIT_V(6); PG8_BAR;
    for (;;) {
        const bool has_next = S.next(ui + 1, nxt);
        const char* nA = has_next ? (const char*)g.A + (size_t)nxt.pm * tstepA + (size_t)nxt.aoff * 2 : cA; const char* nB = has_next ? (const char*)g.Bt + (size_t)nxt.pn * tstepB : cB;
        for (int t = 0; t < nt; t += 2) {
            const bool last = (t == nt - 2);
            const char* a1 = cA + (size_t)(t + 1) * kstep;
            const char* a2 = last ? nA : cA + (size_t)(t + 2) * kstep; const char* b2 = last ? nB : cB + (size_t)(t + 2) * kstep;
            const char* a3 = a2 + kstep; const char* b3 = b2 + kstep;
            PG8_LDB(B0, 0, 0); PG8_LDB(B1, 0, 1); PG8_SCHED; PG8_LDA(At, 0, 0); PG8_STAGE(PG8_SA(1, 1), a1 + hstepA, voffA);
            PG8_WAIT_V(8); PG8_WAIT_L(0); PG8_BAR; PG8_MMA(0, 0, At, B0); PG8_MMA(0, 1, At, B1); PG8_BAR; PG8_SCHED;
            PG8_LDA(At, 0, 1); PG8_STAGE(PG8_SB(0, 0), b2, voffB); PG8_STAGE(PG8_SB(0, 1), b2 + hstepB, voffB); PG8_STAGE(PG8_SA(0, 0), a2, voffA);
            PG8_WAIT_V(8); PG8_WAIT_L(0); PG8_BAR; PG8_MMA(1, 0, At, B0); PG8_MMA(1, 1, At, B1); PG8_BAR; PG8_SCHED;
            PG8_LDB(B0, 1, 0); PG8_LDB(B1, 1, 1); PG8_SCHED; PG8_LDA(At, 1, 0); PG8_STAGE(PG8_SA(0, 1), a2 + hstepA, voffA);
            PG8_WAIT_V(8); PG8_WAIT_L(0); PG8_BAR; PG8_MMA(0, 0, At, B0); PG8_MMA(0, 1, At, B1); PG8_BAR; PG8_SCHED;
            PG8_LDA(At, 1, 1); PG8_STAGE(PG8_SB(1, 0), b3, voffB); PG8_STAGE(PG8_SB(1, 1), b3 + hstepB, voffB); PG8_STAGE(PG8_SA(1, 0), a3, voffA);
            PG8_WAIT_V(8); PG8_WAIT_L(0); PG8_BAR; PG8_MMA(1, 0, At, B0); PG8_MMA(1, 1, At, B1); PG8_BAR; PG8_SCHED;
        }
        if (wr == 0) PG8_BAR;
        E(acc, cur, wr, wc, fr, fq);
        if (!has_next) break;
        if (E.zero_after(cur))
#pragma unroll
        for (int a = 0; a < 2; ++a)
#pragma unroll
            for (int b = 0; b < 2; ++b)
#pragma unroll
                for (int m = 0; m < 4; ++m)
#pragma unroll
                    for (int n = 0; n < 2; ++n) acc[a][b][m][n] = (f32x4){0.f, 0.f, 0.f, 0.f};
        cur = nxt; cA = nA; cB = nB; ++ui;
        if (wr == 1) PG8_BAR;
    }
    PG8_WAIT_V(0);
    PG8_BAR;
#undef PG8_SA
#undef PG8_SB
#undef PG8_STAGE
#undef PG8_LDA
#undef PG8_LDB
#undef PG8_MMA
#undef PG8_WAIT_V
#undef PG8_WAIT_L
#undef PG8_BAR
#undef PG8_SCHED
}
}

__device__ __forceinline__ void glds16(const void* gsrc, unsigned lds_dst) { unsigned keep;
    asm volatile("s_mov_b32 %0, m0\n\ts_mov_b32 m0, %2\n\ts_nop 0\n\tglobal_load_lds_dwordx4 %1, off\n\ts_mov_b32 m0, %0" : "=&s"(keep) : "v"(gsrc), "s"(lds_dst) : "memory"); }
constexpr int ATT_LDS = 65536;
template <bool NOSHIFT> __device__ __forceinline__ void diff_attn_unit(LAS unsigned char* lds, bf16_t* proj, const bf16_t* VT, int b, int h, int qb, const AttnConsts ac, const float* gsub, const int tid, bf16_t* obuf, int opitch, int ocol) {
    const int lane = tid & 63, wid = __builtin_amdgcn_readfirstlane(tid >> 6), wq = wid & 3, c = wid >> 2, i32 = lane & 31, hi = lane >> 5;
    const size_t rowbase = (size_t)b * SEQ; const int q0 = qb * 128, qrow = q0 + 32 * wq + i32;
    bf16x8 qf[4];
    { const bf16_t* qp = proj + (rowbase + qrow) * NP + C_DQ + h * 128 + c * 64 + hi * 8;
#pragma unroll
      for (int ks = 0; ks < 4; ++ks) qf[ks] = *(const bf16x8*)(qp + 16 * ks); }
    const unsigned lds0 = (unsigned)(uintptr_t)lds;
    const int krow_s = 4 * wid + (lane >> 4), vd_s = 8 * wid + (lane >> 3);
    const bf16_t* kg = proj + (rowbase + krow_s) * NP + C_DK + h * 128 + (((lane & 15) ^ (krow_s & 15)) * 8);
    const bf16_t* vg = VT + (size_t)(h * 128 + vd_s) * TOK + rowbase + (((lane & 7) ^ ((vd_s >> 1) & 7)) * 8);
    const unsigned kdst = lds0 + wid * 1024, vdst = lds0 + 65536 + wid * 1024;
#define ATT_ISSUE(tt) do { const unsigned so_ = ((tt) & 3) * 16384; const bf16_t* kp_ = kg + (size_t)(tt) * 64 * NP; const bf16_t* vp_ = vg + (size_t)(tt) * 64; \
        glds16(kp_, (unsigned)__builtin_amdgcn_readfirstlane(kdst + so_)); glds16(kp_ + (size_t)32 * NP, (unsigned)__builtin_amdgcn_readfirstlane(kdst + so_ + 8192)); \
        glds16(vp_, (unsigned)__builtin_amdgcn_readfirstlane(vdst + so_)); glds16(vp_ + (size_t)64 * TOK, (unsigned)__builtin_amdgcn_readfirstlane(vdst + so_ + 8192)); } while (0)
#define ATT_WAITBAR(N) asm volatile("s_waitcnt vmcnt(" #N ") lgkmcnt(0)\n\ts_barrier" ::: "memory")
    const int krow = pi32(i32);
    int koff[2][4];
#pragma unroll
    for (int mt = 0; mt < 2; ++mt)
#pragma unroll
        for (int ks = 0; ks < 4; ++ks) { const int r = 32 * mt + krow; koff[mt][ks] = r * 256 + (((8 * c + 2 * ks + hi) ^ (r & 15)) * 16); }
    const int NT = 2 * qb + 2;
    f32x16 o[4];
#pragma unroll
    for (int dt = 0; dt < 4; ++dt)
#pragma unroll
        for (int r = 0; r < 16; ++r) o[dt][r] = 0.f;
    float l = 0.f;
    bf16x8 pf[4];
#pragma unroll
    for (int kk = 0; kk < 4; ++kk) pf[kk] = (bf16x8){0, 0, 0, 0, 0, 0, 0, 0};
    const int qmax = q0 + 32 * wq + 31;
#define ATT_LDV(dst, slot, kk) do { _Pragma("unroll") for (int dt = 0; dt < 4; ++dt) { const int d = 32 * dt + i32; \
        dst[dt] = *(const LAS bf16x8*)(lds + 65536 + (slot) + d * 128 + (((2 * (kk) + hi) ^ ((d >> 1) & 7)) * 16)); } } while (0)
#define ATT_MMV(src, kk) do { __builtin_amdgcn_s_setprio(1); _Pragma("unroll") for (int dt = 0; dt < 4; ++dt) o[dt] = __builtin_amdgcn_mfma_f32_32x32x16_bf16(src[dt], pf[kk], o[dt], 0, 0, 0); __builtin_amdgcn_s_setprio(0); } while (0)
#define ATT_SB __builtin_amdgcn_sched_barrier(0)
#define ATT_PV(slot) do { bf16x8 va[4], vb[4]; ATT_LDV(va, slot, 0); ATT_SB; ATT_LDV(vb, slot, 1); ATT_SB; ATT_MMV(va, 0); ATT_SB; ATT_LDV(va, slot, 2); ATT_SB; ATT_MMV(vb, 1); ATT_SB; \
        ATT_LDV(vb, slot, 3); ATT_SB; ATT_MMV(va, 2); ATT_SB; ATT_MMV(vb, 3); ATT_SB; } while (0)
    ATT_ISSUE(0); ATT_ISSUE(1);
    ATT_WAITBAR(4);
    for (int t = 0; t < NT; ++t) {
        const int bo = (t & 3) * 16384, sl_cur = bo, sl_prev = ((t - 1) & 3) * 16384;
        if (t + 2 < NT) ATT_ISSUE(t + 2);
        const int kv0 = 64 * t;
        if (c == 1 && t >= 1 && kv0 - 64 <= qmax) ATT_PV(sl_prev);
        if (kv0 <= qmax) {
            f32x16 p[2];
            bf16x8 kf[2][4];
#pragma unroll
            for (int mt = 0; mt < 2; ++mt)
#pragma unroll
                for (int ks = 0; ks < 4; ++ks) kf[mt][ks] = *(const LAS bf16x8*)(lds + bo + koff[mt][ks]);
            if constexpr (!NOSHIFT) {
#pragma unroll
                for (int mt = 0; mt < 2; ++mt)
#pragma unroll
                    for (int r = 0; r < 16; ++r) p[mt][r] = -ac.Mfix;
            }
            ATT_SB;
            __builtin_amdgcn_s_setprio(1);
#pragma unroll
            for (int ks = 0; ks < 4; ++ks)
#pragma unroll
                for (int mt = 0; mt < 2; ++mt) {
                    if (NOSHIFT && ks == 0) { const f32x16 z = {0.f, 0.f, 0.f, 0.f, 0.f, 0.f, 0.f, 0.f, 0.f, 0.f, 0.f, 0.f, 0.f, 0.f, 0.f, 0.f}; p[mt] = __builtin_amdgcn_mfma_f32_32x32x16_bf16(kf[mt][ks], qf[ks], z, 0, 0, 0); }
                    else p[mt] = __builtin_amdgcn_mfma_f32_32x32x16_bf16(kf[mt][ks], qf[ks], p[mt], 0, 0, 0);
                }
            __builtin_amdgcn_s_setprio(0);
            ATT_SB;
            const bool diag = (t >= 2 * qb);
            if (diag) {
                const int qrel = qrow - kv0 - 8 * hi;
#pragma unroll
                for (int mt = 0; mt < 2; ++mt)
#pragma unroll
                    for (int r = 0; r < 16; ++r) { float v = __builtin_amdgcn_exp2f(p[mt][r]); if (32 * mt + 16 * (r >> 3) + (r & 7) > qrel) v = 0.f; p[mt][r] = v; l += v; }
            } else {
#pragma unroll
                for (int mt = 0; mt < 2; ++mt)
#pragma unroll
                    for (int r = 0; r < 16; ++r) { const float v = __builtin_amdgcn_exp2f(p[mt][r]); p[mt][r] = v; l += v; }
            }
            asm volatile("" ::: "memory");
#pragma unroll
            for (int kk = 0; kk < 4; ++kk) { const int mt = kk >> 1, r0 = 8 * (kk & 1); u32x4 w;
                w.x = pk2(p[mt][r0], p[mt][r0 + 1]); w.y = pk2(p[mt][r0 + 2], p[mt][r0 + 3]); w.z = pk2(p[mt][r0 + 4], p[mt][r0 + 5]); w.w = pk2(p[mt][r0 + 6], p[mt][r0 + 7]);
                pf[kk] = __builtin_bit_cast(bf16x8, w); }
            if (c == 0) ATT_PV(sl_cur);
        }
        if (t + 2 < NT) ATT_WAITBAR(4); else ATT_WAITBAR(0);
    }
    if (c == 1 && 64 * (NT - 1) <= qmax) ATT_PV(((NT - 1) & 3) * 16384);
#undef ATT_ISSUE
#undef ATT_WAITBAR
#undef ATT_PV
#undef ATT_LDV
#undef ATT_MMV
#undef ATT_SB
    l = xor32_sum(l);
    const float inv = 1.f / l;
    LAS float* xch = (LAS float*)lds + (size_t)wq * 4096 + lane;
    if (c == 1) {
#pragma unroll
        for (int dt = 0; dt < 4; ++dt)
#pragma unroll
            for (int r = 0; r < 16; ++r) xch[(dt * 16 + r) * 64] = o[dt][r] * inv;
    }
    __syncthreads();
    if (c == 0) {
        float ss = 0.f;
#pragma unroll
        for (int dt = 0; dt < 4; ++dt)
#pragma unroll
            for (int r = 0; r < 16; ++r) { const float v = o[dt][r] * inv - ac.lam * xch[(dt * 16 + r) * 64]; o[dt][r] = v; ss += v * v; }
        ss = xor32_sum(ss);
        const float rs = rs_of(ss, 1.f / 128) * ac.osc;
        bf16_t* op = obuf + (rowbase + qrow) * opitch + ocol + h * 128;
#pragma unroll
        for (int dt = 0; dt < 4; ++dt)
#pragma unroll
            for (int rg = 0; rg < 4; ++rg) { const int d = 32 * dt + 8 * rg + 4 * hi; const f32x4 g = *(const f32x4*)(gsub + d);
                u32x2 w; w.x = pk2(o[dt][4 * rg] * rs * g.x, o[dt][4 * rg + 1] * rs * g.y); w.y = pk2(o[dt][4 * rg + 2] * rs * g.z, o[dt][4 * rg + 3] * rs * g.w);
                *(u32x2*)(op + d) = w; }
    }
    __syncthreads();
}

__device__ __forceinline__ int maprow(int mode, int n) {
    if (mode == 1) { if (n < 5120) return n; if (n < 6144) return 12288 + (n - 5120); if (n < 7168) return 5120 + (n - 6144); return 6144 + (n - 7168); }
    if (mode == 2) { if (n < DFF) return (n >> 7) * 256 + (n & 127); const int m = n - DFF; return (m >> 7) * 256 + 128 + (m & 127); }
    return n;
}
__device__ __forceinline__ void conv_item(const float* W, int K, int N, bf16_t* Wt, const float* g, int mode, int item, int lane) {
    const int nkc = K >> 7, nb = item / nkc, kc = item - nb * nkc, n0 = nb * 64, k0 = kc * 128, kgp = lane >> 4, nq = lane & 15;
    const int drow = maprow(mode, n0) + 4 * nq;
#pragma unroll 2
    for (int it = 0; it < 4; ++it) {
        const int kb = k0 + it * 32 + kgp * 8;
        f32x4 v[8];
#pragma unroll
        for (int j = 0; j < 8; ++j) v[j] = *(const f32x4*)(W + (size_t)(kb + j) * N + n0 + 4 * nq);
        if (g) {
            const f32x4 g0 = *(const f32x4*)(g + kb), g1 = *(const f32x4*)(g + kb + 4);
#pragma unroll
            for (int j = 0; j < 4; ++j) { v[j] *= g0[j]; v[4 + j] *= g1[j]; }
        }
#pragma unroll
        for (int i = 0; i < 4; ++i) {
            u32x4 o; o.x = pk2(v[0][i], v[1][i]); o.y = pk2(v[2][i], v[3][i]); o.z = pk2(v[4][i], v[5][i]); o.w = pk2(v[6][i], v[7][i]);
            *(u32x4*)(Wt + (size_t)(drow + i) * K + kb) = o;
        }
    }
}
__device__ __forceinline__ void row_to_bf16(const float* xr, bf16_t* orow, float* ssout, int lane) {
    float s = 0.f;
#pragma unroll
    for (int j = 0; j < 8; ++j) { const f32x4 v = *(const f32x4*)(xr + 4 * lane + 256 * j); s += sum4(v * v);
        u32x2 w; w.x = pk2(v.x, v.y); w.y = pk2(v.z, v.w); *(u32x2*)(orow + 4 * lane + 256 * j) = w; }
    s = wave_sum(s);
    if (lane == 0) *ssout = s;
}

#define XB_TMO      128
#define XB_XCNT(j)  (256  + 64 * (j))
#define XB_XSUB(j)  (1280 + 64 * (j))
#define XB_XGEN(j)  (2304 + 64 * (j))
#define XB_TOP      3328
#define XB_TOPGEN   3392
#define XCD_BAR_WORDS 3456
#define XB_SPIN_CAP (1u << 18)
__device__ __forceinline__ unsigned xb_ld(unsigned* p)              { return __hip_atomic_load(p, __ATOMIC_RELAXED, __HIP_MEMORY_SCOPE_AGENT); }
__device__ __forceinline__ unsigned xb_add(unsigned* p, unsigned v) { return __hip_atomic_fetch_add(p, v, __ATOMIC_RELAXED, __HIP_MEMORY_SCOPE_AGENT); }
__device__ __forceinline__ unsigned xb_xcc_id() { return (unsigned)__builtin_amdgcn_s_getreg((3 << 11) | 20) & 0xFu; }
#define XB_SPIN(cond, bar) do { unsigned _sp = 0; while (cond) { __builtin_amdgcn_s_sleep(1); \
    if ((++_sp & 255u) == 0u) { if (xb_ld(&(bar)[XB_TMO])) break; if (_sp > XB_SPIN_CAP) { atomicAdd(&(bar)[XB_TMO], 1u); break; } } } } while (0)
struct XcdBarrier { unsigned* bar; unsigned x; volatile LAS unsigned* st; };
__device__ __forceinline__ XcdBarrier xcd_barrier_post(unsigned* bar, volatile LAS unsigned* st) {
    XcdBarrier b; b.bar = bar; b.x = xb_xcc_id(); b.st = st;
    if (threadIdx.x == 0) (void)xb_add(&bar[XB_XCNT(b.x)], 1u);
    return b;
}
__device__ __forceinline__ void xcd_barrier_complete(unsigned* bar, unsigned x, unsigned& nloc, unsigned& nx) {
    const unsigned G = gridDim.x * gridDim.y * gridDim.z;
    unsigned sum, cnt, mine, sp = 0u;
    for (;;) {
        sum = 0u; cnt = 0u; mine = 0u;
#pragma unroll
        for (unsigned j = 0; j < 16; ++j) { const unsigned c = xb_ld(&bar[XB_XCNT(j)]); sum += c; cnt += (c > 0u) ? 1u : 0u; mine = (j == x) ? c : mine; }
        if (sum == G) break;
        __builtin_amdgcn_s_sleep(1);
        if ((++sp & 255u) == 0u) { if (xb_ld(&bar[XB_TMO])) break; if (sp > XB_SPIN_CAP) { atomicAdd(&bar[XB_TMO], 1u); break; } }
    }
    nloc = mine > 0u ? mine : 1u; nx = cnt > 0u ? cnt : 1u;
}
__device__ __forceinline__ void xcd_barrier(const XcdBarrier& b) {
    asm volatile("s_waitcnt vmcnt(0)" ::: "memory");
    __syncthreads();
    if (threadIdx.x == 0) {
        unsigned* bar = b.bar;
        __builtin_amdgcn_s_waitcnt(0);
        unsigned nloc = b.st[0], nx = b.st[1];
        if (nloc == 0u) { xcd_barrier_complete(bar, b.x, nloc, nx); b.st[0] = nloc; b.st[1] = nx; }
        const unsigned old = xb_add(&bar[XB_XSUB(b.x)], 1u);
        const unsigned gen = old / nloc;
        if (old + 1u == (gen + 1u) * nloc) {
            __builtin_amdgcn_fence(__ATOMIC_RELEASE, "agent");
            asm volatile("s_waitcnt vmcnt(0)" ::: "memory");
            const unsigned og = xb_add(&bar[XB_TOP], 1u);
            const unsigned tg = og / nx;
            if (og + 1u == (tg + 1u) * nx) xb_add(&bar[XB_TOPGEN], 1u);
            else XB_SPIN(xb_ld(&bar[XB_TOPGEN]) == tg, bar);
            __builtin_amdgcn_fence(__ATOMIC_ACQUIRE, "agent");
            xb_add(&bar[XB_XGEN(b.x)], 1u);
            asm volatile("s_waitcnt vmcnt(0)" ::: "memory");
        } else {
            XB_SPIN(xb_ld(&bar[XB_XGEN(b.x)]) == gen, bar);
            __builtin_amdgcn_fence(__ATOMIC_ACQUIRE, "agent");
            asm volatile("s_waitcnt vmcnt(0)" ::: "memory");
        }
    }
    __syncthreads();
}

struct Args { const void* in[21]; float* out; unsigned char* ws; int lo, hi, flags, pad; };
constexpr int NPHASE = 16;
constexpr int FL_SKIP_MEMKV = 1, FL_SKIP_ATTN = 2, FL_SKIP_CROSS = 4, FL_SKIP_MAIN = 8, FL_XCDBAR = 16;
constexpr int LDS_BYTES = pg8::STAGE_BYTES + 2048;
constexpr size_t WS_BAR = 1400 * KiB, WS_BAR_BYTES = 16 * KiB;

__global__ void __launch_bounds__(512, 2) mega(Args args) {
    extern __shared__ __attribute__((aligned(16))) unsigned char lds_raw[];
    LAS unsigned char* lds = (LAS unsigned char*)lds_raw;
    cg::grid_group grid = cg::this_grid();
    constexpr int G = 256;
    const int wave0 = __builtin_amdgcn_readfirstlane(threadIdx.x >> 6);
    volatile LAS unsigned* bst = (volatile LAS unsigned*)(lds + pg8::STAGE_BYTES + 1024);
    if (threadIdx.x < 2) bst[threadIdx.x] = 0u;
    __syncthreads();
    XcdBarrier xbar; xbar.bar = (unsigned*)(args.ws + WS_BAR); xbar.x = 0; xbar.st = bst;
    if (args.flags & FL_XCDBAR) xbar = xcd_barrier_post((unsigned*)(args.ws + WS_BAR), bst);
    for (int ph = args.lo; ph < args.hi; ++ph) {
        int bx_ = blockIdx.x; asm volatile("" : "+s"(bx_)); const int bx = bx_, vcu = (bx % 8) * (G / 8) + bx / 8;
        unsigned char* ws = args.ws; asm volatile("" : "+s"(ws));
        constexpr int NGW = G * 8;
        const float* x_in = (const float*)args.in[0]; const float* mem = (const float*)args.in[1]; const int* positions = (const int*)args.in[2];
        float* xcur = args.out;
        float* ssb = (float*)(ws + WS_SS); float* qssb = (float*)(ws + WS_QSS); float* lsumb = (float*)(ws + WS_LSUM); float* kssb = (float*)(ws + WS_KSS); float* ssmem = (float*)(ws + WS_SSMEM);
        float* cs = (float*)(ws + WS_CS); float* xsh = (float*)(ws + WS_XSH);
        bf16_t* memb = (bf16_t*)(ws + WS_MEMB); bf16_t* mkraw = (bf16_t*)(ws + WS_MKRAW); bf16_t* mvT = (bf16_t*)(ws + WS_MVT);
        bf16_t* Win_t = (bf16_t*)(ws + WS_WIN); bf16_t* Wc_t = (bf16_t*)(ws + WS_WC); bf16_t* Wd_t = (bf16_t*)(ws + WS_WD); bf16_t* Wx_t = (bf16_t*)(ws + WS_WX);
        bf16_t* Wmkv_t = (bf16_t*)(ws + WS_WMKV); bf16_t* Wo_t = (bf16_t*)(ws + WS_WO); bf16_t* Wgu_t = (bf16_t*)(ws + WS_WGU); bf16_t* Wdn_t = (bf16_t*)(ws + WS_WDN);
        bf16_t* proj = (bf16_t*)(ws + WS_PROJ); bf16_t* VT = (bf16_t*)(ws + WS_VT); bf16_t* xb = (bf16_t*)(ws + WS_XB); bf16_t* mg = (bf16_t*)(ws + WS_MG); bf16_t* hb = (bf16_t*)(ws + WS_H);

        const int l = ph >> 3, p = ph & 7;
        const int wave = wave0, gw = vcu * 8 + wave;
#define PHASE_TID() const int tid = phase_tid(wave0), lane = tid & 63
        const float* gq_x = (const float*)args.in[14] + l * 256; const float* gk_x = (const float*)args.in[15] + l * 256;
        float* qss = qssb + (size_t)l * TOK * 4; float* lsum = lsumb + (size_t)l * TOK * 4; float* kss = kssb + l * 2048;
        if (p == 0) {
            PHASE_TID();
            const float* g_mix = (const float*)args.in[3] + l * DM; const float* g_mem = (const float*)args.in[12] + l * DM; const float* g_ffn = (const float*)args.in[18] + l * DM;
            const float* w_in = (const float*)args.in[4] + (size_t)l * DM * NIN; const float* w_co = (const float*)args.in[6] + (size_t)l * 1024 * DM;
            const float* w_do = (const float*)args.in[11] + (size_t)l * 1024 * DM; const float* w_mkv = (const float*)args.in[13] + (size_t)l * DM * 2048;
            const float* w_xo = (const float*)args.in[16] + (size_t)l * 1024 * DM; const float* w_o = (const float*)args.in[17] + (size_t)l * DM * DM;
            const float* w_gu = (const float*)args.in[19] + (size_t)l * DM * 2 * DFF; const float* w_dn = (const float*)args.in[20] + (size_t)l * DFF * DM;
            constexpr int I_IN = (NIN / 64) * (DM / 128), I_B = (DM / 64) * (1024 / 128), I_SQ = (DM / 64) * (DM / 128), I_GU = (2 * DFF / 64) * (DM / 128), I_DN = (DM / 64) * (DFF / 128);
            constexpr int NIT = I_IN + 3 * I_B + 2 * I_SQ + I_GU + I_DN;
#pragma unroll 1
            for (int rep = 0; rep < REP_P0; ++rep)
            for (int it = gw; it < NIT; it += NGW) {
                int r = it;
                if (r < I_IN) { conv_item(w_in, DM, NIN, Win_t, g_mix, 1, r, lane); continue; } r -= I_IN;
                if (r < I_GU) { conv_item(w_gu, DM, 2 * DFF, Wgu_t, g_ffn, 2, r, lane); continue; } r -= I_GU;
                if (r < I_DN) { conv_item(w_dn, DFF, DM, Wdn_t, nullptr, 0, r, lane); continue; } r -= I_DN;
                if (r < I_SQ) { conv_item(w_mkv, DM, 2048, Wmkv_t, g_mem, 0, r, lane); continue; } r -= I_SQ;
                if (r < I_SQ) { conv_item(w_o, DM, DM, Wo_t, nullptr, 0, r, lane); continue; } r -= I_SQ;
                if (r < I_B) { conv_item(w_co, 1024, DM, Wc_t, nullptr, 0, r, lane); continue; } r -= I_B;
                if (r < I_B) { conv_item(w_do, 1024, DM, Wd_t, nullptr, 0, r, lane); continue; } r -= I_B;
                conv_item(w_xo, 1024, DM, Wx_t, nullptr, 0, r, lane);
            }
            if (l == 0) {
                for (int m = gw; m < TOK; m += NGW) row_to_bf16(x_in + (size_t)m * DM, xb + (size_t)m * DM, ssb + m, lane);
                for (int m = gw; m < BATCH * MEMLEN; m += NGW) row_to_bf16(mem + (size_t)m * DM, memb + (size_t)m * DM, ssmem + m, lane);
                { unsigned* z = (unsigned*)(ws + WS_ZERO_LO); const int nz = (int)((WS_ZERO_HI - WS_ZERO_LO) / 4);
                  for (int i = bx * 512 + tid; i < nz; i += G * 512) z[i] = 0u; }
                for (int i = bx * 512 + tid; i < TOK * 8; i += G * 512) {
                    const int row = i >> 3, k = i & 7;
                    const float ang = (float)positions[row] * INVF[k];
                    const float kk = rintf(ang * 0.15915494309189535f);
                    float rr = fmaf(-kk, 6.2831854820251465f, ang); rr = fmaf(-kk, -1.7484556000744883e-07f, rr);
                    const float fr = rr * 0.15915494309189535f;
                    cs[row * 16 + k] = __builtin_amdgcn_cosf(fr); cs[row * 16 + 8 + k] = __builtin_amdgcn_sinf(fr);
                }
            }
        } else if (p == 1) {
            PHASE_TID();
            if (PH_EN(1) && !(args.flags & FL_SKIP_MAIN)) {
#pragma unroll 1
                for (int rep = 0; rep < REP_P1; ++rep)
                { pg8::Gemm g{xb, Win_t, TOK, NP, DM, DM, DM}; pg8::StaticOrder S; S.init(TOK, NP, G, bx);
                  pg8::EpiWrap<EIn> E{EIn{proj, ssb + (size_t)(2 * l) * TOK, gq_x, gk_x, rep == REP_P1 - 1 ? qss : nullptr}}; pg8::gemm_phase(lds, g, S, E, phase_tid(wave0)); }
                { pg8::Gemm g{Win_t + (size_t)NP * DM, xb, 1024, TOK, DM, DM, DM}; pg8::StaticOrder S; S.init(1024, TOK, G, bx);
                  pg8::EpiWrap<EColScale> E{EColScale{VT, ssb + (size_t)(2 * l) * TOK, TOK, 0}}; pg8::gemm_phase(lds, g, S, E, phase_tid(wave0)); }
            }
        } else if (p == 2) {
            PHASE_TID();
            const bool do_mkv = !(args.flags & FL_SKIP_MEMKV) && G >= 32;
            if (bx == G - 1 && wave == 0) { const float mx = xattn_shift(gq_x, gk_x, lane); if (lane == 0) xsh[l] = mx; }
#pragma unroll 1
            for (int rep2 = 0; rep2 < REP_P2; ++rep2) { const bool real2 = rep2 == REP_P2 - 1;
            if (PH_EN(2) && do_mkv && bx < 16) {
                if (bx < 8) { pg8::Gemm g{memb, Wmkv_t, 512, 1024, DM, DM, DM}; pg8::StaticOrder S; S.init(512, 1024, 8, bx);
                    pg8::EpiWrap<EMemK> E{EMemK{mkraw, ssmem, real2 ? kss : nullptr}}; pg8::gemm_phase(lds, g, S, E, phase_tid(wave0)); }
                else { pg8::Gemm g{Wmkv_t + (size_t)1024 * DM, memb, 1024, 512, DM, DM, DM}; pg8::StaticOrder S; S.init(1024, 512, 8, bx - 8);
                    pg8::EpiWrap<EColScale> E{EColScale{mvT, ssmem, 512, 0}}; pg8::gemm_phase(lds, g, S, E, phase_tid(wave0)); }
            } else {
                const int nb0 = do_mkv ? 16 : 0, NW2 = (G - nb0) * 8, gw2 = (bx - nb0) * 8 + wave;
                const float* gqd = (const float*)args.in[7] + l * 64; const float* gkd = (const float*)args.in[8] + l * 64; const float* cw = (const float*)args.in[5] + l * 3 * 1024;
#pragma unroll 1
                for (int base = gw2; base < 2 * TOK; base += 4 * NW2) {
                    u32x4 wv[4][2];
#pragma unroll
                    for (int j4 = 0; j4 < 4; ++j4) { const int tk = min(base + j4 * NW2, 2 * TOK - 1);
                        const bf16_t* pp = proj + (size_t)(tk >> 1) * NP + ((tk & 1) ? C_DK : C_DQ) + lane * 16; wv[j4][0] = *(const u32x4*)pp; wv[j4][1] = *(const u32x4*)(pp + 8); }
#pragma unroll
                    for (int j4 = 0; j4 < 4; ++j4) { const int tk = base + j4 * NW2;
                        if (tk < 2 * TOK) {
                            const int row = tk >> 1, which = tk & 1, j = lane & 3;
                            bf16_t* pp = proj + (size_t)row * NP + (which ? C_DK : C_DQ) + lane * 16;
                            f32x4 f0, f1, f2, f3; unpack8(wv[j4][0], f0, f1); unpack8(wv[j4][1], f2, f3);
                            float ss = sum4(f0 * f0) + sum4(f1 * f1) + sum4(f2 * f2) + sum4(f3 * f3);
                            ss += swz_xor<1>(ss); ss += swz_xor<2>(ss);
                            const float rs = rs_of(ss, 1.f / 64);
                            const float* gg = (which ? gkd : gqd) + 16 * j;
                            f0 *= *(const f32x4*)gg * rs; f1 *= *(const f32x4*)(gg + 4) * rs; f2 *= *(const f32x4*)(gg + 8) * rs; f3 *= *(const f32x4*)(gg + 12) * rs;
                            if (j == 0) {
                                const float* cr = cs + (size_t)row * 16;
                                const f32x4 c0 = *(const f32x4*)cr, c1 = *(const f32x4*)(cr + 4), s0 = *(const f32x4*)(cr + 8), s1 = *(const f32x4*)(cr + 12);
                                const f32x4 a0 = f0 * c0 - f2 * s0, a1 = f1 * c1 - f3 * s1, b0 = f2 * c0 + f0 * s0, b1 = f3 * c1 + f1 * s1;
                                f0 = a0; f1 = a1; f2 = b0; f3 = b1;
                            }
                            if (!which) { const float sc = 0.125f * LOG2E; f0 *= sc; f1 *= sc; f2 *= sc; f3 *= sc; }
                            bf16_t* po = real2 ? pp : mg + (size_t)row * DM + lane * 16; *(u32x4*)po = pack8(f0, f1); *(u32x4*)(po + 8) = pack8(f2, f3);
                        } }
                }
#pragma unroll 1
                for (int base = gw2; base < 2 * TOK; base += 2 * NW2) {
                    u32x4 vc[2][3], vx[2][3], vb[2];
#pragma unroll
                    for (int j2 = 0; j2 < 2; ++j2) { const int tk = min(base + j2 * NW2, 2 * TOK - 1);
                        const int id = tk * 64 + lane, row = id >> 7, ch = (id & 127) * 8, sq = row & (SEQ - 1); const bf16_t* pr = proj + (size_t)row * NP;
#pragma unroll
                        for (int jj = 0; jj < 3; ++jj) { const bf16_t* q = pr - (size_t)((sq - 2 + jj >= 0) ? (2 - jj) : 0) * NP; vc[j2][jj] = *(const u32x4*)(q + C_CC + ch); vx[j2][jj] = *(const u32x4*)(q + C_CX + ch); }
                        vb[j2] = *(const u32x4*)(pr + C_CB + ch); }
#pragma unroll
                    for (int j2 = 0; j2 < 2; ++j2) { const int tk = base + j2 * NW2;
                        if (tk < 2 * TOK) { const int id = tk * 64 + lane, row = id >> 7, ch = (id & 127) * 8, sq = row & (SEQ - 1);
                            f32x4 u0 = {0.f, 0.f, 0.f, 0.f}, u1 = u0;
#pragma unroll
                            for (int jj = 0; jj < 3; ++jj) {
                                if (sq - 2 + jj >= 0) { f32x4 a0, a1, b0, b1; unpack8(vc[j2][jj], a0, a1); unpack8(vx[j2][jj], b0, b1);
                                    u0 += *(const f32x4*)(cw + jj * 1024 + ch) * (a0 * b0); u1 += *(const f32x4*)(cw + jj * 1024 + ch + 4) * (a1 * b1); } }
                            f32x4 g0, g1; unpack8(vb[j2], g0, g1);
                            *(u32x4*)(real2 ? proj + (size_t)row * NP + C_CA + ch : mg + (size_t)row * DM + 1024 + ch) = pack8(g0 * u0, g1 * u1);
                        } }
                }
            }
            }
        } else if (p == 3) {
            PHASE_TID();
            if (PH_EN(3) && !(args.flags & FL_SKIP_ATTN)) {
                const AttnConsts ac = attn_consts((const float*)args.in[7] + l * 64, (const float*)args.in[8] + l * 64, (const float*)args.in[9] + l * 256, l, lane);
                const float* gsub = (const float*)args.in[10] + l * 128;
#pragma unroll 1
                for (int rep = 0; rep < REP_ATTN; ++rep) {
                    const bool real = (rep == REP_ATTN - 1);
                    const int v = vcu, bh = v >> 4, s = v & 15;
#pragma unroll 1
                    for (int i = 0; i < 4; ++i) { const int qb = (i == 0) ? 63 - s : (i == 1) ? 32 + s : (i == 2) ? 31 - s : s;
                        if (ac.Mfix <= 40.f) diff_attn_unit<true>(lds, proj, VT, bh >> 3, bh & 7, qb, ac, gsub, phase_tid(wave0), real ? proj : mg, real ? NP : DM, real ? C_OB : 0);
                        else diff_attn_unit<false>(lds, proj, VT, bh >> 3, bh & 7, qb, ac, gsub, phase_tid(wave0), real ? proj : mg, real ? NP : DM, real ? C_OB : 0); }
                }
            }
            if (PH_EN(8) && !(args.flags & FL_SKIP_CROSS)) {
#pragma unroll 1
                for (int repx = 0; repx < REP_X; ++repx) {
                    const int u = bx; const bool realx = repx == REP_X - 1;
                    const int b = u >> 7, h = (u >> 5) & 3, qb = u & 31;
                    { pg8::Gemm g{proj + C_XQ + h * 256, mkraw + (size_t)(b * 256) * 1024 + h * 256, TOK, 256, 256, NP, 1024};
                      LAS float* rkl = (LAS float*)(lds + pg8::STAGE_BYTES);
                      if (tid < 256) rkl[tid] = rs_of(kss[(b * 256 + tid) * 4 + h], 1.f / 256);
                      __syncthreads();
                      pg8::OneUnit S{{b * 32 + qb, 0, 0, 0}, true}; pg8::EpiWrap<EXs<true>> E{EXs<true>{proj, qss, kss, realx ? lsum : nullptr, xsh + l, (unsigned)(uintptr_t)rkl, b, h, LOG2E / 16.f}}; pg8::gemm_phase(lds, g, S, E, phase_tid(wave0)); }
                    __threadfence(); __syncthreads();
                    { pg8::Gemm g{proj + C_P + h * 256, mvT + (size_t)(h * 256) * 512 + b * 256, TOK, 256, 256, NP, 512};
                      pg8::OneUnit S{{b * 32 + qb, 0, 0, 0}, true}; pg8::EpiWrap<EXo> E{EXo{proj, lsum, h, 0}}; pg8::gemm_phase(lds, g, S, E, phase_tid(wave0)); }
                }
            }
        } else if (p == 4) {
            PHASE_TID();
            if (PH_EN(4) && !(args.flags & FL_SKIP_MAIN)) {
#pragma unroll 1
                for (int rep = 0; rep < REP_P4; ++rep) {
                    pg8::Gemm g{proj, Wc_t, TOK, DM, 1024, NP, 1024}; pg8::ChainOrder S; S.base.init(TOK, DM, G, bx);
                    pg8::EpiChain E{mg, proj}; pg8::gemm_phase(lds, g, S, E, phase_tid(wave0));
                }
            }
        } else if (p == 5) {
            PHASE_TID();
            if (PH_EN(5) && !(args.flags & FL_SKIP_MAIN)) {
#pragma unroll 1
                for (int rep = 0; rep < REP_P5; ++rep) { const bool real = rep == REP_P5 - 1;
                pg8::Gemm g{mg, Wo_t, TOK, DM, DM, DM, DM}; pg8::StaticOrder S; S.init(TOK, DM, G, bx);
                pg8::EpiWrap<ERes> E{ERes{l == 0 ? x_in : xcur, real ? xcur : (float*)(ws + WS_PROJ + 192 * MiB), real ? xb : (bf16_t*)(ws + WS_PROJ + 320 * MiB), real ? ssb + (size_t)(2 * l + 1) * TOK : nullptr}}; pg8::gemm_phase(lds, g, S, E, phase_tid(wave0)); }
            }
        } else if (p == 6) {
            PHASE_TID();
            if (PH_EN(6) && !(args.flags & FL_SKIP_MAIN)) {
#pragma unroll 1
                for (int rep = 0; rep < REP_GU; ++rep) {
                pg8::Gemm g{xb, Wgu_t, TOK, 2 * DFF, DM, DM, DM}; pg8::StaticOrder S; S.init(TOK, 2 * DFF, G, bx);
                pg8::EpiWrap<EGU> E{EGU{hb, ssb + (size_t)(2 * l + 1) * TOK}}; pg8::gemm_phase(lds, g, S, E, phase_tid(wave0)); }
            }
        } else {
            PHASE_TID();
            if (PH_EN(7) && !(args.flags & FL_SKIP_MAIN)) {
#pragma unroll 1
                for (int rep = 0; rep < REP_P7; ++rep) { const bool real = rep == REP_P7 - 1;
                pg8::Gemm g{hb, Wdn_t, TOK, DM, DFF, DFF, DFF}; pg8::StaticOrder S; S.init(TOK, DM, G, bx);
                pg8::EpiWrap<ERes> E{ERes{xcur, real ? xcur : (float*)(ws + WS_PROJ + 192 * MiB), real ? xb : (bf16_t*)(ws + WS_PROJ + 320 * MiB), (real && l == 0) ? ssb + (size_t)2 * TOK : nullptr}}; pg8::gemm_phase(lds, g, S, E, phase_tid(wave0)); }
            }
        }
        if (ph + 1 < args.hi) { if (!(args.flags & FL_XCDBAR) || ph == args.lo) grid.sync(); else xcd_barrier(xbar); }
    }
}

template <class E> static void launch_naive(const bf16_t* A, int lda, const bf16_t* Bt, int ldb, int M, int N, int K, E e, hipStream_t st) {
    const size_t n = (size_t)(M / 32) * (E::PAIRED ? (N / 256) * 4 : N / 32);
    hipLaunchKernelGGL(naive_gemm<E>, dim3((unsigned)((n + 3) / 4)), dim3(256), 0, st, A, Bt, e, lda, ldb, M, N, K, 0);
}

extern "C" void kernel_launch(void* const* d_in, const int* in_sizes, int n_in, void* d_out, int out_size, void* d_ws, size_t ws_size, hipStream_t stream) {
    static int grid = 0;
    if (grid == 0) {
        if (n_in != 21 || out_size != TOK * DM || ws_size < WS_END) { fprintf(stderr, "kernel_launch: unexpected shapes / workspace (%d inputs, out %d, ws %zu < %zu)\n", n_in, out_size, ws_size, (size_t)WS_END); grid = -1; return; }
        int dev = 0, cus = 0, per_cu = 0;
        hipGetDevice(&dev); hipDeviceGetAttribute(&cus, hipDeviceAttributeMultiprocessorCount, dev);
        hipFuncSetAttribute((const void*)mega, hipFuncAttributeMaxDynamicSharedMemorySize, LDS_BYTES);
        hipOccupancyMaxActiveBlocksPerMultiprocessor(&per_cu, (const void*)mega, 512, LDS_BYTES);
        if (per_cu < 1) per_cu = 1;
        grid = cus * per_cu; if (grid > 256) grid = 256;
        if (grid != 256) { fprintf(stderr, "kernel_launch: needs 256 co-resident workgroups, got %d\n", grid); grid = -1; return; }
        (void)hipGetLastError();
    }
    if (grid < 0) return;
    unsigned char* ws = (unsigned char*)d_ws;
    Args a{};
    for (int i = 0; i < 21; ++i) a.in[i] = d_in[i];
    a.out = (float*)d_out; a.ws = ws;
    float* ssb = (float*)(ws + WS_SS); float* qssb = (float*)(ws + WS_QSS); float* lsumb = (float*)(ws + WS_LSUM); float* kssb = (float*)(ws + WS_KSS); float* ssmem = (float*)(ws + WS_SSMEM);
    bf16_t* memb = (bf16_t*)(ws + WS_MEMB); bf16_t* mkraw = (bf16_t*)(ws + WS_MKRAW); bf16_t* mvT = (bf16_t*)(ws + WS_MVT);
    bf16_t* Win_t = (bf16_t*)(ws + WS_WIN); bf16_t* Wc_t = (bf16_t*)(ws + WS_WC); bf16_t* Wd_t = (bf16_t*)(ws + WS_WD); bf16_t* Wx_t = (bf16_t*)(ws + WS_WX);
    bf16_t* Wmkv_t = (bf16_t*)(ws + WS_WMKV); bf16_t* Wo_t = (bf16_t*)(ws + WS_WO); bf16_t* Wgu_t = (bf16_t*)(ws + WS_WGU); bf16_t* Wdn_t = (bf16_t*)(ws + WS_WDN);
    bf16_t* proj = (bf16_t*)(ws + WS_PROJ); bf16_t* VT = (bf16_t*)(ws + WS_VT); bf16_t* xb = (bf16_t*)(ws + WS_XB); bf16_t* mg = (bf16_t*)(ws + WS_MG); bf16_t* hb = (bf16_t*)(ws + WS_H);
    const float* x_in = (const float*)d_in[0]; float* xcur = (float*)d_out;

    static Args store[NPHASE + 1]; int nco = 0;
    auto coop = [&](int lo, int hi, int flags) {
        a.lo = lo; a.hi = hi; a.flags = flags; store[nco] = a;
        void* kargs[] = {&store[nco]}; ++nco;
        hipError_t e = hipSuccess;
        if (hi - lo == 1) hipLaunchKernelGGL(mega, dim3(grid), dim3(512), LDS_BYTES, stream, store[nco - 1]);
        else e = hipLaunchCooperativeKernel((const void*)mega, dim3(grid), dim3(512), kargs, LDS_BYTES, stream);
        if (e != hipSuccess) fprintf(stderr, "cooperative launch failed: %s (grid %d)\n", hipGetErrorString(e), grid);
    };
    auto is_naive = [](int p) { return p != 0 && ((NAIVE_MASK >> p) & 1); };
    int ph = 0;
#ifndef STOP_PH
#define STOP_PH NPHASE
#endif
    while (ph < STOP_PH) {
        const int l = ph >> 3, p = ph & 7;
#ifndef SKIP_PH
#define SKIP_PH 0x0
#endif
        if ((SKIP_PH >> p) & 1) { ++ph; continue; }
        const bool cross_naive = (NAIVE_MASK >> 8) & 1;
        const bool pure_fast = !is_naive(p) && !(p == 3 && cross_naive);
        if (pure_fast) {
            int e = ph + 1;
            while (e < STOP_PH) { const int q = e & 7; if (is_naive(q) || (q == 3 && cross_naive)) break; ++e; }
            const bool whole = (ph == 0 && e == NPHASE);
            if (whole) (void)hipMemsetAsync(ws + WS_BAR, 0, WS_BAR_BYTES, stream);
            coop(ph, e, whole ? FL_XCDBAR : 0); ph = e; continue;
        }
        const float* gq_x = (const float*)d_in[14] + l * 256; const float* gk_x = (const float*)d_in[15] + l * 256;
        float* qss = qssb + (size_t)l * TOK * 4; float* lsum = lsumb + (size_t)l * TOK * 4; float* kss = kssb + l * 2048;
        const float* ss0 = ssb + (size_t)(2 * l) * TOK; float* ss1 = ssb + (size_t)(2 * l + 1) * TOK;
        if (p == 1) {
            launch_naive(xb, DM, Win_t, DM, TOK, NP, DM, EIn{proj, ss0, gq_x, gk_x, qss}, stream);
            launch_naive(Win_t + (size_t)NP * DM, DM, xb, DM, 1024, TOK, DM, EColScale{VT, ss0, TOK, 0}, stream);
        } else if (p == 2) {
            coop(ph, ph + 1, FL_SKIP_MEMKV);
            launch_naive(memb, DM, Wmkv_t, DM, 512, 1024, DM, EMemK{mkraw, ssmem, kss}, stream);
            launch_naive(Wmkv_t + (size_t)1024 * DM, DM, memb, DM, 1024, 512, DM, EColScale{mvT, ssmem, 512, 0}, stream);
        } else if (p == 3) {
            const bool attn_naive = is_naive(3);
            if (!attn_naive || !cross_naive) coop(ph, ph + 1, (attn_naive ? FL_SKIP_ATTN : 0) | (cross_naive ? FL_SKIP_CROSS : 0));
            if (attn_naive && !(DBG_SKIP & 1))
                hipLaunchKernelGGL(naive_diff_attn, dim3(16 * 256), dim3(256), 0, stream, proj, VT, (const float*)d_in[7] + l * 64, (const float*)d_in[8] + l * 64,
                                   (const float*)d_in[9] + l * 256, (const float*)d_in[10] + l * 128, l, 0);
            if (cross_naive && !(DBG_SKIP & 2)) {
                for (int b = 0; b < BATCH; ++b) for (int h = 0; h < 4; ++h) {
                    launch_naive(proj + (size_t)b * SEQ * NP + C_XQ + h * 256, NP, mkraw + (size_t)(b * 256) * 1024 + h * 256, 1024, SEQ, 256, 256,
                                 EXs<false>{proj + (size_t)b * SEQ * NP, qss + (size_t)b * SEQ * 4, kss, lsum + (size_t)b * SEQ * 4, (const float*)(ws + WS_XSH) + l, 0u, b, h, LOG2E / 16.f}, stream);
                }
                for (int b = 0; b < BATCH; ++b) for (int h = 0; h < 4; ++h) {
                    launch_naive(proj + (size_t)b * SEQ * NP + C_P + h * 256, NP, mvT + (size_t)(h * 256) * 512 + b * 256, 512, SEQ, 256, 256,
                                 EXo{proj + (size_t)b * SEQ * NP, lsum + (size_t)b * SEQ * 4, h, 0}, stream);
                }
            }
        } else if (p == 4) {
            launch_naive(proj + C_CA, NP, Wc_t, 1024, TOK, DM, 1024, EMerge{mg, proj, 0, 0}, stream);
            launch_naive(proj + C_OB, NP, Wd_t, 1024, TOK, DM, 1024, EMerge{mg, proj, 1, 0}, stream);
            launch_naive(proj + C_OC, NP, Wx_t, 1024, TOK, DM, 1024, EMerge{mg, proj, 2, 0}, stream);
        } else if (p == 5) {
            launch_naive(mg, DM, Wo_t, DM, TOK, DM, DM, ERes{l == 0 ? x_in : xcur, xcur, xb, ss1}, stream);
        } else if (p == 6) {
            launch_naive(xb, DM, Wgu_t, DM, TOK, 2 * DFF, DM, EGU{hb, ss1}, stream);
        } else if (p == 7) {
            launch_naive(hb, DFF, Wdn_t, DFF, TOK, DM, DFF, ERes{xcur, xcur, xb, l == 0 ? ssb + (size_t)2 * TOK : nullptr}, stream);
        }
        ++ph;
    }
}
```

```cpp
#include <hip/hip_runtime.h>
#include <hip/hip_cooperative_groups.h>
#include <cstdio>
#include <cstdint>
namespace cg = cooperative_groups;

#ifndef NAIVE_MASK
#define NAIVE_MASK 0x0
#endif

#ifndef REP_ATTN
#define REP_ATTN 1
#endif
#ifndef REP_P0
#define REP_P0 1
#endif
#ifndef REP_P1
#define REP_P1 1
#endif
#ifndef REP_P4
#define REP_P4 1
#endif
#ifndef REP_P5
#define REP_P5 1
#endif
#ifndef REP_P7
#define REP_P7 1
#endif
#ifndef REP_P2
#define REP_P2 1
#endif
#ifndef REP_X
#define REP_X 1
#endif
#ifndef REP_GU
#define REP_GU 1
#endif
#ifndef DBG_SKIP
#define DBG_SKIP 0
#endif
#ifndef EN_MASK
#define EN_MASK 0xFFFF
#endif
#define PH_EN(n) (((EN_MASK) >> (n)) & 1)
constexpr int BATCH = 2, SEQ = 8192, DM = 2048, TOK = BATCH * SEQ, NIN = 13312, NP = 12288, DFF = 5632, MEMLEN = 256, DEPTH = 2;
constexpr float EPS = 1e-6f, LOG2E = 1.4426950408889634f;
constexpr int C_CB = 0, C_CC = 1024, C_CX = 2048, C_DQ = 3072, C_DK = 4096, C_XQ = 5120, C_G = 6144;
constexpr int C_CA = 0, C_P = 1024, C_OC = 2048, C_OB = 3072;

typedef unsigned short bf16_t;
typedef float f32x4 __attribute__((ext_vector_type(4)));
typedef float f32x2 __attribute__((ext_vector_type(2)));
typedef float f32x16 __attribute__((ext_vector_type(16)));
typedef unsigned u32x4 __attribute__((ext_vector_type(4)));
typedef unsigned u32x2 __attribute__((ext_vector_type(2)));
typedef short bf16x8 __attribute__((ext_vector_type(8)));
typedef __bf16 bf16x2_t __attribute__((ext_vector_type(2)));
#define LAS __attribute__((address_space(3)))

constexpr size_t MiB = 1u << 20, KiB = 1024;
constexpr size_t WS_SS = 0, WS_QSS = 256 * KiB, WS_LSUM = 768 * KiB, WS_KSS = 1280 * KiB, WS_SSMEM = 1296 * KiB, WS_ZERO_LO = 64 * KiB, WS_ZERO_HI = 1296 * KiB;
constexpr size_t WS_XSH = 1300 * KiB;
constexpr size_t WS_CS = 2 * MiB, WS_MEMB = 4 * MiB, WS_MKRAW = 6 * MiB, WS_MVT = 7 * MiB;
constexpr size_t WS_WIN = 8 * MiB, WS_WC = 60 * MiB, WS_WD = 64 * MiB, WS_WX = 68 * MiB, WS_WMKV = 72 * MiB, WS_WO = 80 * MiB, WS_WGU = 88 * MiB, WS_WDN = 132 * MiB;
constexpr size_t WS_PROJ = 154 * MiB, WS_VT = 538 * MiB, WS_XB = 570 * MiB, WS_MG = 634 * MiB, WS_END = 698 * MiB;
constexpr size_t WS_H = WS_PROJ;

__device__ __forceinline__ unsigned pk2(float lo, float hi) { f32x2 v = {lo, hi}; bf16x2_t b = __builtin_convertvector(v, bf16x2_t); return __builtin_bit_cast(unsigned, b); }
__device__ __forceinline__ u32x4 pack8(f32x4 a, f32x4 b) { u32x4 w; w.x = pk2(a.x, a.y); w.y = pk2(a.z, a.w); w.z = pk2(b.x, b.y); w.w = pk2(b.z, b.w); return w; }
__device__ __forceinline__ float blo(unsigned w) { return __uint_as_float(w << 16); }
__device__ __forceinline__ float bhi(unsigned w) { return __uint_as_float(w & 0xffff0000u); }
__device__ __forceinline__ void unpack8(u32x4 w, f32x4& a, f32x4& b) { a = (f32x4){blo(w.x), bhi(w.x), blo(w.y), bhi(w.y)}; b = (f32x4){blo(w.z), bhi(w.z), blo(w.w), bhi(w.w)}; }
__device__ __forceinline__ int opaque(int v) { asm volatile("" : "+v"(v)); return v; }
__device__ __forceinline__ int phase_tid(int wave0) { int t; asm volatile("v_mbcnt_lo_u32_b32 %0, -1, 0\n\tv_mbcnt_hi_u32_b32 %0, -1, %0" : "=v"(t)); return t | (wave0 << 6); }
__device__ __forceinline__ float sum4(f32x4 v) { return (v.x + v.y) + (v.z + v.w); }
__device__ __forceinline__ float rs_of(float ss, float invn) { return rsqrtf(ss * invn + EPS); }
__constant__ float INVF[8] = {1.0f, 0.1939227432012558f, 0.03760603070259094f, 0.007292664609849453f, 0.0014142135623842478f, 0.00027424818836152554f, 5.3182957344688475e-05f, 1.0313385246263351e-05f};
__device__ __forceinline__ float xor32_sum(float v) { auto rr = __builtin_amdgcn_permlane32_swap(__float_as_uint(v), __float_as_uint(v), false, false); return __uint_as_float(rr[0]) + __uint_as_float(rr[1]); }
__device__ __forceinline__ float xor32_max(float v) { auto rr = __builtin_amdgcn_permlane32_swap(__float_as_uint(v), __float_as_uint(v), false, false); return fmaxf(__uint_as_float(rr[0]), __uint_as_float(rr[1])); }
template <int X> __device__ __forceinline__ float swz_xor(float v) { return __int_as_float(__builtin_amdgcn_ds_swizzle(__float_as_int(v), 0x1f | (X << 10))); }
__device__ __forceinline__ float wave_sum(float v) {
    v += swz_xor<1>(v); v += swz_xor<2>(v); v += swz_xor<4>(v); v += swz_xor<8>(v); v += swz_xor<16>(v); v = xor32_sum(v);
    return v;
}
__device__ __forceinline__ float wave_max(float v) {
    v = fmaxf(v, swz_xor<1>(v)); v = fmaxf(v, swz_xor<2>(v)); v = fmaxf(v, swz_xor<4>(v)); v = fmaxf(v, swz_xor<8>(v)); v = fmaxf(v, swz_xor<16>(v)); v = xor32_max(v);
    return v;
}
__device__ __forceinline__ float sigmoidf_(float v) { return __builtin_amdgcn_rcpf(1.f + __expf(-v)); }

struct EIn {
    static constexpr bool PAIRED = false;
    bf16_t* proj; const float* ss; const float* gq; const float* gk; float* qss;
    __device__ __forceinline__ float* target(int row, int col0) const { return (qss && col0 >= C_XQ && col0 < C_G) ? qss + row * 4 + ((col0 - C_XQ) >> 8) : nullptr; }
    __device__ __forceinline__ float rowscale(int row) const { return rs_of(ss[row], 1.f / DM); }
    __device__ __forceinline__ float apply(int row, int col0, f32x4 a, f32x4 b, float rs) const {
        a *= rs; b *= rs; float s = 0.f;
        if (col0 >= C_G) {
#pragma unroll
            for (int i = 0; i < 4; ++i) { a[i] = sigmoidf_(a[i]); b[i] = sigmoidf_(b[i]); }
        } else if (col0 >= C_XQ) {
            const int d = (col0 - C_XQ) & 255;
            s = sum4(a * a) + sum4(b * b);
            const f32x4 g0 = *(const f32x4*)(gq + d) * *(const f32x4*)(gk + d), g1 = *(const f32x4*)(gq + d + 4) * *(const f32x4*)(gk + d + 4);
            a *= g0; b *= g1;
        }
        *(u32x4*)(proj + (size_t)row * NP + col0) = pack8(a, b);
        return s;
    }
};
struct EColScale {
    static constexpr bool PAIRED = false;
    bf16_t* O; const float* ss; int ldc, pad;
    __device__ __forceinline__ float* target(int, int) const { return nullptr; }
    __device__ __forceinline__ float rowscale(int) const { return 1.f; }
    __device__ __forceinline__ float apply(int row, int col0, f32x4 a, f32x4 b, float) const {
        const f32x4 s0 = *(const f32x4*)(ss + col0), s1 = *(const f32x4*)(ss + col0 + 4);
#pragma unroll
        for (int i = 0; i < 4; ++i) { a[i] *= rs_of(s0[i], 1.f / DM); b[i] *= rs_of(s1[i], 1.f / DM); }
        *(u32x4*)(O + (size_t)row * ldc + col0) = pack8(a, b);
        return 0.f;
    }
};
struct EMemK {
    static constexpr bool PAIRED = false;
    bf16_t* O; const float* ssmem; float* kss;
    __device__ __forceinline__ float* target(int row, int col0) const { return kss ? kss + row * 4 + (col0 >> 8) : nullptr; }
    __device__ __forceinline__ float rowscale(int row) const { return rs_of(ssmem[row], 1.f / DM); }
    __device__ __forceinline__ float apply(int row, int col0, f32x4 a, f32x4 b, float rs) const {
        a *= rs; b *= rs;
        *(u32x4*)(O + (size_t)row * 1024 + col0) = pack8(a, b);
        return sum4(a * a) + sum4(b * b);
    }
};
template <bool LDSRK> struct EXs {
    static constexpr bool PAIRED = false;
    bf16_t* proj; const float* qss; const float* kss; float* lsum; const float* Mxp; unsigned rkl; int b, h; float c;
    __device__ __forceinline__ float* target(int row, int) const { return lsum ? lsum + row * 4 + h : nullptr; }
    __device__ __forceinline__ float rowscale(int row) const { return rs_of(qss[row * 4 + h], 1.f / 256) * c; }
    __device__ __forceinline__ float apply(int row, int col0, f32x4 a, f32x4 bb, float rq) const {
        const float Mx = __hip_atomic_load(Mxp, __ATOMIC_RELAXED, __HIP_MEMORY_SCOPE_AGENT);
        f32x4 k0, k1;
        if constexpr (LDSRK) { const LAS float* rk = (const LAS float*)rkl; k0 = *(const LAS f32x4*)(rk + col0); k1 = *(const LAS f32x4*)(rk + col0 + 4); }
        else {
#pragma unroll
            for (int i = 0; i < 4; ++i) { k0[i] = rs_of(kss[(b * 256 + col0 + i) * 4 + h], 1.f / 256); k1[i] = rs_of(kss[(b * 256 + col0 + 4 + i) * 4 + h], 1.f / 256); }
        }
        float s = 0.f;
#pragma unroll
        for (int i = 0; i < 4; ++i) {
            a[i] = __builtin_amdgcn_exp2f(a[i] * rq * k0[i] - Mx);
            bb[i] = __builtin_amdgcn_exp2f(bb[i] * rq * k1[i] - Mx);
            s += a[i] + bb[i];
        }
        *(u32x4*)(proj + (size_t)row * NP + C_P + h * 256 + col0) = pack8(a, bb);
        return s;
    }
};
struct EXo {
    static constexpr bool PAIRED = false;
    bf16_t* proj; const float* lsum; int h, pad;
    __device__ __forceinline__ float* target(int, int) const { return nullptr; }
    __device__ __forceinline__ float rowscale(int row) const { return 1.f / __hip_atomic_load(lsum + row * 4 + h, __ATOMIC_RELAXED, __HIP_MEMORY_SCOPE_AGENT); }
    __device__ __forceinline__ float apply(int row, int col0, f32x4 a, f32x4 b, float inv) const {
        a *= inv; b *= inv;
        *(u32x4*)(proj + (size_t)row * NP + C_OC + h * 256 + col0) = pack8(a, b);
        return 0.f;
    }
};
struct EMerge {
    static constexpr bool PAIRED = false;
    bf16_t* mg; const bf16_t* proj; int gi, pad;
    __device__ __forceinline__ float* target(int, int) const { return nullptr; }
    __device__ __forceinline__ float rowscale(int) const { return 1.f; }
    __device__ __forceinline__ float apply(int row, int col0, f32x4 a, f32x4 b, float) const {
        f32x4 g0, g1; unpack8(*(const u32x4*)(proj + (size_t)row * NP + C_G + gi * 2048 + col0), g0, g1);
        a *= g0; b *= g1;
        bf16_t* p = mg + (size_t)row * DM + col0;
        if (gi > 0) { f32x4 m0, m1; unpack8(*(const u32x4*)p, m0, m1); a += m0; b += m1; }
        *(u32x4*)p = pack8(a, b);
        return 0.f;
    }
};
struct ERes {
    static constexpr bool PAIRED = false;
    const float* xin; float* xout; bf16_t* xb; float* ssn;
    __device__ __forceinline__ float* target(int row, int) const { return ssn ? ssn + row : nullptr; }
    __device__ __forceinline__ float rowscale(int) const { return 1.f; }
    static constexpr bool HASPRE = true;
    __device__ __forceinline__ void pre(int row, int col0, f32x4& p0, f32x4& p1) const { const size_t off = (size_t)row * DM + col0; p0 = *(const f32x4*)(xin + off); p1 = *(const f32x4*)(xin + off + 4); }
    __device__ __forceinline__ float apply(int row, int col0, f32x4 a, f32x4 b, float rs) const { f32x4 p0, p1; pre(row, col0, p0, p1); return apply_pre(row, col0, a, b, rs, p0, p1); }
    __device__ __forceinline__ float apply_pre(int row, int col0, f32x4 a, f32x4 b, float, f32x4 p0, f32x4 p1) const {
        const size_t off = (size_t)row * DM + col0;
        a += p0; b += p1;
        *(f32x4*)(xout + off) = a; *(f32x4*)(xout + off + 4) = b;
        *(u32x4*)(xb + off) = pack8(a, b);
        return sum4(a * a) + sum4(b * b);
    }
};
struct EGU {
    static constexpr bool PAIRED = true;
    bf16_t* H; const float* ss;
    __device__ __forceinline__ float rowscale(int row) const { return rs_of(ss[row], 1.f / DM); }
    __device__ __forceinline__ void apply2(int row, int lcol0, f32x4 a0, f32x4 a1, f32x4 b0, f32x4 b1, float rs) const {
#pragma unroll
        for (int i = 0; i < 4; ++i) {
            const float x = a0[i] * rs, y = a1[i] * rs;
            a0[i] = x * sigmoidf_(x) * (b0[i] * rs); a1[i] = y * sigmoidf_(y) * (b1[i] * rs);
        }
        *(u32x4*)(H + (size_t)row * DFF + lcol0) = pack8(a0, a1);
    }
};

__device__ __forceinline__ float dot8(u32x4 a, u32x4 b) {
    float s = blo(a.x) * blo(b.x); s += bhi(a.x) * bhi(b.x); s += blo(a.y) * blo(b.y); s += bhi(a.y) * bhi(b.y);
    s += blo(a.z) * blo(b.z); s += bhi(a.z) * bhi(b.z); s += blo(a.w) * blo(b.w); s += bhi(a.w) * bhi(b.w); return s;
}
__device__ __forceinline__ int pi32(int i) { return (i & 0x13) | ((i & 4) << 1) | ((i & 8) >> 1); }
template <class E> __global__ void __launch_bounds__(256) naive_gemm(const bf16_t* A, const bf16_t* Bt, E e, int lda, int ldb, int M, int N, int K, int pad) {
    const int lane = threadIdx.x & 63, i32 = lane & 31, hi = lane >> 5;
    const int nct = E::PAIRED ? (N / 256) * 4 : N / 32;
    const long w = (long)blockIdx.x * 4 + (threadIdx.x >> 6); if (w >= (long)(M / 32) * nct) return;
    const int mt = (int)(w / nct), ct = (int)(w % nct), row0 = mt * 32;
    const int pcol = E::PAIRED ? (ct >> 2) * 256 + (ct & 3) * 32 : ct * 32, lcol = E::PAIRED ? (ct >> 2) * 128 + (ct & 3) * 32 : pcol;
    const bf16_t* ap = A + (size_t)(row0 + i32) * lda + 8 * hi;
    const bf16_t* bp = Bt + (size_t)(pcol + pi32(i32)) * ldb + 8 * hi;
    f32x16 acc, acc2;
#pragma unroll
    for (int r = 0; r < 16; ++r) { acc[r] = 0.f; acc2[r] = 0.f; }
    for (int k = 0; k < K; k += 16) {
        const bf16x8 af = *(const bf16x8*)(ap + k), bf = *(const bf16x8*)(bp + k);
        acc = __builtin_amdgcn_mfma_f32_32x32x16_bf16(bf, af, acc, 0, 0, 0);
        if constexpr (E::PAIRED) { const bf16x8 bf2 = *(const bf16x8*)(bp + (size_t)128 * ldb + k); acc2 = __builtin_amdgcn_mfma_f32_32x32x16_bf16(bf2, af, acc2, 0, 0, 0); }
    }
    const int row = row0 + i32;
#pragma unroll
    for (int hf = 0; hf < 2; ++hf) {
        const f32x4 a = {acc[8 * hf], acc[8 * hf + 1], acc[8 * hf + 2], acc[8 * hf + 3]}, b = {acc[8 * hf + 4], acc[8 * hf + 5], acc[8 * hf + 6], acc[8 * hf + 7]};
        if constexpr (E::PAIRED) { const f32x4 c = {acc2[8 * hf], acc2[8 * hf + 1], acc2[8 * hf + 2], acc2[8 * hf + 3]}, d = {acc2[8 * hf + 4], acc2[8 * hf + 5], acc2[8 * hf + 6], acc2[8 * hf + 7]};
            e.apply2(row, lcol + 16 * hf + 8 * hi, a, b, c, d, e.rowscale(row)); }
        else { const float sp = e.apply(row, lcol + 16 * hf + 8 * hi, a, b, e.rowscale(row)); float* tg = e.target(row, lcol + 16 * hf + 8 * hi); if (tg) atomicAdd(tg, sp); }
    }
}

struct AttnConsts { float Mfix, lam, osc; };
__device__ __forceinline__ AttnConsts attn_consts(const float* gq, const float* gk, const float* lv, int layer, int lane) {
    AttnConsts c;
    const float mq = wave_max(fabsf(gq[lane])), mk = wave_max(fabsf(gk[lane]));
    c.Mfix = 8.f * mq * mk * LOG2E;
    const float s1 = wave_sum(lv[lane] * lv[64 + lane]), s2 = wave_sum(lv[128 + lane] * lv[192 + lane]);
    const float lam_init = 0.8f - 0.6f * expf(-0.3f * (float)layer);
    c.lam = expf(s1) - expf(s2) + lam_init; c.osc = 1.f - lam_init;
    return c;
}
__device__ __forceinline__ float xattn_shift(const float* gq, const float* gk, int lane) {
    float m = 0.f;
#pragma unroll
    for (int j = 0; j < 4; ++j) m = fmaxf(m, fabsf(gq[lane + 64 * j] * gk[lane + 64 * j]));
    return 16.f * wave_max(m) * LOG2E;
}

__global__ void __launch_bounds__(256) naive_diff_attn(bf16_t* proj, const bf16_t* VT, const float* gq, const float* gk, const float* lv, const float* gsub, int layer, int pad) {
    __shared__ float sQ[2][32][65], sK[2][32][65], sV[32][129], sP[2][32][33];
    const int t = threadIdx.x, lane = t & 63;
    const AttnConsts ac = attn_consts(gq, gk, lv, layer, lane);
    const int qt = blockIdx.x & 255, bh = blockIdx.x >> 8, b = bh >> 3, h = bh & 7;
    const size_t rowbase = (size_t)b * SEQ; const int q0 = qt * 32;
    for (int i = t; i < 2 * 32 * 64; i += 256) { const int c = i >> 11, r = (i >> 6) & 31, d = i & 63;
        sQ[c][r][d] = blo(proj[(rowbase + q0 + r) * NP + C_DQ + h * 128 + c * 64 + d]); }
    const int c = t >> 7, qr = (t & 127) >> 2, g4 = t & 3;
    float o[32]; float l = 0.f;
#pragma unroll
    for (int i = 0; i < 32; ++i) o[i] = 0.f;
    for (int kt = 0; kt <= qt; ++kt) {
        const int kv0 = kt * 32;
        __syncthreads();
        for (int i = t; i < 2 * 32 * 64; i += 256) { const int cc = i >> 11, r = (i >> 6) & 31, d = i & 63;
            sK[cc][r][d] = blo(proj[(rowbase + kv0 + r) * NP + C_DK + h * 128 + cc * 64 + d]); }
        for (int i = t; i < 32 * 128; i += 256) { const int d = i >> 5, r = i & 31;
            sV[r][d] = blo(VT[(size_t)(h * 128 + d) * TOK + rowbase + kv0 + r]); }
        __syncthreads();
#pragma unroll
        for (int j = 0; j < 8; ++j) { const int kv = g4 * 8 + j; float s = 0.f;
            for (int d = 0; d < 64; ++d) s += sQ[c][qr][d] * sK[c][kv][d];
            float p = __builtin_amdgcn_exp2f(s - ac.Mfix); if (kv0 + kv > q0 + qr) p = 0.f;
            sP[c][qr][kv] = p; }
        __syncthreads();
        for (int kv = 0; kv < 32; ++kv) { const float p = sP[c][qr][kv]; l += p;
#pragma unroll
            for (int i = 0; i < 32; ++i) o[i] += p * sV[kv][g4 * 32 + i]; }
    }
    __syncthreads();
    const float inv = 1.f / l;
    if (c == 1) {
#pragma unroll
        for (int i = 0; i < 32; ++i) sV[qr][g4 * 32 + i] = o[i] * inv; }
    __syncthreads();
    if (c == 0) {
        float ss = 0.f;
#pragma unroll
        for (int i = 0; i < 32; ++i) { o[i] = o[i] * inv - ac.lam * sV[qr][g4 * 32 + i]; ss += o[i] * o[i]; }
        ss += __shfl_xor(ss, 1); ss += __shfl_xor(ss, 2);
        const float rs = rs_of(ss, 1.f / 128) * ac.osc;
#pragma unroll
        for (int i = 0; i < 32; i += 2) {
            const int d = g4 * 32 + i;
            *(unsigned*)(proj + (rowbase + q0 + qr) * NP + C_OB + h * 128 + d) = pk2(o[i] * rs * gsub[d], o[i + 1] * rs * gsub[d + 1]);
        }
    }
}

namespace pg8 {
constexpr int BM = 256, BK = 64, HALF = 128, HTB = HALF * BK * 2, STAGE_BYTES = 8 * HTB, NXCD = 8, WGM = 8;
__host__ __device__ __forceinline__ int lds_byte(int r, int c) { const int st = (r >> 4) * 2 + (c >> 5), rr = r & 15, cc = c & 31, ob = rr * 64 + cc * 2; return st * 1024 + (ob ^ (((ob >> 9) & 1) << 5)); }
__host__ __device__ __forceinline__ void stage_rc(int b, int& R, int& C) { const int st = b / 1024, sb = b % 1024, swz = sb ^ (((sb >> 9) & 1) << 5); R = (st >> 1) * 16 + swz / 64; C = (st & 1) * 32 + (swz % 64) / 2; }
__host__ __device__ __forceinline__ int perm32(int rho) { const int n = rho >> 4, i = rho & 15; return 8 * (i >> 2) + 4 * n + (i & 3); }
struct Unit { int pm, pn, aoff, gi; };
struct Gemm { const bf16_t* A; const bf16_t* Bt; int M, N, K, lda, ldb; };
struct StaticOrder {
    int nM, nN, nwg, G, c;
    __device__ void init(int M, int N, int G_, int c_) { nM = M / BM; nN = N / BM; nwg = nM * nN; G = G_; c = c_; }
    __device__ bool next(int i, Unit& u) const {
        const long L = (long)i * G + c; if (L >= nwg || c >= G) return false;
        int wgid = (int)L; { const int q = nwg / NXCD, r = nwg % NXCD, xcd = wgid % NXCD, off = wgid / NXCD; wgid = (xcd < r ? xcd * (q + 1) : r * (q + 1) + (xcd - r) * q) + off; }
        const int nig = WGM * nN, gid = wgid / nig, fm = gid * WGM, gsz = (nM - fm) < WGM ? (nM - fm) : WGM;
        u.pm = fm + ((wgid % nig) % gsz); u.pn = (wgid % nig) / gsz; u.aoff = 0; u.gi = 0; return true;
    }
};
struct OneUnit { Unit u; bool valid; __device__ bool next(int i, Unit& o) const { if (i || !valid) return false; o = u; return true; } };

template <class F, class = void> struct has_pre { static constexpr bool value = false; };
template <class F> struct has_pre<F, decltype((void)F::HASPRE)> { static constexpr bool value = true; };
template <class F> struct EpiWrap {
    F f;
    __device__ __forceinline__ bool zero_after(const Unit&) const { return true; }
    __device__ __forceinline__ void operator()(f32x4 (&acc)[2][2][4][2], const Unit& u, int wr, int wc, int fr, int fq) const {
        f32x4 pr[4][2][2];
        float rsv[2][4];
#pragma unroll
        for (int ai = 0; ai < 2; ++ai)
#pragma unroll
            for (int m = 0; m < 4; ++m) rsv[ai][m] = f.rowscale(u.pm * BM + ai * HALF + wr * 64 + m * 16 + fr);
#pragma unroll
        for (int ai = 0; ai < 2; ++ai)
#pragma unroll
            for (int m = 0; m < 4; ++m) {
                const int row = u.pm * BM + ai * HALF + wr * 64 + m * 16 + fr;
                if constexpr (F::PAIRED) f.apply2(row, u.pn * 128 + wc * 32 + 8 * fq, acc[ai][0][m][0], acc[ai][0][m][1], acc[ai][1][m][0], acc[ai][1][m][1], rsv[ai][m]);
                else if constexpr (has_pre<F>::value) {
                    if (m == 0) {
#pragma unroll
                        for (int mm = 0; mm < 4; ++mm)
#pragma unroll
                            for (int bj = 0; bj < 2; ++bj) f.pre(row + 16 * mm, u.pn * BM + bj * HALF + wc * 32 + 8 * fq, pr[mm][bj][0], pr[mm][bj][1]);
                    }
                    float sp = 0.f;
#pragma unroll
                    for (int bj = 0; bj < 2; ++bj) sp += f.apply_pre(row, u.pn * BM + bj * HALF + wc * 32 + 8 * fq, acc[ai][bj][m][0], acc[ai][bj][m][1], rsv[ai][m], pr[m][bj][0], pr[m][bj][1]);
                    float* tg = f.target(row, u.pn * BM + wc * 32 + 8 * fq);
                    if (tg) { sp += swz_xor<16>(sp); sp = xor32_sum(sp); if (fq == 0) atomicAdd(tg, sp); }
                } else {
                    float sp = 0.f;
#pragma unroll
                    for (int bj = 0; bj < 2; ++bj) sp += f.apply(row, u.pn * BM + bj * HALF + wc * 32 + 8 * fq, acc[ai][bj][m][0], acc[ai][bj][m][1], rsv[ai][m]);
                    float* tg = f.target(row, u.pn * BM + wc * 32 + 8 * fq);
                    if (tg) { sp += swz_xor<16>(sp); sp = xor32_sum(sp); if (fq == 0) atomicAdd(tg, sp); }
                }
                if (m == 3) asm volatile("" ::: "memory");
            }
    }
};

struct ChainOrder {
    StaticOrder base;
    __device__ bool next(int j, Unit& u) const {
        const int i = j / 3, gi = j - 3 * i; Unit t;
        if (!base.next(i, t)) return false;
        u.pm = t.pm; u.pn = gi * 8 + t.pn; u.aoff = (gi == 0) ? C_CA : (gi == 1) ? C_OB : C_OC; u.gi = gi; return true;
    }
};
struct EpiChain {
    bf16_t* mg; const bf16_t* proj;
    __device__ __forceinline__ bool zero_after(const Unit& u) const { return u.gi == 2; }
    __device__ __forceinline__ void operator()(f32x4 (&acc)[2][2][4][2], const Unit& u, int wr, int wc, int fr, int fq) const {
        const int pn = u.pn & 7, gi = u.gi;
        u32x4 gc[4][2], gn[4][2];
#pragma unroll
        for (int ai = 0; ai < 2; ++ai)
#pragma unroll
            for (int m = 0; m < 4; ++m) {
                const int row = u.pm * BM + ai * HALF + wr * 64 + m * 16 + fr;
                if (m == 0) {
#pragma unroll
                    for (int mm = 0; mm < 4; ++mm)
#pragma unroll
                        for (int bj = 0; bj < 2; ++bj) {
                            const bf16_t* gp = proj + (size_t)(row + 16 * mm) * NP + C_G + gi * 2048 + pn * BM + bj * HALF + wc * 32 + 8 * fq;
                            gc[mm][bj] = *(const u32x4*)gp; if (gi < 2) gn[mm][bj] = *(const u32x4*)(gp + 2048);
                        }
                }
#pragma unroll
                for (int bj = 0; bj < 2; ++bj) {
                    const int col0 = pn * BM + bj * HALF + wc * 32 + 8 * fq;
                    f32x4 g0, g1; unpack8(gc[m][bj], g0, g1);
                    if (gi < 2) {
                        f32x4 n0, n1; unpack8(gn[m][bj], n0, n1);
#pragma unroll
                        for (int i = 0; i < 4; ++i) { g0[i] *= __builtin_amdgcn_rcpf(fmaxf(n0[i], 1e-30f)); g1[i] *= __builtin_amdgcn_rcpf(fmaxf(n1[i], 1e-30f)); }
                        acc[ai][bj][m][0] *= g0; acc[ai][bj][m][1] *= g1;
                    } else {
                        *(u32x4*)(mg + (size_t)row * DM + col0) = pack8(acc[ai][bj][m][0] * g0, acc[ai][bj][m][1] * g1);
                    }
                }
                if (m == 3) asm volatile("" ::: "memory");
            }
    }
};

template <class Epi, class Sched>
__device__ __forceinline__ void gemm_phase(LAS unsigned char* lds, const Gemm g, const Sched& S, const Epi& E, const int tid) {
    const int wid = __builtin_amdgcn_readfirstlane(tid >> 6), lane = tid & 63, wr = wid >> 2, wc = wid & 3, fr = lane & 15, fq = lane >> 4;
    const int K = g.K, nt = K / BK;
    unsigned voffA[2], voffB[2];
#pragma unroll
    for (int i = 0; i < 2; ++i) { int R, C; stage_rc(tid * 16 + i * 8192, R, C); const int Rb = (R & ~31) + perm32(R & 31);
        voffA[i] = (unsigned)(R * g.lda + C) * 2u; voffB[i] = (unsigned)(Rb * g.ldb + C) * 2u; }
    const size_t kstep = (size_t)(BK * 2);
    const size_t hstepA = (size_t)HALF * g.lda * 2, hstepB = (size_t)HALF * g.ldb * 2, tstepA = 2 * hstepA, tstepB = 2 * hstepB;
    const unsigned ldsw = (unsigned)wid * 1024u;
    const int aoff = lds_byte(wr * 64 + fr, fq * 8), boff = lds_byte(wc * 32 + fr, fq * 8);
#define PG8_SA(b, h) (((b) * 2 + (h)) * HTB)
#define PG8_SB(b, h) ((4 + (b) * 2 + (h)) * HTB)
#define PG8_STAGE(bufoff, gbase, voff) do { _Pragma("unroll") for (int _i = 0; _i < 2; ++_i) \
        __builtin_amdgcn_global_load_lds((const unsigned*)((const char*)(gbase) + (voff)[_i]), (LAS unsigned*)(lds + (bufoff) + ldsw + _i * 8192), 16, 0, 0); } while (0)
#define PG8_LDA(dst, b, h) do { _Pragma("unroll") for (int m = 0; m < 4; ++m) _Pragma("unroll") for (int k = 0; k < 2; ++k) dst[m][k] = *(const LAS bf16x8*)(lds + PG8_SA(b, h) + aoff + m * 2048 + k * 1024); } while (0)
#define PG8_LDB(dst, b, h) do { _Pragma("unroll") for (int n = 0; n < 2; ++n) _Pragma("unroll") for (int k = 0; k < 2; ++k) dst[n][k] = *(const LAS bf16x8*)(lds + PG8_SB(b, h) + boff + n * 2048 + k * 1024); } while (0)
#define PG8_MMA(ai, bj, At, Bt) do { __builtin_amdgcn_s_setprio(1); _Pragma("unroll") for (int m = 0; m < 4; ++m) _Pragma("unroll") for (int n = 0; n < 2; ++n) _Pragma("unroll") for (int k = 0; k < 2; ++k) \
        acc[ai][bj][m][n] = __builtin_amdgcn_mfma_f32_16x16x32_bf16(Bt[n][k], At[m][k], acc[ai][bj][m][n], 0, 0, 0); __builtin_amdgcn_s_setprio(0); } while (0)
#define PG8_WAIT_V(n) asm volatile("s_waitcnt vmcnt(" #n ")" ::: "memory")
#define PG8_WAIT_L(n) asm volatile("s_waitcnt lgkmcnt(" #n ")" ::: "memory")
#define PG8_BAR __builtin_amdgcn_s_barrier()
#define PG8_SCHED __builtin_amdgcn_sched_barrier(0)
    Unit cur, nxt; int ui = 0;
    if (!S.next(0, cur)) return;
    f32x4 acc[2][2][4][2];
#pragma unroll
    for (int a = 0; a < 2; ++a)
#pragma unroll
        for (int b = 0; b < 2; ++b)
#pragma unroll
            for (int m = 0; m < 4; ++m)
#pragma unroll
                for (int n = 0; n < 2; ++n) acc[a][b][m][n] = (f32x4){0.f, 0.f, 0.f, 0.f};
    bf16x8 At[4][2], B0[2][2], B1[2][2];
    const char* cA = (const char*)g.A + (size_t)cur.pm * tstepA + (size_t)cur.aoff * 2; const char* cB = (const char*)g.Bt + (size_t)cur.pn * tstepB;
    PG8_STAGE(PG8_SB(0, 0), cB, voffB); PG8_STAGE(PG8_SB(0, 1), cB + hstepB, voffB); PG8_STAGE(PG8_SA(0, 0), cA, voffA); PG8_STAGE(PG8_SA(0, 1), cA + hstepA, voffA);
    if (wr == 1) PG8_BAR;
    PG8_WAIT_V(2); PG8_BAR;
    PG8_STAGE(PG8_SB(1, 0), cB + kstep, voffB); PG8_STAGE(PG8_SA(1, 0), cA + kstep, voffA); PG8_STAGE(PG8_SB(1, 1), cB + hstepB + kstep, voffB);
    PG8_WAIT_V(6); PG8_BAR;
    for (;;) {
        const bool has_next = S.next(ui + 1, nxt);
        const char* nA = has_next ? (const char*)g.A + (size_t)nxt.pm * tstepA + (size_t)nxt.aoff * 2 : cA; const char* nB = has_next ? (const char*)g.Bt + (size_t)nxt.pn * tstepB : cB;
        for (int t = 0; t < nt; t += 2) {
            const bool last = (t == nt - 2);
            const char* a1 = cA + (size_t)(t + 1) * kstep;
            const char* a2 = last ? nA : cA + (size_t)(t + 2) * kstep; const char* b2 = last ? nB : cB + (size_t)(t + 2) * kstep;
            const char* a3 = a2 + kstep; const char* b3 = b2 + kstep;
            PG8_LDB(B0, 0, 0); PG8_LDB(B1, 0, 1); PG8_SCHED; PG8_LDA(At, 0, 0); PG8_STAGE(PG8_SA(1, 1), a1 + hstepA, voffA);
            PG8_WAIT_V(8); PG8_WAIT_L(0); PG8_BAR; PG8_MMA(0, 0, At, B0); PG8_MMA(0, 1, At, B1); PG8_BAR; PG8_SCHED;
            PG8_LDA(At, 0, 1); PG8_STAGE(PG8_SB(0, 0), b2, voffB); PG8_STAGE(PG8_SB(0, 1), b2 + hstepB, voffB); PG8_STAGE(PG8_SA(0, 0), a2, voffA);
            PG8_WAIT_V(8); PG8_WAIT_L(0); PG8_BAR; PG8_MMA(1, 0, At, B0); PG8_MMA(1, 1, At, B1); PG8_BAR; PG8_SCHED;
            PG8_LDB(B0, 1, 0); PG8_LDB(B1, 1, 1); PG8_SCHED; PG8_LDA(At, 1, 0); PG8_STAGE(PG8_SA(0, 1), a2 + hstepA, voffA);
            PG8_WAIT_V(8); PG8_WAIT_L(0); PG8_BAR; PG8_MMA(0, 0, At, B0); PG8_MMA(0, 1, At, B1); PG8_BAR; PG8_SCHED;
            PG8_LDA(At, 1, 1); PG8_STAGE(PG8_SB(1, 0), b3, voffB); PG8_STAGE(PG8_SB(1, 1), b3 + hstepB, voffB); PG8_STAGE(PG8_SA(1, 0), a3, voffA);
            PG8_WAIT_V(8); PG8_WAIT_L(0); PG8_BAR; PG8_MMA(1, 0, At, B0); PG8_MMA(1, 1, At, B1); PG8_BAR; PG8_SCHED;
        }
        if (wr == 0) PG8_BAR;
        E(acc, cur, wr, wc, fr, fq);
        if (!has_next) break;
        if (E.zero_after(cur))
#pragma unroll
        for (int a = 0; a < 2; ++a)
#pragma unroll
            for (int b = 0; b < 2; ++b)
#pragma unroll
                for (int m = 0; m < 4; ++m)
#pragma unroll
                    for (int n = 0; n < 2; ++n) acc[a][b][m][n] = (f32x4){0.f, 0.f, 0.f, 0.f};
        cur = nxt; cA = nA; cB = nB; ++ui;
        if (wr == 1) PG8_BAR;
    }
    PG8_WAIT_V(0);
    PG8_BAR;
#undef PG8_SA
#undef PG8_SB
#undef PG8_STAGE
#undef PG8_LDA
#undef PG8_LDB
#undef PG8_MMA
#undef PG8_WAIT_V
#undef PG8_WAIT_L
#undef PG8_BAR
#undef PG8_SCHED
}
}

__device__ __forceinline__ void glds16(const void* gsrc, unsigned lds_dst) { unsigned keep;
    asm volatile("s_mov_b32 %0, m0\n\ts_mov_b32 m0, %2\n\ts_nop 0\n\tglobal_load_lds_dwordx4 %1, off\n\ts_mov_b32 m0, %0" : "=&s"(keep) : "v"(gsrc), "s"(lds_dst) : "memory"); }
constexpr int ATT_LDS = 65536;
template <bool NOSHIFT> __device__ __forceinline__ void diff_attn_unit(LAS unsigned char* lds, bf16_t* proj, const bf16_t* VT, int b, int h, int qb, const AttnConsts ac, const float* gsub, const int tid, bf16_t* obuf, int opitch, int ocol) {
    const int lane = tid & 63, wid = __builtin_amdgcn_readfirstlane(tid >> 6), wq = wid & 3, c = wid >> 2, i32 = lane & 31, hi = lane >> 5;
    const size_t rowbase = (size_t)b * SEQ; const int q0 = qb * 128, qrow = q0 + 32 * wq + i32;
    bf16x8 qf[4];
    { const bf16_t* qp = proj + (rowbase + qrow) * NP + C_DQ + h * 128 + c * 64 + hi * 8;
#pragma unroll
      for (int ks = 0; ks < 4; ++ks) qf[ks] = *(const bf16x8*)(qp + 16 * ks); }
    const unsigned lds0 = (unsigned)(uintptr_t)lds;
    const int krow_s = 4 * wid + (lane >> 4), vd_s = 8 * wid + (lane >> 3);
    const bf16_t* kg = proj + (rowbase + krow_s) * NP + C_DK + h * 128 + (((lane & 15) ^ (krow_s & 15)) * 8);
    const bf16_t* vg = VT + (size_t)(h * 128 + vd_s) * TOK + rowbase + (((lane & 7) ^ ((vd_s >> 1) & 7)) * 8);
    const unsigned kdst = lds0 + wid * 1024, vdst = lds0 + 65536 + wid * 1024;
#define ATT_ISSUE(tt) do { const unsigned so_ = ((tt) & 3) * 16384; const bf16_t* kp_ = kg + (size_t)(tt) * 64 * NP; const bf16_t* vp_ = vg + (size_t)(tt) * 64; \
        glds16(kp_, (unsigned)__builtin_amdgcn_readfirstlane(kdst + so_)); glds16(kp_ + (size_t)32 * NP, (unsigned)__builtin_amdgcn_readfirstlane(kdst + so_ + 8192)); \
        glds16(vp_, (unsigned)__builtin_amdgcn_readfirstlane(vdst + so_)); glds16(vp_ + (size_t)64 * TOK, (unsigned)__builtin_amdgcn_readfirstlane(vdst + so_ + 8192)); } while (0)
#define ATT_WAITBAR(N) asm volatile("s_waitcnt vmcnt(" #N ") lgkmcnt(0)\n\ts_barrier" ::: "memory")
    const int krow = pi32(i32);
    int koff[2][4];
#pragma unroll
    for (int mt = 0; mt < 2; ++mt)
#pragma unroll
        for (int ks = 0; ks < 4; ++ks) { const int r = 32 * mt + krow; koff[mt][ks] = r * 256 + (((8 * c + 2 * ks + hi) ^ (r & 15)) * 16); }
    const int NT = 2 * qb + 2;
    f32x16 o[4];
#pragma unroll
    for (int dt = 0; dt < 4; ++dt)
#pragma unroll
        for (int r = 0; r < 16; ++r) o[dt][r] = 0.f;
    float l = 0.f;
    bf16x8 pf[4];
#pragma unroll
    for (int kk = 0; kk < 4; ++kk) pf[kk] = (bf16x8){0, 0, 0, 0, 0, 0, 0, 0};
    const int qmax = q0 + 32 * wq + 31;
#define ATT_LDV(dst, slot, kk) do { _Pragma("unroll") for (int dt = 0; dt < 4; ++dt) { const int d = 32 * dt + i32; \
        dst[dt] = *(const LAS bf16x8*)(lds + 65536 + (slot) + d * 128 + (((2 * (kk) + hi) ^ ((d >> 1) & 7)) * 16)); } } while (0)
#define ATT_MMV(src, kk) do { __builtin_amdgcn_s_setprio(1); _Pragma("unroll") for (int dt = 0; dt < 4; ++dt) o[dt] = __builtin_amdgcn_mfma_f32_32x32x16_bf16(src[dt], pf[kk], o[dt], 0, 0, 0); __builtin_amdgcn_s_setprio(0); } while (0)
#define ATT_SB __builtin_amdgcn_sched_barrier(0)
#define ATT_PV(slot) do { bf16x8 va[4], vb[4]; ATT_LDV(va, slot, 0); ATT_SB; ATT_LDV(vb, slot, 1); ATT_SB; ATT_MMV(va, 0); ATT_SB; ATT_LDV(va, slot, 2); ATT_SB; ATT_MMV(vb, 1); ATT_SB; \
        ATT_LDV(vb, slot, 3); ATT_SB; ATT_MMV(va, 2); ATT_SB; ATT_MMV(vb, 3); ATT_SB; } while (0)
    ATT_ISSUE(0); ATT_ISSUE(1);
    ATT_WAITBAR(4);
    for (int t = 0; t < NT; ++t) {
        const int bo = (t & 3) * 16384, sl_cur = bo, sl_prev = ((t - 1) & 3) * 16384;
        if (t + 2 < NT) ATT_ISSUE(t + 2);
        const int kv0 = 64 * t;
        if (c == 1 && t >= 1 && kv0 - 64 <= qmax) ATT_PV(sl_prev);
        if (kv0 <= qmax) {
            f32x16 p[2];
            bf16x8 kf[2][4];
#pragma unroll
            for (int mt = 0; mt < 2; ++mt)
#pragma unroll
                for (int ks = 0; ks < 4; ++ks) kf[mt][ks] = *(const LAS bf16x8*)(lds + bo + koff[mt][ks]);
            if constexpr (!NOSHIFT) {
#pragma unroll
                for (int mt = 0; mt < 2; ++mt)
#pragma unroll
                    for (int r = 0; r < 16; ++r) p[mt][r] = -ac.Mfix;
            }
            ATT_SB;
            __builtin_amdgcn_s_setprio(1);
#pragma unroll
            for (int ks = 0; ks < 4; ++ks)
#pragma unroll
                for (int mt = 0; mt < 2; ++mt) {
                    if (NOSHIFT && ks == 0) { const f32x16 z = {0.f, 0.f, 0.f, 0.f, 0.f, 0.f, 0.f, 0.f, 0.f, 0.f, 0.f, 0.f, 0.f, 0.f, 0.f, 0.f}; p[mt] = __builtin_amdgcn_mfma_f32_32x32x16_bf16(kf[mt][ks], qf[ks], z, 0, 0, 0); }
                    else p[mt] = __builtin_amdgcn_mfma_f32_32x32x16_bf16(kf[mt][ks], qf[ks], p[mt], 0, 0, 0);
                }
            __builtin_amdgcn_s_setprio(0);
            ATT_SB;
            const bool diag = (t >= 2 * qb);
            if (diag) {
                const int qrel = qrow - kv0 - 8 * hi;
#pragma unroll
                for (int mt = 0; mt < 2; ++mt)
#pragma unroll
                    for (int r = 0; r < 16; ++r) { float v = __builtin_amdgcn_exp2f(p[mt][r]); if (32 * mt + 16 * (r >> 3) + (r & 7) > qrel) v = 0.f; p[mt][r] = v; l += v; }
            } else {
#pragma unroll
                for (int mt = 0; mt < 2; ++mt)
#pragma unroll
                    for (int r = 0; r < 16; ++r) { const float v = __builtin_amdgcn_exp2f(p[mt][r]); p[mt][r] = v; l += v; }
            }
            asm volatile("" ::: "memory");
#pragma unroll
            for (int kk = 0; kk < 4; ++kk) { const int mt = kk >> 1, r0 = 8 * (kk & 1); u32x4 w;
                w.x = pk2(p[mt][r0], p[mt][r0 + 1]); w.y = pk2(p[mt][r0 + 2], p[mt][r0 + 3]); w.z = pk2(p[mt][r0 + 4], p[mt][r0 + 5]); w.w = pk2(p[mt][r0 + 6], p[mt][r0 + 7]);
                pf[kk] = __builtin_bit_cast(bf16x8, w); }
            if (c == 0) ATT_PV(sl_cur);
        }
        if (t + 2 < NT) ATT_WAITBAR(4); else ATT_WAITBAR(0);
    }
    if (c == 1 && 64 * (NT - 1) <= qmax) ATT_PV(((NT - 1) & 3) * 16384);
#undef ATT_ISSUE
#undef ATT_WAITBAR
#undef ATT_PV
#undef ATT_LDV
#undef ATT_MMV
#undef ATT_SB
    l = xor32_sum(l);
    const float inv = 1.f / l;
    LAS float* xch = (LAS float*)lds + (size_t)wq * 4096 + lane;
    if (c == 1) {
#pragma unroll
        for (int dt = 0; dt < 4; ++dt)
#pragma unroll
            for (int r = 0; r < 16; ++r) xch[(dt * 16 + r) * 64] = o[dt][r] * inv;
    }
    __syncthreads();
    if (c == 0) {
        float ss = 0.f;
#pragma unroll
        for (int dt = 0; dt < 4; ++dt)
#pragma unroll
            for (int r = 0; r < 16; ++r) { const float v = o[dt][r] * inv - ac.lam * xch[(dt * 16 + r) * 64]; o[dt][r] = v; ss += v * v; }
        ss = xor32_sum(ss);
        const float rs = rs_of(ss, 1.f / 128) * ac.osc;
        bf16_t* op = obuf + (rowbase + qrow) * opitch + ocol + h * 128;
#pragma unroll
        for (int dt = 0; dt < 4; ++dt)
#pragma unroll
            for (int rg = 0; rg < 4; ++rg) { const int d = 32 * dt + 8 * rg + 4 * hi; const f32x4 g = *(const f32x4*)(gsub + d);
                u32x2 w; w.x = pk2(o[dt][4 * rg] * rs * g.x, o[dt][4 * rg + 1] * rs * g.y); w.y = pk2(o[dt][4 * rg + 2] * rs * g.z, o[dt][4 * rg + 3] * rs * g.w);
                *(u32x2*)(op + d) = w; }
    }
    __syncthreads();
}

__device__ __forceinline__ int maprow(int mode, int n) {
    if (mode == 1) { if (n < 5120) return n; if (n < 6144) return 12288 + (n - 5120); if (n < 7168) return 5120 + (n - 6144); return 6144 + (n - 7168); }
    if (mode == 2) { if (n < DFF) return (n >> 7) * 256 + (n & 127); const int m = n - DFF; return (m >> 7) * 256 + 128 + (m & 127); }
    return n;
}
__device__ __forceinline__ void conv_item(const float* W, int K, int N, bf16_t* Wt, const float* g, int mode, int item, int lane) {
    const int nkc = K >> 7, nb = item / nkc, kc = item - nb * nkc, n0 = nb * 64, k0 = kc * 128, kgp = lane >> 4, nq = lane & 15;
    const int drow = maprow(mode, n0) + 4 * nq;
#pragma unroll 2
    for (int it = 0; it < 4; ++it) {
        const int kb = k0 + it * 32 + kgp * 8;
        f32x4 v[8];
#pragma unroll
        for (int j = 0; j < 8; ++j) v[j] = *(const f32x4*)(W + (size_t)(kb + j) * N + n0 + 4 * nq);
        if (g) {
            const f32x4 g0 = *(const f32x4*)(g + kb), g1 = *(const f32x4*)(g + kb + 4);
#pragma unroll
            for (int j = 0; j < 4; ++j) { v[j] *= g0[j]; v[4 + j] *= g1[j]; }
        }
#pragma unroll
        for (int i = 0; i < 4; ++i) {
            u32x4 o; o.x = pk2(v[0][i], v[1][i]); o.y = pk2(v[2][i], v[3][i]); o.z = pk2(v[4][i], v[5][i]); o.w = pk2(v[6][i], v[7][i]);
            *(u32x4*)(Wt + (size_t)(drow + i) * K + kb) = o;
        }
    }
}
__device__ __forceinline__ void row_to_bf16(const float* xr, bf16_t* orow, float* ssout, int lane) {
    float s = 0.f;
#pragma unroll
    for (int j = 0; j < 8; ++j) { const f32x4 v = *(const f32x4*)(xr + 4 * lane + 256 * j); s += sum4(v * v);
        u32x2 w; w.x = pk2(v.x, v.y); w.y = pk2(v.z, v.w); *(u32x2*)(orow + 4 * lane + 256 * j) = w; }
    s = wave_sum(s);
    if (lane == 0) *ssout = s;
}

#define XB_TMO      128
#define XB_XCNT(j)  (256  + 64 * (j))
#define XB_XSUB(j)  (1280 + 64 * (j))
#define XB_XGEN(j)  (2304 + 64 * (j))
#define XB_TOP      3328
#define XB_TOPGEN   3392
#define XCD_BAR_WORDS 3456
#define XB_SPIN_CAP (1u << 18)
__device__ __forceinline__ unsigned xb_ld(unsigned* p)              { return __hip_atomic_load(p, __ATOMIC_RELAXED, __HIP_MEMORY_SCOPE_AGENT); }
__device__ __forceinline__ unsigned xb_add(unsigned* p, unsigned v) { return __hip_atomic_fetch_add(p, v, __ATOMIC_RELAXED, __HIP_MEMORY_SCOPE_AGENT); }
__device__ __forceinline__ unsigned xb_xcc_id() { return (unsigned)__builtin_amdgcn_s_getreg((3 << 11) | 20) & 0xFu; }
#define XB_SPIN(cond, bar) do { unsigned _sp = 0; while (cond) { __builtin_amdgcn_s_sleep(1); \
    if ((++_sp & 255u) == 0u) { if (xb_ld(&(bar)[XB_TMO])) break; if (_sp > XB_SPIN_CAP) { atomicAdd(&(bar)[XB_TMO], 1u); break; } } } } while (0)
struct XcdBarrier { unsigned* bar; unsigned x; volatile LAS unsigned* st; };
__device__ __forceinline__ XcdBarrier xcd_barrier_post(unsigned* bar, volatile LAS unsigned* st) {
    XcdBarrier b; b.bar = bar; b.x = xb_xcc_id(); b.st = st;
    if (threadIdx.x == 0) (void)xb_add(&bar[XB_XCNT(b.x)], 1u);
    return b;
}
__device__ __forceinline__ void xcd_barrier_complete(unsigned* bar, unsigned x, unsigned& nloc, unsigned& nx) {
    const unsigned G = gridDim.x * gridDim.y * gridDim.z;
    unsigned sum, cnt, mine, sp = 0u;
    for (;;) {
        sum = 0u; cnt = 0u; mine = 0u;
#pragma unroll
        for (unsigned j = 0; j < 16; ++j) { const unsigned c = xb_ld(&bar[XB_XCNT(j)]); sum += c; cnt += (c > 0u) ? 1u : 0u; mine = (j == x) ? c : mine; }
        if (sum == G) break;
        __builtin_amdgcn_s_sleep(1);
        if ((++sp & 255u) == 0u) { if (xb_ld(&bar[XB_TMO])) break; if (sp > XB_SPIN_CAP) { atomicAdd(&bar[XB_TMO], 1u); break; } }
    }
    nloc = mine > 0u ? mine : 1u; nx = cnt > 0u ? cnt : 1u;
}
__device__ __forceinline__ void xcd_barrier(const XcdBarrier& b) {
    asm volatile("s_waitcnt vmcnt(0)" ::: "memory");
    __syncthreads();
    if (threadIdx.x == 0) {
        unsigned* bar = b.bar;
        __builtin_amdgcn_s_waitcnt(0);
        unsigned nloc = b.st[0], nx = b.st[1];
        if (nloc == 0u) { xcd_barrier_complete(bar, b.x, nloc, nx); b.st[0] = nloc; b.st[1] = nx; }
        const unsigned old = xb_add(&bar[XB_XSUB(b.x)], 1u);
        const unsigned gen = old / nloc;
        if (old + 1u == (gen + 1u) * nloc) {
            __builtin_amdgcn_fence(__ATOMIC_RELEASE, "agent");
            asm volatile("s_waitcnt vmcnt(0)" ::: "memory");
            const unsigned og = xb_add(&bar[XB_TOP], 1u);
            const unsigned tg = og / nx;
            if (og + 1u == (tg + 1u) * nx) xb_add(&bar[XB_TOPGEN], 1u);
            else XB_SPIN(xb_ld(&bar[XB_TOPGEN]) == tg, bar);
            __builtin_amdgcn_fence(__ATOMIC_ACQUIRE, "agent");
            xb_add(&bar[XB_XGEN(b.x)], 1u);
            asm volatile("s_waitcnt vmcnt(0)" ::: "memory");
        } else {
            XB_SPIN(xb_ld(&bar[XB_XGEN(b.x)]) == gen, bar);
            __builtin_amdgcn_fence(__ATOMIC_ACQUIRE, "agent");
            asm volatile("s_waitcnt vmcnt(0)" ::: "memory");
        }
    }
    __syncthreads();
}

struct Args { const void* in[21]; float* out; unsigned char* ws; int lo, hi, flags, pad; };
constexpr int NPHASE = 16;
constexpr int FL_SKIP_MEMKV = 1, FL_SKIP_ATTN = 2, FL_SKIP_CROSS = 4, FL_SKIP_MAIN = 8, FL_XCDBAR = 16;
constexpr int LDS_BYTES = pg8::STAGE_BYTES + 2048;
constexpr size_t WS_BAR = 1400 * KiB, WS_BAR_BYTES = 16 * KiB;

__global__ void __launch_bounds__(512, 2) mega(Args args) {
    extern __shared__ __attribute__((aligned(16))) unsigned char lds_raw[];
    LAS unsigned char* lds = (LAS unsigned char*)lds_raw;
    cg::grid_group grid = cg::this_grid();
    constexpr int G = 256;
    const int wave0 = __builtin_amdgcn_readfirstlane(threadIdx.x >> 6);
    volatile LAS unsigned* bst = (volatile LAS unsigned*)(lds + pg8::STAGE_BYTES + 1024);
    if (threadIdx.x < 2) bst[threadIdx.x] = 0u;
    __syncthreads();
    XcdBarrier xbar; xbar.bar = (unsigned*)(args.ws + WS_BAR); xbar.x = 0; xbar.st = bst;
    if (args.flags & FL_XCDBAR) xbar = xcd_barrier_post((unsigned*)(args.ws + WS_BAR), bst);
    for (int ph = args.lo; ph < args.hi; ++ph) {
        int bx_ = blockIdx.x; asm volatile("" : "+s"(bx_)); const int bx = bx_, vcu = (bx % 8) * (G / 8) + bx / 8;
        unsigned char* ws = args.ws; asm volatile("" : "+s"(ws));
        constexpr int NGW = G * 8;
        const float* x_in = (const float*)args.in[0]; const float* mem = (const float*)args.in[1]; const int* positions = (const int*)args.in[2];
        float* xcur = args.out;
        float* ssb = (float*)(ws + WS_SS); float* qssb = (float*)(ws + WS_QSS); float* lsumb = (float*)(ws + WS_LSUM); float* kssb = (float*)(ws + WS_KSS); float* ssmem = (float*)(ws + WS_SSMEM);
        float* cs = (float*)(ws + WS_CS); float* xsh = (float*)(ws + WS_XSH);
        bf16_t* memb = (bf16_t*)(ws + WS_MEMB); bf16_t* mkraw = (bf16_t*)(ws + WS_MKRAW); bf16_t* mvT = (bf16_t*)(ws + WS_MVT);
        bf16_t* Win_t = (bf16_t*)(ws + WS_WIN); bf16_t* Wc_t = (bf16_t*)(ws + WS_WC); bf16_t* Wd_t = (bf16_t*)(ws + WS_WD); bf16_t* Wx_t = (bf16_t*)(ws + WS_WX);
        bf16_t* Wmkv_t = (bf16_t*)(ws + WS_WMKV); bf16_t* Wo_t = (bf16_t*)(ws + WS_WO); bf16_t* Wgu_t = (bf16_t*)(ws + WS_WGU); bf16_t* Wdn_t = (bf16_t*)(ws + WS_WDN);
        bf16_t* proj = (bf16_t*)(ws + WS_PROJ); bf16_t* VT = (bf16_t*)(ws + WS_VT); bf16_t* xb = (bf16_t*)(ws + WS_XB); bf16_t* mg = (bf16_t*)(ws + WS_MG); bf16_t* hb = (bf16_t*)(ws + WS_H);

        const int l = ph >> 3, p = ph & 7;
        const int wave = wave0, gw = vcu * 8 + wave;
#define PHASE_TID() const int tid = phase_tid(wave0), lane = tid & 63
        const float* gq_x = (const float*)args.in[14] + l * 256; const float* gk_x = (const float*)args.in[15] + l * 256;
        float* qss = qssb + (size_t)l * TOK * 4; float* lsum = lsumb + (size_t)l * TOK * 4; float* kss = kssb + l * 2048;
        if (p == 0) {
            PHASE_TID();
            const float* g_mix = (const float*)args.in[3] + l * DM; const float* g_mem = (const float*)args.in[12] + l * DM; const float* g_ffn = (const float*)args.in[18] + l * DM;
            const float* w_in = (const float*)args.in[4] + (size_t)l * DM * NIN; const float* w_co = (const float*)args.in[6] + (size_t)l * 1024 * DM;
            const float* w_do = (const float*)args.in[11] + (size_t)l * 1024 * DM; const float* w_mkv = (const float*)args.in[13] + (size_t)l * DM * 2048;
            const float* w_xo = (const float*)args.in[16] + (size_t)l * 1024 * DM; const float* w_o = (const float*)args.in[17] + (size_t)l * DM * DM;
            const float* w_gu = (const float*)args.in[19] + (size_t)l * DM * 2 * DFF; const float* w_dn = (const float*)args.in[20] + (size_t)l * DFF * DM;
            constexpr int I_IN = (NIN / 64) * (DM / 128), I_B = (DM / 64) * (1024 / 128), I_SQ = (DM / 64) * (DM / 128), I_GU = (2 * DFF / 64) * (DM / 128), I_DN = (DM / 64) * (DFF / 128);
            constexpr int NIT = I_IN + 3 * I_B + 2 * I_SQ + I_GU + I_DN;
#pragma unroll 1
            for (int rep = 0; rep < REP_P0; ++rep)
            for (int it = gw; it < NIT; it += NGW) {
                int r = it;
                if (r < I_IN) { conv_item(w_in, DM, NIN, Win_t, g_mix, 1, r, lane); continue; } r -= I_IN;
                if (r < I_GU) { conv_item(w_gu, DM, 2 * DFF, Wgu_t, g_ffn, 2, r, lane); continue; } r -= I_GU;
                if (r < I_DN) { conv_item(w_dn, DFF, DM, Wdn_t, nullptr, 0, r, lane); continue; } r -= I_DN;
                if (r < I_SQ) { conv_item(w_mkv, DM, 2048, Wmkv_t, g_mem, 0, r, lane); continue; } r -= I_SQ;
                if (r < I_SQ) { conv_item(w_o, DM, DM, Wo_t, nullptr, 0, r, lane); continue; } r -= I_SQ;
                if (r < I_B) { conv_item(w_co, 1024, DM, Wc_t, nullptr, 0, r, lane); continue; } r -= I_B;
                if (r < I_B) { conv_item(w_do, 1024, DM, Wd_t, nullptr, 0, r, lane); continue; } r -= I_B;
                conv_item(w_xo, 1024, DM, Wx_t, nullptr, 0, r, lane);
            }
            if (l == 0) {
                for (int m = gw; m < TOK; m += NGW) row_to_bf16(x_in + (size_t)m * DM, xb + (size_t)m * DM, ssb + m, lane);
                for (int m = gw; m < BATCH * MEMLEN; m += NGW) row_to_bf16(mem + (size_t)m * DM, memb + (size_t)m * DM, ssmem + m, lane);
                { unsigned* z = (unsigned*)(ws + WS_ZERO_LO); const int nz = (int)((WS_ZERO_HI - WS_ZERO_LO) / 4);
                  for (int i = bx * 512 + tid; i < nz; i += G * 512) z[i] = 0u; }
                for (int i = bx * 512 + tid; i < TOK * 8; i += G * 512) {
                    const int row = i >> 3, k = i & 7;
                    const float ang = (float)positions[row] * INVF[k];
                    const float kk = rintf(ang * 0.15915494309189535f);
                    float rr = fmaf(-kk, 6.2831854820251465f, ang); rr = fmaf(-kk, -1.7484556000744883e-07f, rr);
                    const float fr = rr * 0.15915494309189535f;
                    cs[row * 16 + k] = __builtin_amdgcn_cosf(fr); cs[row * 16 + 8 + k] = __builtin_amdgcn_sinf(fr);
                }
            }
        } else if (p == 1) {
            PHASE_TID();
            if (PH_EN(1) && !(args.flags & FL_SKIP_MAIN)) {
#pragma unroll 1
                for (int rep = 0; rep < REP_P1; ++rep)
                { pg8::Gemm g{xb, Win_t, TOK, NP, DM, DM, DM}; pg8::StaticOrder S; S.init(TOK, NP, G, bx);
                  pg8::EpiWrap<EIn> E{EIn{proj, ssb + (size_t)(2 * l) * TOK, gq_x, gk_x, rep == REP_P1 - 1 ? qss : nullptr}}; pg8::gemm_phase(lds, g, S, E, phase_tid(wave0)); }
                { pg8::Gemm g{Win_t + (size_t)NP * DM, xb, 1024, TOK, DM, DM, DM}; pg8::StaticOrder S; S.init(1024, TOK, G, bx);
                  pg8::EpiWrap<EColScale> E{EColScale{VT, ssb + (size_t)(2 * l) * TOK, TOK, 0}}; pg8::gemm_phase(lds, g, S, E, phase_tid(wave0)); }
            }
        } else if (p == 2) {
            PHASE_TID();
            const bool do_mkv = !(args.flags & FL_SKIP_MEMKV) && G >= 32;
            if (bx == G - 1 && wave == 0) { const float mx = xattn_shift(gq_x, gk_x, lane); if (lane == 0) xsh[l] = mx; }
#pragma unroll 1
            for (int rep2 = 0; rep2 < REP_P2; ++rep2) { const bool real2 = rep2 == REP_P2 - 1;
            if (PH_EN(2) && do_mkv && bx < 16) {
                if (bx < 8) { pg8::Gemm g{memb, Wmkv_t, 512, 1024, DM, DM, DM}; pg8::StaticOrder S; S.init(512, 1024, 8, bx);
                    pg8::EpiWrap<EMemK> E{EMemK{mkraw, ssmem, real2 ? kss : nullptr}}; pg8::gemm_phase(lds, g, S, E, phase_tid(wave0)); }
                else { pg8::Gemm g{Wmkv_t + (size_t)1024 * DM, memb, 1024, 512, DM, DM, DM}; pg8::StaticOrder S; S.init(1024, 512, 8, bx - 8);
                    pg8::EpiWrap<EColScale> E{EColScale{mvT, ssmem, 512, 0}}; pg8::gemm_phase(lds, g, S, E, phase_tid(wave0)); }
            } else {
                const int nb0 = do_mkv ? 16 : 0, NW2 = (G - nb0) * 8, gw2 = (bx - nb0) * 8 + wave;
                const float* gqd = (const float*)args.in[7] + l * 64; const float* gkd = (const float*)args.in[8] + l * 64; const float* cw = (const float*)args.in[5] + l * 3 * 1024;
#pragma unroll 1
                for (int base = gw2; base < 2 * TOK; base += 4 * NW2) {
                    u32x4 wv[4][2];
#pragma unroll
                    for (int j4 = 0; j4 < 4; ++j4) { const int tk = min(base + j4 * NW2, 2 * TOK - 1);
                        const bf16_t* pp = proj + (size_t)(tk >> 1) * NP + ((tk & 1) ? C_DK : C_DQ) + lane * 16; wv[j4][0] = *(const u32x4*)pp; wv[j4][1] = *(const u32x4*)(pp + 8); }
#pragma unroll
                    for (int j4 = 0; j4 < 4; ++j4) { const int tk = base + j4 * NW2;
                        if (tk < 2 * TOK) {
                            const int row = tk >> 1, which = tk & 1, j = lane & 3;
                            bf16_t* pp = proj + (size_t)row * NP + (which ? C_DK : C_DQ) + lane * 16;
                            f32x4 f0, f1, f2, f3; unpack8(wv[j4][0], f0, f1); unpack8(wv[j4][1], f2, f3);
                            float ss = sum4(f0 * f0) + sum4(f1 * f1) + sum4(f2 * f2) + sum4(f3 * f3);
                            ss += swz_xor<1>(ss); ss += swz_xor<2>(ss);
                            const float rs = rs_of(ss, 1.f / 64);
                            const float* gg = (which ? gkd : gqd) + 16 * j;
                            f0 *= *(const f32x4*)gg * rs; f1 *= *(const f32x4*)(gg + 4) * rs; f2 *= *(const f32x4*)(gg + 8) * rs; f3 *= *(const f32x4*)(gg + 12) * rs;
                            if (j == 0) {
                                const float* cr = cs + (size_t)row * 16;
                                const f32x4 c0 = *(const f32x4*)cr, c1 = *(const f32x4*)(cr + 4), s0 = *(const f32x4*)(cr + 8), s1 = *(const f32x4*)(cr + 12);
                                const f32x4 a0 = f0 * c0 - f2 * s0, a1 = f1 * c1 - f3 * s1, b0 = f2 * c0 + f0 * s0, b1 = f3 * c1 + f1 * s1;
                                f0 = a0; f1 = a1; f2 = b0; f3 = b1;
                            }
                            if (!which) { const float sc = 0.125f * LOG2E; f0 *= sc; f1 *= sc; f2 *= sc; f3 *= sc; }
                            bf16_t* po = real2 ? pp : mg + (size_t)row * DM + lane * 16; *(u32x4*)po = pack8(f0, f1); *(u32x4*)(po + 8) = pack8(f2, f3);
                        } }
                }
#pragma unroll 1
                for (int base = gw2; base < 2 * TOK; base += 2 * NW2) {
                    u32x4 vc[2][3], vx[2][3], vb[2];
#pragma unroll
                    for (int j2 = 0; j2 < 2; ++j2) { const int tk = min(base + j2 * NW2, 2 * TOK - 1);
                        const int id = tk * 64 + lane, row = id >> 7, ch = (id & 127) * 8, sq = row & (SEQ - 1); const bf16_t* pr = proj + (size_t)row * NP;
#pragma unroll
                        for (int jj = 0; jj < 3; ++jj) { const bf16_t* q = pr - (size_t)((sq - 2 + jj >= 0) ? (2 - jj) : 0) * NP; vc[j2][jj] = *(const u32x4*)(q + C_CC + ch); vx[j2][jj] = *(const u32x4*)(q + C_CX + ch); }
                        vb[j2] = *(const u32x4*)(pr + C_CB + ch); }
#pragma unroll
                    for (int j2 = 0; j2 < 2; ++j2) { const int tk = base + j2 * NW2;
                        if (tk < 2 * TOK) { const int id = tk * 64 + lane, row = id >> 7, ch = (id & 127) * 8, sq = row & (SEQ - 1);
                            f32x4 u0 = {0.f, 0.f, 0.f, 0.f}, u1 = u0;
#pragma unroll
                            for (int jj = 0; jj < 3; ++jj) {
                                if (sq - 2 + jj >= 0) { f32x4 a0, a1, b0, b1; unpack8(vc[j2][jj], a0, a1); unpack8(vx[j2][jj], b0, b1);
                                    u0 += *(const f32x4*)(cw + jj * 1024 + ch) * (a0 * b0); u1 += *(const f32x4*)(cw + jj * 1024 + ch + 4) * (a1 * b1); } }
                            f32x4 g0, g1; unpack8(vb[j2], g0, g1);
                            *(u32x4*)(real2 ? proj + (size_t)row * NP + C_CA + ch : mg + (size_t)row * DM + 1024 + ch) = pack8(g0 * u0, g1 * u1);
                        } }
                }
            }
            }
        } else if (p == 3) {
            PHASE_TID();
            if (PH_EN(3) && !(args.flags & FL_SKIP_ATTN)) {
                const AttnConsts ac = attn_consts((const float*)args.in[7] + l * 64, (const float*)args.in[8] + l * 64, (const float*)args.in[9] + l * 256, l, lane);
                const float* gsub = (const float*)args.in[10] + l * 128;
#pragma unroll 1
                for (int rep = 0; rep < REP_ATTN; ++rep) {
                    const bool real = (rep == REP_ATTN - 1);
                    const int v = vcu, bh = v >> 4, s = v & 15;
#pragma unroll 1
                    for (int i = 0; i < 4; ++i) { const int qb = (i == 0) ? 63 - s : (i == 1) ? 32 + s : (i == 2) ? 31 - s : s;
                        if (ac.Mfix <= 40.f) diff_attn_unit<true>(lds, proj, VT, bh >> 3, bh & 7, qb, ac, gsub, phase_tid(wave0), real ? proj : mg, real ? NP : DM, real ? C_OB : 0);
                        else diff_attn_unit<false>(lds, proj, VT, bh >> 3, bh & 7, qb, ac, gsub, phase_tid(wave0), real ? proj : mg, real ? NP : DM, real ? C_OB : 0); }
                }
            }
            if (PH_EN(8) && !(args.flags & FL_SKIP_CROSS)) {
#pragma unroll 1
                for (int repx = 0; repx < REP_X; ++repx) {
                    const int u = bx; const bool realx = repx == REP_X - 1;
                    const int b = u >> 7, h = (u >> 5) & 3, qb = u & 31;
                    { pg8::Gemm g{proj + C_XQ + h * 256, mkraw + (size_t)(b * 256) * 1024 + h * 256, TOK, 256, 256, NP, 1024};
                      LAS float* rkl = (LAS float*)(lds + pg8::STAGE_BYTES);
                      if (tid < 256) rkl[tid] = rs_of(kss[(b * 256 + tid) * 4 + h], 1.f / 256);
                      __syncthreads();
                      pg8::OneUnit S{{b * 32 + qb, 0, 0, 0}, true}; pg8::EpiWrap<EXs<true>> E{EXs<true>{proj, qss, kss, realx ? lsum : nullptr, xsh + l, (unsigned)(uintptr_t)rkl, b, h, LOG2E / 16.f}}; pg8::gemm_phase(lds, g, S, E, phase_tid(wave0)); }
                    __threadfence(); __syncthreads();
                    { pg8::Gemm g{proj + C_P + h * 256, mvT + (size_t)(h * 256) * 512 + b * 256, TOK, 256, 256, NP, 512};
                      pg8::OneUnit S{{b * 32 + qb, 0, 0, 0}, true}; pg8::EpiWrap<EXo> E{EXo{proj, lsum, h, 0}}; pg8::gemm_phase(lds, g, S, E, phase_tid(wave0)); }
                }
            }
        } else if (p == 4) {
            PHASE_TID();
            if (PH_EN(4) && !(args.flags & FL_SKIP_MAIN)) {
#pragma unroll 1
                for (int rep = 0; rep < REP_P4; ++rep) {
                    pg8::Gemm g{proj, Wc_t, TOK, DM, 1024, NP, 1024}; pg8::ChainOrder S; S.base.init(TOK, DM, G, bx);
                    pg8::EpiChain E{mg, proj}; pg8::gemm_phase(lds, g, S, E, phase_tid(wave0));
                }
            }
        } else if (p == 5) {
            PHASE_TID();
            if (PH_EN(5) && !(args.flags & FL_SKIP_MAIN)) {
#pragma unroll 1
                for (int rep = 0; rep < REP_P5; ++rep) { const bool real = rep == REP_P5 - 1;
                pg8::Gemm g{mg, Wo_t, TOK, DM, DM, DM, DM}; pg8::StaticOrder S; S.init(TOK, DM, G, bx);
                pg8::EpiWrap<ERes> E{ERes{l == 0 ? x_in : xcur, real ? xcur : (float*)(ws + WS_PROJ + 192 * MiB), real ? xb : (bf16_t*)(ws + WS_PROJ + 320 * MiB), real ? ssb + (size_t)(2 * l + 1) * TOK : nullptr}}; pg8::gemm_phase(lds, g, S, E, phase_tid(wave0)); }
            }
        } else if (p == 6) {
            PHASE_TID();
            if (PH_EN(6) && !(args.flags & FL_SKIP_MAIN)) {
#pragma unroll 1
                for (int rep = 0; rep < REP_GU; ++rep) {
                pg8::Gemm g{xb, Wgu_t, TOK, 2 * DFF, DM, DM, DM}; pg8::StaticOrder S; S.init(TOK, 2 * DFF, G, bx);
                pg8::EpiWrap<EGU> E{EGU{hb, ssb + (size_t)(2 * l + 1) * TOK}}; pg8::gemm_phase(lds, g, S, E, phase_tid(wave0)); }
            }
        } else {
            PHASE_TID();
            if (PH_EN(7) && !(args.flags & FL_SKIP_MAIN)) {
#pragma unroll 1
                for (int rep = 0; rep < REP_P7; ++rep) { const bool real = rep == REP_P7 - 1;
                pg8::Gemm g{hb, Wdn_t, TOK, DM, DFF, DFF, DFF}; pg8::StaticOrder S; S.init(TOK, DM, G, bx);
                pg8::EpiWrap<ERes> E{ERes{xcur, real ? xcur : (float*)(ws + WS_PROJ + 192 * MiB), real ? xb : (bf16_t*)(ws + WS_PROJ + 320 * MiB), (real && l == 0) ? ssb + (size_t)2 * TOK : nullptr}}; pg8::gemm_phase(lds, g, S, E, phase_tid(wave0)); }
            }
        }
        if (ph + 1 < args.hi) { if (!(args.flags & FL_XCDBAR) || ph == args.lo) grid.sync(); else xcd_barrier(xbar); }
    }
}

template <class E> static void launch_naive(const bf16_t* A, int lda, const bf16_t* Bt, int ldb, int M, int N, int K, E e, hipStream_t st) {
    const size_t n = (size_t)(M / 32) * (E::PAIRED ? (N / 256) * 4 : N / 32);
    hipLaunchKernelGGL(naive_gemm<E>, dim3((unsigned)((n + 3) / 4)), dim3(256), 0, st, A, Bt, e, lda, ldb, M, N, K, 0);
}

extern "C" void kernel_launch(void* const* d_in, const int* in_sizes, int n_in, void* d_out, int out_size, void* d_ws, size_t ws_size, hipStream_t stream) {
    static int grid = 0;
    if (grid == 0) {
        if (n_in != 21 || out_size != TOK * DM || ws_size < WS_END) { fprintf(stderr, "kernel_launch: unexpected shapes / workspace (%d inputs, out %d, ws %zu < %zu)\n", n_in, out_size, ws_size, (size_t)WS_END); grid = -1; return; }
        int dev = 0, cus = 0, per_cu = 0;
        hipGetDevice(&dev); hipDeviceGetAttribute(&cus, hipDeviceAttributeMultiprocessorCount, dev);
        hipFuncSetAttribute((const void*)mega, hipFuncAttributeMaxDynamicSharedMemorySize, LDS_BYTES);
        hipOccupancyMaxActiveBlocksPerMultiprocessor(&per_cu, (const void*)mega, 512, LDS_BYTES);
        if (per_cu < 1) per_cu = 1;
        grid = cus * per_cu; if (grid > 256) grid = 256;
        if (grid != 256) { fprintf(stderr, "kernel_launch: needs 256 co-resident workgroups, got %d\n", grid); grid = -1; return; }
        (void)hipGetLastError();
    }
    if (grid < 0) return;
    unsigned char* ws = (unsigned char*)d_ws;
    Args a{};
    for (int i = 0; i < 21; ++i) a.in[i] = d_in[i];
    a.out = (float*)d_out; a.ws = ws;
    float* ssb = (float*)(ws + WS_SS); float* qssb = (float*)(ws + WS_QSS); float* lsumb = (float*)(ws + WS_LSUM); float* kssb = (float*)(ws + WS_KSS); float* ssmem = (float*)(ws + WS_SSMEM);
    bf16_t* memb = (bf16_t*)(ws + WS_MEMB); bf16_t* mkraw = (bf16_t*)(ws + WS_MKRAW); bf16_t* mvT = (bf16_t*)(ws + WS_MVT);
    bf16_t* Win_t = (bf16_t*)(ws + WS_WIN); bf16_t* Wc_t = (bf16_t*)(ws + WS_WC); bf16_t* Wd_t = (bf16_t*)(ws + WS_WD); bf16_t* Wx_t = (bf16_t*)(ws + WS_WX);
    bf16_t* Wmkv_t = (bf16_t*)(ws + WS_WMKV); bf16_t* Wo_t = (bf16_t*)(ws + WS_WO); bf16_t* Wgu_t = (bf16_t*)(ws + WS_WGU); bf16_t* Wdn_t = (bf16_t*)(ws + WS_WDN);
    bf16_t* proj = (bf16_t*)(ws + WS_PROJ); bf16_t* VT = (bf16_t*)(ws + WS_VT); bf16_t* xb = (bf16_t*)(ws + WS_XB); bf16_t* mg = (bf16_t*)(ws + WS_MG); bf16_t* hb = (bf16_t*)(ws + WS_H);
    const float* x_in = (const float*)d_in[0]; float* xcur = (float*)d_out;

    static Args store[NPHASE + 1]; int nco = 0;
    auto coop = [&](int lo, int hi, int flags) {
        a.lo = lo; a.hi = hi; a.flags = flags; store[nco] = a;
        void* kargs[] = {&store[nco]}; ++nco;
        hipError_t e = hipSuccess;
        if (hi - lo == 1) hipLaunchKernelGGL(mega, dim3(grid), dim3(512), LDS_BYTES, stream, store[nco - 1]);
        else e = hipLaunchCooperativeKernel((const void*)mega, dim3(grid), dim3(512), kargs, LDS_BYTES, stream);
        if (e != hipSuccess) fprintf(stderr, "cooperative launch failed: %s (grid %d)\n", hipGetErrorString(e), grid);
    };
    auto is_naive = [](int p) { return p != 0 && ((NAIVE_MASK >> p) & 1); };
    int ph = 0;
#ifndef STOP_PH
#define STOP_PH NPHASE
#endif
    while (ph < STOP_PH) {
        const int l = ph >> 3, p = ph & 7;
#ifndef SKIP_PH
#define SKIP_PH 0x0
#endif
        if ((SKIP_PH >> p) & 1) { ++ph; continue; }
        const bool cross_naive = (NAIVE_MASK >> 8) & 1;
        const bool pure_fast = !is_naive(p) && !(p == 3 && cross_naive);
        if (pure_fast) {
            int e = ph + 1;
            while (e < STOP_PH) { const int q = e & 7; if (is_naive(q) || (q == 3 && cross_naive)) break; ++e; }
            const bool whole = (ph == 0 && e == NPHASE);
            if (whole) (void)hipMemsetAsync(ws + WS_BAR, 0, WS_BAR_BYTES, stream);
            coop(ph, e, whole ? FL_XCDBAR : 0); ph = e; continue;
        }
        const float* gq_x = (const float*)d_in[14] + l * 256; const float* gk_x = (const float*)d_in[15] + l * 256;
        float* qss = qssb + (size_t)l * TOK * 4; float* lsum = lsumb + (size_t)l * TOK * 4; float* kss = kssb + l * 2048;
        const float* ss0 = ssb + (size_t)(2 * l) * TOK; float* ss1 = ssb + (size_t)(2 * l + 1) * TOK;
        if (p == 1) {
            launch_naive(xb, DM, Win_t, DM, TOK, NP, DM, EIn{proj, ss0, gq_x, gk_x, qss}, stream);
            launch_naive(Win_t + (size_t)NP * DM, DM, xb, DM, 1024, TOK, DM, EColScale{VT, ss0, TOK, 0}, stream);
        } else if (p == 2) {
            coop(ph, ph + 1, FL_SKIP_MEMKV);
            launch_naive(memb, DM, Wmkv_t, DM, 512, 1024, DM, EMemK{mkraw, ssmem, kss}, stream);
            launch_naive(Wmkv_t + (size_t)1024 * DM, DM, memb, DM, 1024, 512, DM, EColScale{mvT, ssmem, 512, 0}, stream);
        } else if (p == 3) {
            const bool attn_naive = is_naive(3);
            if (!attn_naive || !cross_naive) coop(ph, ph + 1, (attn_naive ? FL_SKIP_ATTN : 0) | (cross_naive ? FL_SKIP_CROSS : 0));
            if (attn_naive && !(DBG_SKIP & 1))
                hipLaunchKernelGGL(naive_diff_attn, dim3(16 * 256), dim3(256), 0, stream, proj, VT, (const float*)d_in[7] + l * 64, (const float*)d_in[8] + l * 64,
                                   (const float*)d_in[9] + l * 256, (const float*)d_in[10] + l * 128, l, 0);
            if (cross_naive && !(DBG_SKIP & 2)) {
                for (int b = 0; b < BATCH; ++b) for (int h = 0; h < 4; ++h) {
                    launch_naive(proj + (size_t)b * SEQ * NP + C_XQ + h * 256, NP, mkraw + (size_t)(b * 256) * 1024 + h * 256, 1024, SEQ, 256, 256,
                                 EXs<false>{proj + (size_t)b * SEQ * NP, qss + (size_t)b * SEQ * 4, kss, lsum + (size_t)b * SEQ * 4, (const float*)(ws + WS_XSH) + l, 0u, b, h, LOG2E / 16.f}, stream);
                }
                for (int b = 0; b < BATCH; ++b) for (int h = 0; h < 4; ++h) {
                    launch_naive(proj + (size_t)b * SEQ * NP + C_P + h * 256, NP, mvT + (size_t)(h * 256) * 512 + b * 256, 512, SEQ, 256, 256,
                                 EXo{proj + (size_t)b * SEQ * NP, lsum + (size_t)b * SEQ * 4, h, 0}, stream);
                }
            }
        } else if (p == 4) {
            launch_naive(proj + C_CA, NP, Wc_t, 1024, TOK, DM, 1024, EMerge{mg, proj, 0, 0}, stream);
            launch_naive(proj + C_OB, NP, Wd_t, 1024, TOK, DM, 1024, EMerge{mg, proj, 1, 0}, stream);
            launch_naive(proj + C_OC, NP, Wx_t, 1024, TOK, DM, 1024, EMerge{mg, proj, 2, 0}, stream);
        } else if (p == 5) {
            launch_naive(mg, DM, Wo_t, DM, TOK, DM, DM, ERes{l == 0 ? x_in : xcur, xcur, xb, ss1}, stream);
        } else if (p == 6) {
            launch_naive(xb, DM, Wgu_t, DM, TOK, 2 * DFF, DM, EGU{hb, ss1}, stream);
        } else if (p == 7) {
            launch_naive(hb, DFF, Wdn_t, DFF, TOK, DM, DFF, ERes{xcur, xcur, xb, l == 0 ? ssb + (size_t)2 * TOK : nullptr}, stream);
        }
        ++ph;
    }
}
```
